# Optimizing an MI355X kernel written in HIP

```python
import jax, jax.numpy as jnp
from jax import lax
import numpy as np

D_MODEL = 1024
BATCH = 16
SEQ = 4096
DEPTH = 2

GRID_W = 64
CTX_LEN = 256
HEAD_DIM = 64
ATTN_WIDTH = D_MODEL // 2
N_Q_HEADS = ATTN_WIDTH // HEAD_DIM
N_KV_HEADS = N_Q_HEADS // 4
GQA_GROUP = N_Q_HEADS // N_KV_HEADS
KV_WIDTH = N_KV_HEADS * HEAD_DIM
POOL_WINDOWS = (2, 4, 8, 16)
N_POOL_GROUPS = len(POOL_WINDOWS)
POOL_WIDTH = D_MODEL // 4
POOL_GROUP = POOL_WIDTH // N_POOL_GROUPS
N_FOURIER_GROUPS = 4
FOURIER_WIDTH = D_MODEL // 4
FOURIER_GROUP = FOURIER_WIDTH // N_FOURIER_GROUPS
MIX_WIDTH = ATTN_WIDTH + POOL_WIDTH + FOURIER_WIDTH
Q_END = ATTN_WIDTH
K_END = Q_END + KV_WIDTH
KV_END = K_END + KV_WIDTH
POOL_END = KV_END + POOL_WIDTH
IN_WIDTH = POOL_END + FOURIER_WIDTH
D_FF = -(-8 * D_MODEL // (3 * 256)) * 256
Q_BLOCK = 128
ROPE_THETA = 10000.0
EPS = 1e-6

kernel_name = "hybrid_attn_pool_fourier_dit_block"


def rms_norm(x, g):
    xf = x.astype(jnp.float32)
    y = xf * lax.rsqrt(jnp.mean(xf * xf, axis=-1, keepdims=True) + EPS)
    return (y * g.astype(jnp.float32)).astype(x.dtype)


def axial_rope_tables(length):
    rows = length // GRID_W
    row_ids = jnp.repeat(jnp.arange(rows), GRID_W).astype(jnp.float32)
    col_ids = jnp.tile(jnp.arange(GRID_W), rows).astype(jnp.float32)
    n_freq = HEAD_DIM // 4
    freqs = ROPE_THETA ** (-jnp.arange(n_freq, dtype=jnp.float32) / n_freq)
    ang = jnp.stack([row_ids[:, None] * freqs, col_ids[:, None] * freqs], axis=1)
    return jnp.cos(ang), jnp.sin(ang)


def apply_rope(x, cos, sin):
    n_freq = HEAD_DIM // 4
    xf = x.astype(jnp.float32).reshape(*x.shape[:-1], 2, 2, n_freq)
    x1, x2 = xf[..., 0, :], xf[..., 1, :]
    cb, sb = cos[None, :, None], sin[None, :, None]
    out = jnp.stack([x1 * cb - x2 * sb, x2 * cb + x1 * sb], axis=-2)
    return out.reshape(x.shape).astype(x.dtype)


def gqa_softmax(qg, k, v):
    s = jnp.einsum('bqgrd,bkgd->bgrqk', qg, k, preferred_element_type=jnp.float32) * (HEAD_DIM ** -0.5)
    p = jax.nn.softmax(s, axis=-1).astype(v.dtype)
    return jnp.einsum('bgrqk,bkgd->bqgrd', p, v)


def latent_attention(q, k, v, k_ctx, v_ctx):
    b, s = q.shape[:2]
    n_blk = s // Q_BLOCK
    k_all = jnp.concatenate([k_ctx, k], axis=1)
    v_all = jnp.concatenate([v_ctx, v], axis=1)
    qb = q.reshape(b, n_blk, Q_BLOCK, N_KV_HEADS, GQA_GROUP, HEAD_DIM).transpose(1, 0, 2, 3, 4, 5)
    o = lax.map(lambda qblk: gqa_softmax(qblk, k_all, v_all), qb)
    return o.transpose(1, 0, 2, 3, 4, 5).reshape(b, s, ATTN_WIDTH)


def context_attention(q, k, v):
    b, cl = q.shape[:2]
    qg = q.reshape(b, cl, N_KV_HEADS, GQA_GROUP, HEAD_DIM)
    return gqa_softmax(qg, k, v).reshape(b, cl, ATTN_WIDTH)


def pool_mix(u, w_pool, pool_scale):
    b, length, _ = u.shape
    ug = u.astype(jnp.float32).reshape(b, length, N_POOL_GROUPS, POOL_GROUP)
    cs = jnp.concatenate([jnp.zeros((b, 1, N_POOL_GROUPS, POOL_GROUP), jnp.float32),
                          jnp.cumsum(ug, axis=1)], axis=1)
    t = jnp.arange(length)
    means = []
    for gi, w in enumerate(POOL_WINDOWS):
        lo = jnp.clip(t - w // 2, 0, length)
        hi = jnp.clip(t + w - w // 2, 0, length)
        cs_g = cs[:, :, gi]
        cnt = (hi - lo).astype(jnp.float32)
        means.append((cs_g[:, hi] - cs_g[:, lo]) / cnt[None, :, None])
    d = jnp.stack(means, axis=2) - ug
    y = jnp.einsum('blgc,gcd->blgd', d, w_pool.astype(jnp.float32)).reshape(b, length, POOL_WIDTH)
    return (y * pool_scale.astype(jnp.float32)).astype(u.dtype)


def fourier_mix(u, w_four):
    b, length, _ = u.shape
    ug = u.astype(jnp.float32).reshape(b, length, N_FOURIER_GROUPS, FOURIER_GROUP)
    f = jnp.fft.fft2(ug, axes=(1, 3), norm='ortho').real
    y = jnp.einsum('blgc,gcd->blgd', f, w_four.astype(jnp.float32))
    return y.reshape(b, length, FOURIER_WIDTH).astype(u.dtype)


def head_rms(x, g):
    return rms_norm(x, g)


def swiglu(h, w_gate_up, w_down):
    gate, up = jnp.split(h @ w_gate_up, 2, axis=-1)
    return (jax.nn.silu(gate) * up) @ w_down


def setup_inputs(seed: int = 0) -> dict:
    key = jax.random.key(seed)
    ks = jax.random.split(key, 18)
    f32 = jnp.float32

    def nrm(k, shape, s):
        return jax.random.normal(k, shape, f32) * s

    return {
        "x": nrm(ks[0], (BATCH, SEQ, D_MODEL), 1.0),
        "c": nrm(ks[1], (BATCH, D_MODEL), 1.0),
        "ctx": nrm(ks[2], (BATCH, CTX_LEN, D_MODEL), 1.0),
        "c_ctx": nrm(ks[3], (D_MODEL,), 1.0),
        "w_ada": nrm(ks[4], (DEPTH, D_MODEL, 6 * D_MODEL), D_MODEL ** -0.5),
        "b_ada": nrm(ks[5], (DEPTH, 6 * D_MODEL), 0.01),
        "g_mix": 1.0 + nrm(ks[6], (DEPTH, D_MODEL), 0.02),
        "g_ffn": 1.0 + nrm(ks[7], (DEPTH, D_MODEL), 0.02),
        "w_in": nrm(ks[8], (DEPTH, D_MODEL, IN_WIDTH), D_MODEL ** -0.5),
        "q_gain": 1.0 + nrm(ks[9], (DEPTH, HEAD_DIM), 0.02),
        "k_gain": 1.0 + nrm(ks[10], (DEPTH, HEAD_DIM), 0.02),
        "w_pool": nrm(ks[11], (DEPTH, N_POOL_GROUPS, POOL_GROUP, POOL_GROUP), POOL_GROUP ** -0.5),
        "pool_scale": 1.0 + nrm(ks[12], (DEPTH, POOL_WIDTH), 0.02),
        "w_four": nrm(ks[13], (DEPTH, N_FOURIER_GROUPS, FOURIER_GROUP, FOURIER_GROUP), FOURIER_GROUP ** -0.5),
        "w_out": nrm(ks[14], (DEPTH, MIX_WIDTH, D_MODEL), MIX_WIDTH ** -0.5),
        "w_gate_up": nrm(ks[15], (DEPTH, D_MODEL, 2 * D_FF), D_MODEL ** -0.5),
        "w_down": nrm(ks[16], (DEPTH, D_FF, D_MODEL), D_FF ** -0.5),
    }


def reference(x, c, ctx, c_ctx, w_ada, b_ada, g_mix, g_ffn, w_in, q_gain, k_gain,
              w_pool, pool_scale, w_four, w_out, w_gate_up, w_down):
    b, s, _ = x.shape
    cl = ctx.shape[1]
    cos, sin = axial_rope_tables(s)
    sc, scc = jax.nn.silu(c), jax.nn.silu(c_ctx)
    for i in range(DEPTH):
        update_ctx = i < DEPTH - 1
        mod_x = (sc @ w_ada[i] + b_ada[i])[:, None, :]
        mod_c = scc @ w_ada[i] + b_ada[i]
        sh1, sc1, ga1, sh2, sc2, ga2 = jnp.split(mod_x, 6, axis=-1)
        csh1, csc1, cga1, csh2, csc2, cga2 = jnp.split(mod_c, 6, axis=-1)

        hx = rms_norm(x, g_mix[i]) * (1.0 + sc1) + sh1
        hc = rms_norm(ctx, g_mix[i]) * (1.0 + csc1) + csh1
        zx = hx @ w_in[i]
        if update_ctx:
            zc = hc @ w_in[i]
            zc_kv = zc[..., Q_END:KV_END]
        else:
            zc_kv = hc @ w_in[i][:, Q_END:KV_END]
        kc = head_rms(zc_kv[..., :KV_WIDTH].reshape(b, cl, N_KV_HEADS, HEAD_DIM), k_gain[i])
        vc = zc_kv[..., KV_WIDTH:].reshape(b, cl, N_KV_HEADS, HEAD_DIM)

        q = apply_rope(head_rms(zx[..., :Q_END].reshape(b, s, N_Q_HEADS, HEAD_DIM), q_gain[i]), cos, sin)
        k = apply_rope(head_rms(zx[..., Q_END:K_END].reshape(b, s, N_KV_HEADS, HEAD_DIM), k_gain[i]), cos, sin)
        v = zx[..., K_END:KV_END].reshape(b, s, N_KV_HEADS, HEAD_DIM)
        mx = jnp.concatenate([
            latent_attention(q, k, v, kc, vc),
            pool_mix(zx[..., KV_END:POOL_END], w_pool[i], pool_scale[i]),
            fourier_mix(zx[..., POOL_END:], w_four[i]),
        ], axis=-1)
        x = x + ga1 * (mx @ w_out[i])

        if update_ctx:
            qc = head_rms(zc[..., :Q_END].reshape(b, cl, N_Q_HEADS, HEAD_DIM), q_gain[i])
            mc = jnp.concatenate([
                context_attention(qc, kc, vc),
                pool_mix(zc[..., KV_END:POOL_END], w_pool[i], pool_scale[i]),
                fourier_mix(zc[..., POOL_END:], w_four[i]),
            ], axis=-1)
            ctx = ctx + cga1 * (mc @ w_out[i])

        fx = rms_norm(x, g_ffn[i]) * (1.0 + sc2) + sh2
        x = x + ga2 * swiglu(fx, w_gate_up[i], w_down[i])
        if update_ctx:
            fc = rms_norm(ctx, g_ffn[i]) * (1.0 + csc2) + csh2
            ctx = ctx + cga2 * swiglu(fc, w_gate_up[i], w_down[i])
    return x
```

```cpp
#include <hip/hip_runtime.h>
#include <hip/hip_bf16.h>
#include <hip/hip_cooperative_groups.h>
#include <cstdio>
#include <cstdint>
#include <cmath>
namespace pg8 {
#define PG8_LAS __attribute__((address_space(3)))
typedef unsigned short bf16_t;
typedef short bf16x8 __attribute__((ext_vector_type(8)));
typedef float f32x4 __attribute__((ext_vector_type(4)));
typedef unsigned u32x4 __attribute__((ext_vector_type(4)));
constexpr int BM = 256, BK = 64, HALF = 128, HTB = HALF * BK * 2  , STAGE_BYTES = 8 * HTB, NXCD = 8, WGM = 8;

__host__ __device__ __forceinline__ int lds_byte(int r, int c) { const int st = (r >> 4) * 2 + (c >> 5), rr = r & 15, cc = c & 31, ob = rr * 64 + cc * 2; return st * 1024 + (ob ^ (((ob >> 9) & 1) << 5)); }
__host__ __device__ __forceinline__ void stage_rc(int b, int& R, int& C) { const int st = b / 1024, sb = b % 1024, swz = sb ^ (((sb >> 9) & 1) << 5); R = (st >> 1) * 16 + swz / 64; C = (st & 1) * 32 + (swz % 64) / 2; }
__host__ __device__ __forceinline__ int perm32(int rho) { const int n = rho >> 4, i = rho & 15; return 8 * (i >> 2) + 4 * n + (i & 3); }

struct Unit { int pm, pn; };
struct Gemm { const bf16_t* A; const bf16_t* Bt; int M, N, K; };

struct StaticOrder {
    int nM, nN, nwg, G, c;
    __host__ __device__ void init(int M, int N, int G_, int c_) { nM = M / BM; nN = N / BM; nwg = nM * nN; G = G_; c = c_; }
    __host__ __device__ bool next(int i, Unit& u) const {
        const long L = (long)i * G + c; if (L >= nwg) return false;
        int wgid = (int)L; { const int q = nwg / NXCD, r = nwg % NXCD, xcd = wgid % NXCD, off = wgid / NXCD; wgid = (xcd < r ? xcd * (q + 1) : r * (q + 1) + (xcd - r) * q) + off; }
        const int nig = WGM * nN, gid = wgid / nig, fm = gid * WGM, gsz = (nM - fm) < WGM ? (nM - fm) : WGM;
        u.pm = fm + ((wgid % nig) % gsz); u.pn = (wgid % nig) / gsz; return true;
    }
    __device__ __forceinline__ void a_ready(const Unit&) const {}
    __device__ __forceinline__ void done(const Unit&) const {}
};

__device__ __forceinline__ unsigned cvt_pk_bf16(float lo, float hi) { unsigned r; asm volatile("v_cvt_pk_bf16_f32 %0, %1, %2" : "=v"(r) : "v"(lo), "v"(hi)); return r; }
typedef float f32x2 __attribute__((ext_vector_type(2)));
constexpr int XROWS = 65536, CTXL = 256, SEQL = 4096, MODW = 6144;
struct EpiIn {
    static constexpr bool PERM = true, AFTER_DRAIN = false;
    bf16_t* Z; bf16_t* PQt; bf16_t* PQtc; int row_off, col_off;
    bf16_t* QP; bf16_t* KP; bf16_t* VP; const float* qg; const float* kg; const PG8_LAS float* rope; float qscale;
    __device__ __forceinline__ void operator()(const f32x4 (&acc)[2][2][4][2], const Unit& u, int wr, int wc, int fr, int fq) const {
        const int gr0 = row_off + u.pm * BM, ct = (col_off >> 8) + u.pn;
        if (ct < 3) {
            const bool isx = gr0 < XROWS, isv = (ct == 2) && (wc >= 2), isq = ct < 2;
            f32x4 gn[2][2];
            { const float* gp = (isq ? qg : kg) + 8 * fq;
#pragma unroll
              for (int bj = 0; bj < 2; ++bj)
#pragma unroll
                  for (int n = 0; n < 2; ++n) gn[bj][n] = *(const f32x4*)(gp + 32 * bj + 4 * n); }
            const float osc = isq ? qscale : 1.0f;
            const int half = fq >> 1, f0 = 8 * (fq & 1);
#pragma unroll
            for (int ai = 0; ai < 2; ++ai)
#pragma unroll
                for (int m = 0; m < 4; ++m) {
                    const int grow = gr0 + ai * HALF + wr * 64 + m * 16 + fr;
                    const int b = isx ? (grow >> 12) : ((grow - XROWS) >> 8), t = isx ? (grow & 4095) : ((grow - XROWS) & 255);
                    const size_t kvrow = (size_t)b * (SEQL + CTXL) + (isx ? CTXL + t : t);
                    if (isv) {
#pragma unroll
                        for (int bj = 0; bj < 2; ++bj) { const f32x4 v0 = acc[ai][bj][m][0], v1 = acc[ai][bj][m][1];
                            u32x4 w; w.x = cvt_pk_bf16(v0[0], v0[1]); w.y = cvt_pk_bf16(v0[2], v0[3]); w.z = cvt_pk_bf16(v1[0], v1[1]); w.w = cvt_pk_bf16(v1[2], v1[3]);
                            *(u32x4*)(VP + kvrow * 128 + (wc - 2) * 64 + 32 * bj + 8 * fq) = w; }
                    } else {
                        float ss = 0.f;
#pragma unroll
                        for (int bj = 0; bj < 2; ++bj)
#pragma unroll
                            for (int n = 0; n < 2; ++n) { const f32x4 v = acc[ai][bj][m][n]; ss += (v[0] * v[0] + v[1] * v[1]) + (v[2] * v[2] + v[3] * v[3]); }
                        ss += __shfl_xor(ss, 16); ss += __shfl_xor(ss, 32);
                        const float rstd = 1.0f / sqrtf(ss * (1.0f / 64.0f) + 1e-6f);
#pragma unroll
                        for (int bj = 0; bj < 2; ++bj) { f32x4 y[2];
#pragma unroll
                            for (int n = 0; n < 2; ++n) y[n] = acc[ai][bj][m][n] * rstd * gn[bj][n];
                            f32x4 pr[2];
#pragma unroll
                            for (int n = 0; n < 2; ++n)
#pragma unroll
                                for (int j = 0; j < 4; ++j) pr[n][j] = __shfl_xor(y[n][j], 32);
                            if (isx) { const int pos = bj == 0 ? (t >> 6) : (t & 63); const PG8_LAS float* cp = rope + pos * 16 + f0;
#pragma unroll
                                for (int n = 0; n < 2; ++n) { const f32x4 c = *(const PG8_LAS f32x4*)(cp + 4 * n), s = *(const PG8_LAS f32x4*)(cp + 1024 + 4 * n);
                                    y[n] = half == 0 ? y[n] * c - pr[n] * s : y[n] * c + pr[n] * s; } }
                            const f32x4 o0 = y[0] * osc, o1 = y[1] * osc;
                            u32x4 w; w.x = cvt_pk_bf16(o0[0], o0[1]); w.y = cvt_pk_bf16(o0[2], o0[3]); w.z = cvt_pk_bf16(o1[0], o1[1]); w.w = cvt_pk_bf16(o1[2], o1[3]);
                            bf16_t* dst = isq ? QP + (size_t)grow * 512 + (ct * 4 + wc) * 64 + 32 * bj + 8 * fq : KP + kvrow * 128 + wc * 64 + 32 * bj + 8 * fq;
                            *(u32x4*)dst = w; }
                    }
                }
        } else if (ct == 3) {
            bf16_t* base = Z + (size_t)(gr0 + wr * 64 + fr) * 1024 + ct * 256 + wc * 32 + 8 * fq;
#pragma unroll
            for (int ai = 0; ai < 2; ++ai)
#pragma unroll
                for (int m = 0; m < 4; ++m) { bf16_t* rowp = base + (size_t)(ai * HALF + m * 16) * 1024;
#pragma unroll
                    for (int bj = 0; bj < 2; ++bj) { const f32x4 v0 = acc[ai][bj][m][0], v1 = acc[ai][bj][m][1];
                        u32x4 w; w.x = cvt_pk_bf16(v0[0], v0[1]); w.y = cvt_pk_bf16(v0[2], v0[3]); w.z = cvt_pk_bf16(v1[0], v1[1]); w.w = cvt_pk_bf16(v1[2], v1[3]);
                        *(u32x4*)(rowp + bj * HALF) = w; } }
        } else {
            const int part = ct - 4; const bool isx = gr0 < XROWS;
            const int b = isx ? (gr0 >> 12) : ((gr0 - XROWS) >> 8);
            const int L = isx ? SEQL : CTXL;
            const int l0 = (isx ? (gr0 & 4095) : 0) + wr * 64 + fr;
            bf16_t* T = isx ? PQt : PQtc;
#pragma unroll
            for (int bj = 0; bj < 2; ++bj)
#pragma unroll
                for (int n = 0; n < 2; ++n)
#pragma unroll
                    for (int j = 0; j < 4; ++j) { const int cc = bj * HALF + wc * 32 + 8 * fq + 4 * n + j;
                        bf16_t* cp = T + ((size_t)((b * 256 + cc) * 2 + part)) * L + l0;
#pragma unroll
                        for (int ai = 0; ai < 2; ++ai)
#pragma unroll
                            for (int m = 0; m < 4; ++m) cp[ai * HALF + m * 16] = (bf16_t)(cvt_pk_bf16(acc[ai][bj][m][n][j], 0.f) & 0xffffu); }
        }
    }
};
struct EpiRes {
    static constexpr bool PERM = true, AFTER_DRAIN = false;
    const float* bx; const float* bc; const bf16_t* bs; bf16_t* os; float* of; const float* gate;
    __device__ __forceinline__ void operator()(const f32x4 (&acc)[2][2][4][2], const Unit& u, int wr, int wc, int fr, int fq) const {
        const bool isx = u.pm < 256;
        const float* gt = gate + (size_t)(isx ? (u.pm >> 4) : 16) * MODW;
        const int col0 = u.pn * BM + wc * 32 + 8 * fq;
        f32x4 gv[2][2];
#pragma unroll
        for (int bj = 0; bj < 2; ++bj)
#pragma unroll
            for (int n = 0; n < 2; ++n) gv[bj][n] = *(const f32x4*)(gt + col0 + bj * HALF + 4 * n);
        const bool bf32 = bx != nullptr, obf = os != nullptr;
#pragma unroll
        for (int ai = 0; ai < 2; ++ai)
#pragma unroll
            for (int m = 0; m < 4; ++m) { const size_t grow = (size_t)u.pm * BM + ai * HALF + wr * 64 + m * 16 + fr;
#pragma unroll
                for (int bj = 0; bj < 2; ++bj) { const size_t off = grow * 1024 + col0 + bj * HALF; f32x4 b0, b1;
                    if (bf32) { const float* bp = isx ? bx + off : bc + (off - (size_t)XROWS * 1024); b0 = *(const f32x4*)bp; b1 = *(const f32x4*)(bp + 4); }
                    else { const u32x4 w = *(const u32x4*)(bs + off);
                        b0 = (f32x4){__builtin_bit_cast(float, w.x << 16), __builtin_bit_cast(float, w.x & 0xffff0000u), __builtin_bit_cast(float, w.y << 16), __builtin_bit_cast(float, w.y & 0xffff0000u)};
                        b1 = (f32x4){__builtin_bit_cast(float, w.z << 16), __builtin_bit_cast(float, w.z & 0xffff0000u), __builtin_bit_cast(float, w.w << 16), __builtin_bit_cast(float, w.w & 0xffff0000u)}; }
                    const f32x4 o0 = b0 + gv[bj][0] * acc[ai][bj][m][0], o1 = b1 + gv[bj][1] * acc[ai][bj][m][1];
                    if (obf) { u32x4 w; w.x = cvt_pk_bf16(o0[0], o0[1]); w.y = cvt_pk_bf16(o0[2], o0[3]); w.z = cvt_pk_bf16(o1[0], o1[1]); w.w = cvt_pk_bf16(o1[2], o1[3]); *(u32x4*)(os + off) = w; }
                    else { *(f32x4*)(of + off) = o0; *(f32x4*)(of + off + 4) = o1; } } }
    }
};
struct EpiSwiglu {
    static constexpr bool PERM = true, AFTER_DRAIN = false;
    bf16_t* H;
    __device__ __forceinline__ void operator()(const f32x4 (&acc)[2][2][4][2], const Unit& u, int wr, int wc, int fr, int fq) const {
        bf16_t* base = H + (size_t)(u.pm * BM + wr * 64 + fr) * 2816 + u.pn * HALF + wc * 32 + 8 * fq;
#pragma unroll
        for (int ai = 0; ai < 2; ++ai)
#pragma unroll
            for (int m = 0; m < 4; ++m) { float r[8];
#pragma unroll
                for (int n = 0; n < 2; ++n)
#pragma unroll
                    for (int j = 0; j < 4; ++j) { const float g = acc[ai][0][m][n][j], up = acc[ai][1][m][n][j];
                        r[n * 4 + j] = g * __builtin_amdgcn_rcpf(1.0f + __builtin_amdgcn_exp2f(-1.4426950408889634f * g)) * up; }
                u32x4 w; w.x = cvt_pk_bf16(r[0], r[1]); w.y = cvt_pk_bf16(r[2], r[3]); w.z = cvt_pk_bf16(r[4], r[5]); w.w = cvt_pk_bf16(r[6], r[7]);
                *(u32x4*)(base + (size_t)(ai * HALF + m * 16) * 2816) = w; }
    }
};
struct EpiFour {
    static constexpr bool PERM = true, AFTER_DRAIN = false;
    bf16_t* MX; int rowbase, L; float scale;
    __device__ __forceinline__ void operator()(const f32x4 (&acc)[2][2][4][2], const Unit& u, int wr, int wc, int fr, int fq) const {
        bf16_t* base = MX + (size_t)(rowbase + u.pn * L + u.pm * BM + wr * 64 + fr) * 1024 + 768 + wc * 32 + 8 * fq;
#pragma unroll
        for (int ai = 0; ai < 2; ++ai)
#pragma unroll
            for (int m = 0; m < 4; ++m) { bf16_t* rowp = base + (size_t)(ai * HALF + m * 16) * 1024;
#pragma unroll
                for (int bj = 0; bj < 2; ++bj) { const f32x4 v0 = acc[ai][bj][m][0] * scale, v1 = acc[ai][bj][m][1] * scale;
                    u32x4 w; w.x = cvt_pk_bf16(v0[0], v0[1]); w.y = cvt_pk_bf16(v0[2], v0[3]); w.z = cvt_pk_bf16(v1[0], v1[1]); w.w = cvt_pk_bf16(v1[2], v1[3]);
                    *(u32x4*)(rowp + bj * HALF) = w; } }
    }
};
template <class Epi, class Sched, bool ALIGN_EPI = false, bool SP2 = false>
__device__ __forceinline__ void gemm_phase(PG8_LAS unsigned char* lds, const Gemm g, const Sched& S, const Epi& E) {
    int tid_l = threadIdx.x; asm volatile("" : "+v"(tid_l)); const int tid = tid_l, wid = __builtin_amdgcn_readfirstlane(tid >> 6), lane = tid & 63, wr = wid >> 2, wc = wid & 3, fr = lane & 15, fq = lane >> 4;
    const int K = g.K, nt = K / BK;
    unsigned voffA[2], voffB[2];
#pragma unroll
    for (int i = 0; i < 2; ++i) { int R, C; stage_rc(tid * 16 + i * 8192, R, C); const int Rb = Epi::PERM ? ((R & ~31) + perm32(R & 31)) : R;
        voffA[i] = (unsigned)(R * K + C) * 2u; voffB[i] = (unsigned)(Rb * K + C) * 2u; }
    const size_t kstep = (size_t)(BK * 2);
    const size_t hstep = (size_t)HALF * K * 2;
    const size_t tstep = 2 * hstep;
    const unsigned ldsw = (unsigned)wid * 1024u;
    const int aoff = lds_byte(wr * 64 + fr, fq * 8), boff = lds_byte(wc * 32 + fr, fq * 8);
#define PG8_SA(b, h) (((b) * 2 + (h)) * HTB)
#define PG8_SB(b, h) ((4 + (b) * 2 + (h)) * HTB)
#define PG8_STAGE(bufoff, gbase, voff) do { _Pragma("unroll") for (int _i = 0; _i < 2; ++_i) \
        __builtin_amdgcn_global_load_lds((const unsigned*)((const char*)(gbase) + (voff)[_i]), (PG8_LAS unsigned*)(lds + (bufoff) + ldsw + _i * 8192), 16, 0, 0); } while (0)
#define PG8_LDA(dst, b, h) do { _Pragma("unroll") for (int m = 0; m < 4; ++m) _Pragma("unroll") for (int k = 0; k < 2; ++k) dst[m][k] = *(const PG8_LAS bf16x8*)(lds + PG8_SA(b, h) + aoff + m * 2048 + k * 1024); } while (0)
#define PG8_LDB(dst, b, h) do { _Pragma("unroll") for (int n = 0; n < 2; ++n) _Pragma("unroll") for (int k = 0; k < 2; ++k) dst[n][k] = *(const PG8_LAS bf16x8*)(lds + PG8_SB(b, h) + boff + n * 2048 + k * 1024); } while (0)
#define PG8_MMA(ai, bj, At, Bt) do { __builtin_amdgcn_s_setprio(1); _Pragma("unroll") for (int m = 0; m < 4; ++m) _Pragma("unroll") for (int n = 0; n < 2; ++n) _Pragma("unroll") for (int k = 0; k < 2; ++k) \
        acc[ai][bj][m][n] = __builtin_amdgcn_mfma_f32_16x16x32_bf16(Bt[n][k], At[m][k], acc[ai][bj][m][n], 0, 0, 0); __builtin_amdgcn_s_setprio(0); } while (0)
#define PG8_WAIT_V(n) asm volatile("s_waitcnt vmcnt(" #n ")" ::: "memory")
#define PG8_WAIT_L(n) asm volatile("s_waitcnt lgkmcnt(" #n ")" ::: "memory")
#define PG8_BAR __builtin_amdgcn_s_barrier()
#define PG8_SCHED __builtin_amdgcn_sched_barrier(0)
    Unit cur, nxt; int ui = 0;
    if (!S.next(0, cur)) return;
    f32x4 acc[2][2][4][2];
#pragma unroll
    for (int a = 0; a < 2; ++a)
#pragma unroll
        for (int b = 0; b < 2; ++b)
#pragma unroll
            for (int m = 0; m < 4; ++m)
#pragma unroll
                for (int n = 0; n < 2; ++n) acc[a][b][m][n] = (f32x4){0.f, 0.f, 0.f, 0.f};
    bf16x8 At[4][2], B0[2][2], B1[2][2];
    const char* cA = (const char*)g.A + (size_t)cur.pm * tstep; const char* cB = (const char*)g.Bt + (size_t)cur.pn * tstep;
    S.a_ready(cur);
    if constexpr (SP2) {
        PG8_STAGE(PG8_SB(0, 0), cB, voffB); PG8_STAGE(PG8_SB(0, 1), cB + hstep, voffB); PG8_STAGE(PG8_SA(0, 0), cA, voffA); PG8_STAGE(PG8_SA(0, 1), cA + hstep, voffA);
        if (wr == 1) PG8_BAR;
        PG8_WAIT_V(2); PG8_BAR;
        PG8_STAGE(PG8_SB(1, 0), cB + kstep, voffB); PG8_STAGE(PG8_SA(1, 0), cA + kstep, voffA); PG8_STAGE(PG8_SB(1, 1), cB + hstep + kstep, voffB);
        PG8_WAIT_V(6); PG8_BAR;
    } else {
        PG8_STAGE(PG8_SB(0, 0), cB, voffB); PG8_STAGE(PG8_SA(0, 0), cA, voffA); PG8_STAGE(PG8_SB(0, 1), cB + hstep, voffB); PG8_STAGE(PG8_SA(0, 1), cA + hstep, voffA);
        if (wr == 1) PG8_BAR;
        PG8_WAIT_V(4); PG8_BAR;
        PG8_STAGE(PG8_SB(1, 0), cB + kstep, voffB); PG8_STAGE(PG8_SA(1, 0), cA + kstep, voffA); PG8_STAGE(PG8_SB(1, 1), cB + hstep + kstep, voffB);
        PG8_WAIT_V(6); PG8_BAR;
    }
    for (;;) {
        const bool has_next = S.next(ui + 1, nxt);
        const char* nA = has_next ? (const char*)g.A + (size_t)nxt.pm * tstep : cA; const char* nB = has_next ? (const char*)g.Bt + (size_t)nxt.pn * tstep : cB;
        for (int t = 0; t < nt; t += 2) {
            const bool last = (t == nt - 2);
            const char* a1 = cA + (size_t)(t + 1) * kstep;
            const char* a2 = last ? nA : cA + (size_t)(t + 2) * kstep; const char* b2 = last ? nB : cB + (size_t)(t + 2) * kstep;
            const char* a3 = a2 + kstep; const char* b3 = b2 + kstep;
            if (last && has_next) S.a_ready(nxt);
            if constexpr (SP2) {
            PG8_LDB(B0, 0, 0); PG8_LDB(B1, 0, 1); PG8_SCHED; PG8_LDA(At, 0, 0); PG8_STAGE(PG8_SA(1, 1), a1 + hstep, voffA);
            PG8_WAIT_V(8); PG8_WAIT_L(0); PG8_BAR; PG8_MMA(0, 0, At, B0); PG8_MMA(0, 1, At, B1); PG8_BAR; PG8_SCHED;
            PG8_LDA(At, 0, 1); PG8_STAGE(PG8_SB(0, 0), b2, voffB); PG8_STAGE(PG8_SB(0, 1), b2 + hstep, voffB); PG8_STAGE(PG8_SA(0, 0), a2, voffA);
            PG8_WAIT_V(8); PG8_WAIT_L(0); PG8_BAR; PG8_MMA(1, 0, At, B0); PG8_MMA(1, 1, At, B1); PG8_BAR; PG8_SCHED;
            PG8_LDB(B0, 1, 0); PG8_LDB(B1, 1, 1); PG8_SCHED; PG8_LDA(At, 1, 0); PG8_STAGE(PG8_SA(0, 1), a2 + hstep, voffA);
            PG8_WAIT_V(8); PG8_WAIT_L(0); PG8_BAR; PG8_MMA(0, 0, At, B0); PG8_MMA(0, 1, At, B1); PG8_BAR; PG8_SCHED;
            PG8_LDA(At, 1, 1); PG8_STAGE(PG8_SB(1, 0), b3, voffB); PG8_STAGE(PG8_SB(1, 1), b3 + hstep, voffB); PG8_STAGE(PG8_SA(1, 0), a3, voffA);
            PG8_WAIT_V(8); PG8_WAIT_L(0); PG8_BAR; PG8_MMA(1, 0, At, B0); PG8_MMA(1, 1, At, B1); PG8_BAR; PG8_SCHED;
            } else {
            PG8_LDB(B0, 0, 0); PG8_SCHED; PG8_LDA(At, 0, 0); PG8_STAGE(PG8_SA(1, 1), a1 + hstep, voffA);
            PG8_WAIT_L(8); PG8_BAR; PG8_WAIT_L(0); PG8_MMA(0, 0, At, B0); PG8_BAR; PG8_SCHED;
            PG8_LDB(B1, 0, 1); PG8_STAGE(PG8_SB(0, 0), b2, voffB);
            PG8_BAR; PG8_WAIT_L(0); PG8_MMA(0, 1, At, B1); PG8_BAR;
            PG8_LDA(At, 0, 1); PG8_STAGE(PG8_SA(0, 0), a2, voffA);
            PG8_BAR; PG8_WAIT_L(0); PG8_MMA(1, 0, At, B0); PG8_BAR; PG8_SCHED;
            PG8_STAGE(PG8_SB(0, 1), b2 + hstep, voffB);
            PG8_WAIT_V(6); PG8_BAR; PG8_MMA(1, 1, At, B1); PG8_BAR;
            PG8_LDB(B0, 1, 0); PG8_SCHED; PG8_LDA(At, 1, 0); PG8_STAGE(PG8_SA(0, 1), a2 + hstep, voffA);
            PG8_WAIT_L(8); PG8_BAR; PG8_WAIT_L(0); PG8_MMA(0, 0, At, B0); PG8_BAR; PG8_SCHED;
            PG8_LDB(B1, 1, 1); PG8_STAGE(PG8_SB(1, 0), b3, voffB);
            PG8_BAR; PG8_WAIT_L(0); PG8_MMA(0, 1, At, B1); PG8_BAR;
            PG8_LDA(At, 1, 1); PG8_STAGE(PG8_SA(1, 0), a3, voffA);
            PG8_BAR; PG8_WAIT_L(0); PG8_MMA(1, 0, At, B0); PG8_BAR; PG8_SCHED;
            PG8_STAGE(PG8_SB(1, 1), b3 + hstep, voffB);
            PG8_WAIT_V(6); PG8_BAR; PG8_MMA(1, 1, At, B1); PG8_BAR;
            }
        }
        if constexpr (ALIGN_EPI) { if (wr == 0) PG8_BAR; }
        if constexpr (!Epi::AFTER_DRAIN) { E(acc, cur, wr, wc, fr, fq); S.done(cur); }
        if (!has_next) break;
#pragma unroll
        for (int a = 0; a < 2; ++a)
#pragma unroll
            for (int b = 0; b < 2; ++b)
#pragma unroll
                for (int m = 0; m < 4; ++m)
#pragma unroll
                    for (int n = 0; n < 2; ++n) acc[a][b][m][n] = (f32x4){0.f, 0.f, 0.f, 0.f};
        cur = nxt; cA = nA; cB = nB; ++ui;
        if constexpr (ALIGN_EPI) { if (wr == 1) PG8_BAR; }
    }
    PG8_WAIT_V(0);
    if constexpr (!ALIGN_EPI) { if (wr == 0) PG8_BAR; }
    PG8_BAR;
    if constexpr (Epi::AFTER_DRAIN) { E.fused(acc, cur, wr, wc, fr, fq, lds, wid, lane); S.done(cur); }
#undef PG8_SA
#undef PG8_SB
#undef PG8_STAGE
#undef PG8_LDA
#undef PG8_LDB
#undef PG8_MMA
#undef PG8_WAIT_V
#undef PG8_WAIT_L
#undef PG8_BAR
#undef PG8_SCHED
}
}
namespace attn_body {
using bf16=__hip_bfloat16;
using bf16x8=__attribute__((ext_vector_type(8)))short;
using s16x4=__attribute__((ext_vector_type(4)))short;
using f32x16=__attribute__((ext_vector_type(16)))float;
using u32x4=__attribute__((ext_vector_type(4)))unsigned;
constexpr int D=64,QPITCH=512,KVPITCH=128,OPITCH=1024;
constexpr int NW=8,QBLK=32,QB=QBLK*NW,KVBLK=64;

__device__ __forceinline__ int crow(int r,int hi){return (r&3)+8*(r>>2)+4*hi;}
#define SBAR() __builtin_amdgcn_sched_barrier(0)
__device__ __forceinline__ void cmask(f32x16&p0,f32x16&p1,int jb,int qrel,int hi){
  const float NEG=-INFINITY; int kb=64*jb+4*hi;
  #pragma unroll
  for(int r=0;r<16;++r){int kv=kb+(r&3)+8*(r>>2); if(kv>qrel)p0[r]=NEG; if(kv+32>qrel)p1[r]=NEG;}
}

constexpr int NSLOT=3, SLOTB=8192;
constexpr int LDS_K=0, LDS_V=NSLOT*SLOTB, LDS_WS=2*NSLOT*SLOTB, LDS_OST=LDS_WS+NW*64*4, LDS_BYTES=LDS_OST+NW*4096;
constexpr float C2=0.125f*1.4426950408889634f;
__device__ __forceinline__ void glds16(const void*gsrc,unsigned lds_dst){unsigned keep;
  asm volatile("s_mov_b32 %0, m0\n\ts_mov_b32 m0, %2\n\ts_nop 0\n\tglobal_load_lds_dwordx4 %1, off\n\ts_mov_b32 m0, %0":"=&s"(keep):"v"(gsrc),"s"(lds_dst):"memory");}
__device__ __forceinline__ float max3f(float a,float b,float c){float r;asm("v_max3_f32 %0, %1, %2, %3":"=v"(r):"v"(a),"v"(b),"v"(c));return r;}
__device__ __forceinline__ float max2f(float a,float b){float r;asm("v_max_f32_e32 %0, %1, %2":"=v"(r):"v"(a),"v"(b));return r;}
__device__ __forceinline__ float fadd_s(float a,float b){float r;asm("v_add_f32_e32 %0, %1, %2":"=v"(r):"v"(a),"v"(b));return r;}
__device__ __forceinline__ float fsub_s(float a,float b){float r;asm("v_sub_f32_e32 %0, %1, %2":"=v"(r):"v"(a),"v"(b));return r;}
typedef float f32x2_t __attribute__((ext_vector_type(2))); typedef __bf16 bf16x2_t __attribute__((ext_vector_type(2)));
__device__ __forceinline__ unsigned cvtpk_s(float lo,float hi){f32x2_t v={lo,hi};bf16x2_t b=__builtin_convertvector(v,bf16x2_t);return __builtin_bit_cast(unsigned,b);}
#define WAIT_BAR(N) asm volatile("s_waitcnt vmcnt(" #N ") lgkmcnt(0)\n\ts_barrier":::"memory")

__device__ __forceinline__ void qkt(f32x16&p0,f32x16&p1,const char*Kslot,const bf16x8*qr,const f32x16&negm,int r32,int hi){
  const char*kb=Kslot+hi*1024+r32*16;
  #pragma unroll
  for(int d0=0;d0<4;++d0){
    const bf16x8 b0=*reinterpret_cast<const bf16x8*>(kb+d0*2048);
    const bf16x8 b1=*reinterpret_cast<const bf16x8*>(kb+d0*2048+512);
    if(d0==0){p0=__builtin_amdgcn_mfma_f32_32x32x16_bf16(b0,qr[0],negm,0,0,0);p1=__builtin_amdgcn_mfma_f32_32x32x16_bf16(b1,qr[0],negm,0,0,0);}
    else{p0=__builtin_amdgcn_mfma_f32_32x32x16_bf16(b0,qr[d0],p0,0,0,0);p1=__builtin_amdgcn_mfma_f32_32x32x16_bf16(b1,qr[d0],p1,0,0,0);}}
}
typedef __attribute__((address_space(3))) const char* lds_cptr;
typedef short v4i16_t __attribute__((ext_vector_type(4)));
__device__ __forceinline__ void kload8(bf16x8*kf,lds_cptr kp){
  kf[0]=*(const __attribute__((address_space(3))) bf16x8*)(kp);      kf[1]=*(const __attribute__((address_space(3))) bf16x8*)(kp+512);
  kf[2]=*(const __attribute__((address_space(3))) bf16x8*)(kp+2048); kf[3]=*(const __attribute__((address_space(3))) bf16x8*)(kp+2560);
  kf[4]=*(const __attribute__((address_space(3))) bf16x8*)(kp+4096); kf[5]=*(const __attribute__((address_space(3))) bf16x8*)(kp+4608);
  kf[6]=*(const __attribute__((address_space(3))) bf16x8*)(kp+6144); kf[7]=*(const __attribute__((address_space(3))) bf16x8*)(kp+6656);
}
__device__ __forceinline__ void kload2(bf16x8*kf,lds_cptr kp,int j){ kf[2*j]=*(const __attribute__((address_space(3))) bf16x8*)(kp+j*2048); kf[2*j+1]=*(const __attribute__((address_space(3))) bf16x8*)(kp+j*2048+512); }
__device__ __forceinline__ s16x4 vtr(lds_cptr p){ return __builtin_bit_cast(s16x4,__builtin_amdgcn_ds_read_tr16_b64_v4i16((__attribute__((address_space(3))) v4i16_t*)p)); }
__device__ __forceinline__ float rowmax(const f32x16&p0,const f32x16&p1){
  float a=max3f(p0[0],p0[1],p1[0]),b=max3f(p0[2],p0[3],p1[1]);a=max3f(a,p1[2],p1[3]);
  #pragma unroll
  for(int r=4;r<16;r+=4){a=max3f(a,p0[r],p0[r+1]);b=max3f(b,p0[r+2],p0[r+3]);a=max3f(a,p1[r],p1[r+1]);b=max3f(b,p1[r+2],p1[r+3]);}
  const float m=max2f(a,b);
  auto rr=__builtin_amdgcn_permlane32_swap(__float_as_uint(m),__float_as_uint(m),false,false);
  return max2f(__uint_as_float(rr[0]),__uint_as_float(rr[1]));
}
__device__ __forceinline__ void pv(f32x16*o,int vb,bf16x8 pa0,bf16x8 pa1,bf16x8 pa2,bf16x8 pa3){
  #pragma unroll
  for(int d0=0;d0<2;++d0){s16x4 lo[4],hi[4];
    #pragma unroll
    for(int ks=0;ks<4;++ks){
      asm volatile("ds_read_b64_tr_b16 %0,%1 offset:%c2":"=&v"(lo[ks]):"v"(vb),"i"(d0*4096+ks*1024):"memory");
      asm volatile("ds_read_b64_tr_b16 %0,%1 offset:%c2":"=&v"(hi[ks]):"v"(vb),"i"(d0*4096+ks*1024+512):"memory");}
    asm volatile("s_waitcnt lgkmcnt(0)":::"memory");SBAR();
    #define PK(k) (bf16x8){lo[k][0],lo[k][1],lo[k][2],lo[k][3],hi[k][0],hi[k][1],hi[k][2],hi[k][3]}
    o[d0]=__builtin_amdgcn_mfma_f32_32x32x16_bf16(pa0,PK(0),o[d0],0,0,0);
    o[d0]=__builtin_amdgcn_mfma_f32_32x32x16_bf16(pa1,PK(1),o[d0],0,0,0);
    o[d0]=__builtin_amdgcn_mfma_f32_32x32x16_bf16(pa2,PK(2),o[d0],0,0,0);
    o[d0]=__builtin_amdgcn_mfma_f32_32x32x16_bf16(pa3,PK(3),o[d0],0,0,0);
    #undef PK
  }
}

#ifndef ATTN_STORE16
#define ATTN_STORE16(p,v) (*(u32x4*)(p)=(v))
#endif
template<int THRL> __device__ __forceinline__ void attn_unit(const bf16*Qu,const bf16*__restrict__ Kh,const bf16*__restrict__ Vh,bf16*Ou,const int NT,char*shm){
  int tid_l=threadIdx.x; asm volatile("":"+v"(tid_l)); const int tid=tid_l,lane=tid&63,r32=lane&31,hi=lane>>5; const int wid=__builtin_amdgcn_readfirstlane(tid>>6);
  const bf16*Qw=Qu+(long)(wid*QBLK)*QPITCH;
  const unsigned lds0=(unsigned)(uintptr_t)shm;
  float*wsf=(float*)(shm+LDS_WS)+wid*64;
  const bf16*ksrc=Kh+(long)lane*KVPITCH+wid*8;
  const bf16*vsrc=Vh+(long)(16*(wid&3)+(lane>>2))*KVPITCH+(wid>>2)*32+(lane&3)*8;
  const unsigned kdst=lds0+LDS_K+wid*1024, vdst=lds0+LDS_V+wid*1024;
  #define DMA_K(t,slot) glds16(ksrc+(long)(t)*KVBLK*KVPITCH,(unsigned)__builtin_amdgcn_readfirstlane(kdst+(slot)))
  #define DMA_V(t,slot) glds16(vsrc+(long)(t)*KVBLK*KVPITCH,(unsigned)__builtin_amdgcn_readfirstlane(vdst+(slot)))
  const int vb0=(int)(lds0+LDS_V)+((lane>>4)&1)*32+(lane&3)*8+(4*hi+((lane&15)>>2))*64;
  const char*Kbase=shm+LDS_K; bf16x8 kf[8];
  const lds_cptr shm3=(lds_cptr)shm; const lds_cptr kp0=shm3+LDS_K+hi*1024+r32*16; const lds_cptr vp0=shm3+LDS_V+((lane>>4)&1)*32+(lane&3)*8+(4*hi+((lane&15)>>2))*64;
  DMA_K(0,0);DMA_V(0,0);DMA_K(1,SLOTB);
  bf16x8 qr[4];
  #pragma unroll
  for(int d0=0;d0<4;++d0)qr[d0]=*reinterpret_cast<const bf16x8*>(&Qw[(long)r32*QPITCH+d0*16+hi*8]);
  float mhat=0.f,l_reg=0.f;f32x16 o[2];o[0]=f32x16{};o[1]=f32x16{};f32x16 negm=f32x16{};asm volatile("":"+v"(negm));
  #define CMASK(P0,P1,t) do{}while(0)
  bool resc=false;
  #define START(P0,P1) do{ const float rm=rowmax(P0,P1); resc=false; \
    { const float dl=rm; mhat=fadd_s(mhat,dl); \
      _Pragma("unroll") for(int r=0;r<16;++r){P0[r]=fsub_s(P0[r],dl);P1[r]=fsub_s(P1[r],dl);} \
      _Pragma("unroll") for(int r=0;r<16;++r)negm[r]=-mhat; asm volatile("":"+v"(negm)); } \
    _Pragma("unroll") for(int r=0;r<16;++r)P0[r]=__builtin_amdgcn_exp2f(P0[r]); }while(0)
  #define RESC() do{ if(resc){ asm volatile("s_waitcnt lgkmcnt(0)":::"memory"); \
      _Pragma("unroll") for(int d_=0;d_<2;++d_) _Pragma("unroll") for(int r=0;r<16;++r)o[d_][r]*=wsf[crow(r,hi)]; } }while(0)
  f32x16 pA0,pA1,pB0,pB1;
  int sl_prev=0,sl_cur=0,sl_next=SLOTB;
  #define ROT() do{sl_prev=sl_cur;sl_cur=sl_next;sl_next=(sl_next==(NSLOT-1)*SLOTB)?0:sl_next+SLOTB;}while(0)
  DMA_K(2,2*SLOTB);
  WAIT_BAR(3);
  qkt(pA0,pA1,Kbase,qr,negm,r32,hi);asm volatile("s_nop 15\n\ts_nop 7":"+v"(pA0),"+v"(pA1));CMASK(pA0,pA1,0);
  START(pA0,pA1);
  _Pragma("unroll") for(int r=0;r<16;++r)pA1[r]=__builtin_amdgcn_exp2f(pA1[r]);
  WAIT_BAR(0);
  DMA_K(3,0);DMA_V(1,SLOTB);
  ROT();
  kload8(kf,kp0+sl_cur);
  WAIT_BAR(2);
  s16x4 vlo[8],vhi[8]; u32x4 pw0,pw1,pw2,pw3;
  #define PKW(P,B) cvtpk_s(P[B],P[B+1])
  #define PAF(k) __builtin_bit_cast(bf16x8,pw##k)
  #define VFR(i) (bf16x8){vlo[i][0],vlo[i][1],vlo[i][2],vlo[i][3],vhi[i][0],vhi[i][1],vhi[i][2],vhi[i][3]}
  #define PIN(x) asm volatile("":"+v"(x))
  #define MX3(a,b,c) __builtin_fmaxf(__builtin_fmaxf((a),(b)),(c))
  #define GAPA(MF,A0,A1,A2,A3,W0,W1,PW) do{ MF; sacc+=A0; sacc+=A1; sacc+=A2; sacc+=A3; PIN(sacc); W0; W1; PIN(PW); SBAR(); }while(0)
  #define EX(v) __builtin_amdgcn_exp2f(v)
  #define GAPB(MF,X,B) do{ MF; X[B]=EX(X[B]); X[B+1]=EX(X[B+1]); X[B+2]=EX(X[B+2]); X[B+3]=EX(X[B+3]); PIN(X); SBAR(); }while(0)
  #define VRD(i) do{ vlo[i]=vtr(vp_+(((i)>>2)*4096+((i)&3)*1024)); vhi[i]=vtr(vp_+(((i)>>2)*4096+((i)&3)*1024+512)); }while(0)
  #define KRD(G,j) do{ if(G){ kload2(kf,kp0+sl_next,j); SBAR(); } }while(0)
  #define STEP(C0,C1,P0,P1,t,GK,GV,GL) do{ SBAR(); \
    const lds_cptr vp_=vp0+sl_prev; \
    VRD(0); SBAR(); float sacc=(P0[0]+P0[1]); \
    GAPA(C0=__builtin_amdgcn_mfma_f32_32x32x16_bf16(kf[0],qr[0],negm,0,0,0), P0[2],P0[3],P0[4],P0[5],     pw0[0]=PKW(P0,0), pw0[1]=PKW(P0,2), pw0); \
    VRD(4); SBAR(); GAPA(C1=__builtin_amdgcn_mfma_f32_32x32x16_bf16(kf[1],qr[0],negm,0,0,0), P0[6],P0[7],P0[8],P0[9],     pw0[2]=PKW(P0,4), pw0[3]=PKW(P0,6), pw0); \
    VRD(1); SBAR(); GAPA(C0=__builtin_amdgcn_mfma_f32_32x32x16_bf16(kf[2],qr[1],C0,0,0,0),   P0[10],P0[11],P0[12],P0[13], pw1[0]=PKW(P0,8), pw1[1]=PKW(P0,10), pw1); \
    VRD(5); SBAR(); GAPA(C1=__builtin_amdgcn_mfma_f32_32x32x16_bf16(kf[3],qr[1],C1,0,0,0),   P0[14],P0[15],P1[0],P1[1],   pw1[2]=PKW(P0,12),pw1[3]=PKW(P0,14), pw1); \
    VRD(2); SBAR(); GAPA(C0=__builtin_amdgcn_mfma_f32_32x32x16_bf16(kf[4],qr[2],C0,0,0,0),   P1[2],P1[3],P1[4],P1[5],     pw2[0]=PKW(P1,0), pw2[1]=PKW(P1,2), pw2); \
    VRD(6); SBAR(); GAPA(C1=__builtin_amdgcn_mfma_f32_32x32x16_bf16(kf[5],qr[2],C1,0,0,0),   P1[6],P1[7],P1[8],P1[9],     pw2[2]=PKW(P1,4), pw2[3]=PKW(P1,6), pw2); \
    VRD(3); SBAR(); GAPA(C0=__builtin_amdgcn_mfma_f32_32x32x16_bf16(kf[6],qr[3],C0,0,0,0),   P1[10],P1[11],P1[12],P1[13], pw3[0]=PKW(P1,8), pw3[1]=PKW(P1,10), pw3); \
    VRD(7); SBAR(); GAPA(C1=__builtin_amdgcn_mfma_f32_32x32x16_bf16(kf[7],qr[3],C1,0,0,0),   P1[14],P1[15],0.f,0.f,       pw3[2]=PKW(P1,12),pw3[3]=PKW(P1,14), pw3); \
    l_reg+=sacc; \
    if(GK){DMA_K((t)+3,sl_cur);} if(GV){DMA_V((t)+1,sl_next);} \
    CMASK(C0,C1,t); \
    { float a=MX3(C0[0],C0[1],C1[0]),b=MX3(C0[2],C0[3],C1[1]); a=MX3(a,C1[2],C1[3]); \
      _Pragma("unroll") for(int r=4;r<16;r+=4){a=MX3(a,C0[r],C0[r+1]);b=MX3(b,C0[r+2],C0[r+3]);a=MX3(a,C1[r],C1[r+1]);b=MX3(b,C1[r+2],C1[r+3]);} \
      float rm=__builtin_fmaxf(a,b); { auto rr=__builtin_amdgcn_permlane32_swap(__float_as_uint(rm),__float_as_uint(rm),false,false); rm=__builtin_fmaxf(__uint_as_float(rr[0]),__uint_as_float(rr[1])); } \
      resc=false; \
      if(__builtin_expect(__any(rm>(float)THRL),0)){ const float dl=__builtin_fmaxf(rm,0.f); mhat+=dl; \
        _Pragma("unroll") for(int r=0;r<16;++r){C0[r]-=dl;C1[r]-=dl;} \
        _Pragma("unroll") for(int r=0;r<16;++r)negm[r]=-mhat; asm volatile("":"+v"(negm)); \
        const float f=__builtin_amdgcn_exp2f(-dl); l_reg*=f; if(hi==0)wsf[r32]=f; resc=true; } } \
    SBAR(); \
    GAPB(o[0]=__builtin_amdgcn_mfma_f32_32x32x16_bf16(PAF(0),VFR(0),o[0],0,0,0), C0,0); \
    GAPB(o[1]=__builtin_amdgcn_mfma_f32_32x32x16_bf16(PAF(0),VFR(4),o[1],0,0,0), C0,4); \
    KRD(GL,0); GAPB(o[0]=__builtin_amdgcn_mfma_f32_32x32x16_bf16(PAF(1),VFR(1),o[0],0,0,0), C0,8); \
    KRD(GL,1); GAPB(o[1]=__builtin_amdgcn_mfma_f32_32x32x16_bf16(PAF(1),VFR(5),o[1],0,0,0), C0,12); \
    KRD(GL,2); GAPB(o[0]=__builtin_amdgcn_mfma_f32_32x32x16_bf16(PAF(2),VFR(2),o[0],0,0,0), C1,0); \
    KRD(GL,3); GAPB(o[1]=__builtin_amdgcn_mfma_f32_32x32x16_bf16(PAF(2),VFR(6),o[1],0,0,0), C1,4); \
    GAPB(o[0]=__builtin_amdgcn_mfma_f32_32x32x16_bf16(PAF(3),VFR(3),o[0],0,0,0), C1,8); \
    GAPB(o[1]=__builtin_amdgcn_mfma_f32_32x32x16_bf16(PAF(3),VFR(7),o[1],0,0,0), C1,12); \
    }while(0)
  int t=1;
  #undef CMASK
  #define CMASK(P0,P1,t) do{}while(0)
  for(;t+5<NT;t+=2){
    STEP(pB0,pB1,pA0,pA1,t,true,true,true);     WAIT_BAR(2); RESC(); ROT();
    STEP(pA0,pA1,pB0,pB1,t+1,true,true,true);   WAIT_BAR(2); RESC(); ROT();
  }
  #undef CMASK
  #define CMASK(P0,P1,t) do{}while(0)
  #define ENDW(tt) do{ if((tt)+3<NT){WAIT_BAR(2);} else if((tt)+2<NT){WAIT_BAR(1);} else {WAIT_BAR(0);} }while(0)
  for(;t+1<NT;t+=2){
    STEP(pB0,pB1,pA0,pA1,t,(t+3<NT),(t+1<NT),(t+1<NT));       ENDW(t);   RESC(); ROT();
    STEP(pA0,pA1,pB0,pB1,t+1,(t+4<NT),(t+2<NT),(t+2<NT));     ENDW(t+1); RESC(); ROT();
  }
  STEP(pB0,pB1,pA0,pA1,NT-1,false,false,false); RESC();
  { float sacc=pB0[0]+pB0[1]; _Pragma("unroll") for(int r=2;r<16;++r)sacc+=pB0[r]; _Pragma("unroll") for(int r=0;r<16;++r)sacc+=pB1[r]; l_reg+=sacc;
    pw0=(u32x4){PKW(pB0,0),PKW(pB0,2),PKW(pB0,4),PKW(pB0,6)};pw1=(u32x4){PKW(pB0,8),PKW(pB0,10),PKW(pB0,12),PKW(pB0,14)};pw2=(u32x4){PKW(pB1,0),PKW(pB1,2),PKW(pB1,4),PKW(pB1,6)};pw3=(u32x4){PKW(pB1,8),PKW(pB1,10),PKW(pB1,12),PKW(pB1,14)};
    SBAR(); pv(o,vb0+sl_cur,PAF(0),PAF(1),PAF(2),PAF(3)); }
  #undef PKW
  #undef PAF
  #undef VFR
  #undef PIN
  #undef MX3
  #undef GAPA
  #undef GAPB
  #undef EX
  #undef VRD
  #undef KRD
  #undef STEP
  #undef ENDW
  {auto rr=__builtin_amdgcn_permlane32_swap(__float_as_uint(l_reg),__float_as_uint(l_reg),false,false);l_reg=__uint_as_float(rr[0])+__uint_as_float(rr[1]);}
  if(hi==0)wsf[32+r32]=l_reg;asm volatile("s_waitcnt lgkmcnt(0)":::"memory");
  float rli[16];
  #pragma unroll
  for(int r=0;r<16;++r)rli[r]=__builtin_amdgcn_rcpf(wsf[32+crow(r,hi)]);
  bf16*Ow=Ou+(long)(wid*QBLK)*OPITCH;
  { bf16*stg=(bf16*)(shm+LDS_OST)+wid*2048;
    #pragma unroll
    for(int r=0;r<16;++r){const int orow=crow(r,hi);
      #pragma unroll
      for(int d0=0;d0<2;++d0)stg[orow*64+d0*32+r32]=__float2bfloat16(o[d0][r]*rli[r]);}
    asm volatile("s_waitcnt lgkmcnt(0)":::"memory");
    #pragma unroll
    for(int i=0;i<4;++i){const int row=i*8+(lane>>3),ch=lane&7; const u32x4 v=*(const u32x4*)(stg+row*64+ch*8); ATTN_STORE16(Ow+(long)row*OPITCH+ch*8,v);} }
  asm volatile("s_waitcnt lgkmcnt(0)\n\ts_barrier":::"memory");
  #undef DMA_K
  #undef DMA_V
  #undef CMASK
  #undef START
  #undef RESC
  #undef ROT
}
#undef SBAR
#undef WAIT_BAR
}
namespace cg = cooperative_groups;
#define LAS __attribute__((address_space(3)))
typedef unsigned short bf16;
typedef unsigned v4u __attribute__((ext_vector_type(4)));
typedef unsigned v2u __attribute__((ext_vector_type(2)));
typedef float f32x4 __attribute__((ext_vector_type(4)));
constexpr int NWAVES = 8, NTHR = 512;
constexpr int DMODEL = 1024, NBATCH = 16, SEQ = 4096, CTX = 256, MXR = NBATCH * SEQ, MCR = NBATCH * CTX, MTR = MXR + MCR;
constexpr int NIN = 1536, DFF = 2816, NGU = 5632, KVL = SEQ + CTX, INW = 1280, MODW_ = 6144;
constexpr size_t MiB = 1u << 20;
constexpr size_t WS_MOD = 0, WS_WIN = 1 * MiB, WS_WOUT = 7 * MiB, WS_WGU = 11 * MiB, WS_WDN = 33 * MiB, WS_TRIG = 44 * MiB, WS_TRIGC = 108 * MiB,
                 WS_CX = 109 * MiB, WS_KP = 125 * MiB, WS_VP = 142 * MiB, WS_HX = 159 * MiB, WS_Z = 295 * MiB, WS_PQT = 431 * MiB, WS_PQTC = 495 * MiB,
                 WS_QP = 499 * MiB, WS_MX = 567 * MiB, WS_H = 295 * MiB, WS_XS = 703 * MiB, WS_PQF = 839 * MiB, WS_PQFC = 871 * MiB, WS_END = 873 * MiB, WS_CTL = 896 * 1024, CTL_BYTES = 16384;
static_assert(WS_H + (size_t)MTR * DFF * 2 <= WS_END && WS_MX + (size_t)MTR * 1024 * 2 <= WS_END && WS_KP + (size_t)NBATCH * KVL * 128 * 2 <= WS_VP, "ws map");
constexpr int LDS_BYTES = 147456;
constexpr float QSCALE = 0.125f * 1.4426950408889634f;

struct P { const float *x, *c, *ctx, *c_ctx, *w_ada, *b_ada, *g_mix, *g_ffn, *w_in, *q_gain, *k_gain, *w_pool, *pool_scale, *w_four, *w_out, *w_gate_up, *w_down; float* out; unsigned char* ws; };

__device__ __forceinline__ unsigned f2bf(float f) { unsigned u = __builtin_bit_cast(unsigned, f); return (u + 0x7fffu + ((u >> 16) & 1u)) >> 16; }
__device__ __forceinline__ unsigned pk2(float lo, float hi) { return f2bf(lo) | (f2bf(hi) << 16); }
__device__ __forceinline__ float bf2f(unsigned short h) { return __builtin_bit_cast(float, (unsigned)h << 16); }
__device__ __forceinline__ float wave_sum(float v) {
#pragma unroll
    for (int o = 1; o < 64; o <<= 1) v += __shfl_xor(v, o);
    return v;
}

__device__ __forceinline__ void p0_mod(const P& p, LAS unsigned char* lds, int tid, int wave, int lane) {
    LAS float* sc = (LAS float*)lds;
    LAS float* red = (LAS float*)(lds + 69632);
    float* MOD = (float*)(p.ws + WS_MOD);
    if ((int)blockIdx.x >= 192) return;
    for (int i = tid; i < 17 * 1024; i += NTHR) { const int r = i >> 10, k = i & 1023; const float v = r < 16 ? p.c[r * 1024 + k] : p.c_ctx[k]; sc[i] = v / (1.0f + __expf(-v)); }
    __syncthreads();
    for (int it = blockIdx.x; it < 192; it += gridDim.x) {
        const int layer = it / 96, n0 = (it % 96) * 64;
        float acc[17];
#pragma unroll
        for (int r = 0; r < 17; ++r) acc[r] = 0.f;
        const float* W = p.w_ada + ((size_t)layer * 1024 + wave * 128) * MODW_ + n0 + lane;
        for (int kc = 0; kc < 128; kc += 16) { float wv[16];
#pragma unroll
            for (int j = 0; j < 16; ++j) wv[j] = W[(size_t)(kc + j) * MODW_];
#pragma unroll
            for (int j = 0; j < 16; ++j)
#pragma unroll
                for (int r = 0; r < 17; ++r) acc[r] += sc[r * 1024 + wave * 128 + kc + j] * wv[j]; }
#pragma unroll
        for (int r = 0; r < 17; ++r) red[(wave * 17 + r) * 64 + lane] = acc[r];
        __syncthreads();
        for (int i = tid; i < 17 * 64; i += NTHR) { const int r = i >> 6, l = i & 63; float s = p.b_ada[layer * MODW_ + n0 + l];
#pragma unroll
            for (int w = 0; w < 8; ++w) s += red[(w * 17 + r) * 64 + l];
            MOD[((size_t)layer * 17 + r) * MODW_ + n0 + l] = s; }
        __syncthreads();
    }
}
__device__ __forceinline__ void p0_comp(const P& p, LAS unsigned char* lds, int tid) {
    LAS float* M2 = (LAS float*)lds;
    LAS float* tile = (LAS float*)(lds + 16384);
    for (int it = (int)gridDim.x - 1 - (int)blockIdx.x; it < 192; it += gridDim.x) {
        const int kc = it & 7, g = (it >> 3) & 3, ty = (it >> 5) % 3, layer = it / 96;
        const int k0 = kc * 128;
        LAS float* wfs = (LAS float*)(lds + 49664);
        if (ty != 0) { for (int i = tid; i < 4096; i += NTHR) wfs[i] = p.w_four[(size_t)(layer * 4 + g) * 4096 + i]; __syncthreads(); }
        for (int i = tid; i < 4096; i += NTHR) { const int c = i >> 6, d = i & 63; float v;
            if (ty == 0) v = p.w_pool[((size_t)(layer * 4 + g) * 64 + c) * 64 + d] * p.pool_scale[layer * 256 + g * 64 + d];
            else { v = 0.f;
#pragma unroll 8
                for (int m = 0; m < 64; ++m) { const float rev = (float)((m * c) & 63) * (1.0f / 64.0f); const float t = ty == 1 ? __builtin_amdgcn_cosf(rev) : __builtin_amdgcn_sinf(rev); v += t * wfs[m * 64 + d]; } }
            M2[i] = v; }
        const int srccol = (ty == 0 ? 768 : 1024) + g * 64;
        for (int i = tid; i < 128 * 64; i += NTHR) { const int kk = i >> 6, c = i & 63; tile[kk * 65 + c] = p.w_in[((size_t)layer * 1024 + k0 + kk) * INW + srccol + c]; }
        __syncthreads();
        { const int d = tid & 63, kg = tid >> 6;
          bf16* dst = (bf16*)(p.ws + WS_WIN) + ((size_t)layer * NIN + 768 + ty * 256 + g * 64 + d) * 1024 + k0 + kg * 16;
          float o[16];
#pragma unroll
          for (int j = 0; j < 16; ++j) o[j] = 0.f;
          for (int c = 0; c < 64; ++c) { const float mv = M2[c * 64 + d];
#pragma unroll
              for (int j = 0; j < 16; ++j) o[j] += tile[(kg * 16 + j) * 65 + c] * mv; }
          v4u w0, w1; w0.x = pk2(o[0], o[1]); w0.y = pk2(o[2], o[3]); w0.z = pk2(o[4], o[5]); w0.w = pk2(o[6], o[7]);
          w1.x = pk2(o[8], o[9]); w1.y = pk2(o[10], o[11]); w1.z = pk2(o[12], o[13]); w1.w = pk2(o[14], o[15]);
          *(v4u*)dst = w0; *(v4u*)(dst + 8) = w1; }
        __syncthreads();
    }
}
__device__ __forceinline__ void tr_item(const float* W, int ldw, int c0, int k0, bf16* WT, int K, int r0, LAS float* scr, int lane) {
#pragma unroll 8
    for (int i = 0; i < 32; ++i) { const int kk = 2 * i + (lane >> 5); scr[kk * 33 + (lane & 31)] = W[(size_t)(k0 + kk) * ldw + c0 + (lane & 31)]; }
    asm volatile("s_waitcnt lgkmcnt(0)" ::: "memory");
    const int c = lane & 7;
#pragma unroll
    for (int j = 0; j < 4; ++j) { const int n = (lane >> 3) + 8 * j; const LAS float* s = scr + (8 * c) * 33 + n;
        v4u o; o.x = pk2(s[0 * 33], s[1 * 33]); o.y = pk2(s[2 * 33], s[3 * 33]); o.z = pk2(s[4 * 33], s[5 * 33]); o.w = pk2(s[6 * 33], s[7 * 33]);
        *(v4u*)(WT + (size_t)(r0 + n) * K + k0 + 8 * c) = o; }
    asm volatile("s_waitcnt lgkmcnt(0)" ::: "memory");
}
__device__ __forceinline__ void p0_transposes(const P& p, LAS unsigned char* lds, int wave, int lane) {
    LAS float* scr = (LAS float*)(lds + wave * 16384);
    const int gw = blockIdx.x * NWAVES + wave, NGW = gridDim.x * NWAVES;
    constexpr int I_IN = 24 * 16, I_OUT = 32 * 16, I_GU = 176 * 16, I_DN = 32 * 44, I_L = I_IN + I_OUT + I_GU + I_DN;
    for (int it = gw; it < 2 * I_L; it += NGW) {
        const int layer = it / I_L; int r = it % I_L;
        if (r < I_IN) { const int nb = r % 24, kb = r / 24; tr_item(p.w_in + (size_t)layer * 1024 * INW, INW, nb * 32, kb * 64, (bf16*)(p.ws + WS_WIN) + (size_t)layer * NIN * 1024, 1024, (nb >> 3) * 256 + 128 * (nb & 1) + 32 * ((nb & 7) >> 1), scr, lane); continue; } r -= I_IN;
        if (r < I_OUT) { const int nb = r % 32, kb = r / 32; tr_item(p.w_out + (size_t)layer * 1024 * 1024, 1024, nb * 32, kb * 64, (bf16*)(p.ws + WS_WOUT) + (size_t)layer * 1024 * 1024, 1024, nb * 32, scr, lane); continue; } r -= I_OUT;
        if (r < I_GU) { const int nb = r % 176, kb = r / 176; const int n0 = nb * 32; const int j = n0 < DFF ? n0 : n0 - DFF; const int drow = (j >> 7) * 256 + (n0 < DFF ? 0 : 128) + (j & 127);
            tr_item(p.w_gate_up + (size_t)layer * 1024 * NGU, NGU, n0, kb * 64, (bf16*)(p.ws + WS_WGU) + (size_t)layer * NGU * 1024, 1024, drow, scr, lane); continue; } r -= I_GU;
        { const int nb = r % 32, kb = r / 32; tr_item(p.w_down + (size_t)layer * DFF * 1024, 1024, nb * 32, kb * 64, (bf16*)(p.ws + WS_WDN) + (size_t)layer * 1024 * DFF, DFF, nb * 32, scr, lane); }
    }
}
__device__ __forceinline__ void p0_trig(const P& p, int tid) {
    const int gt = blockIdx.x * NTHR + tid, NGT = gridDim.x * NTHR;
    bf16* T = (bf16*)(p.ws + WS_TRIG);
    for (int it = gt; it < 4096 * 512; it += NGT) { const int k = it >> 9, c8 = (it & 511) * 8;
        float v[8];
#pragma unroll
        for (int jj = 0; jj < 8; ++jj) { const int j = c8 + jj; const bool isS = j > 2048; const int l = isS ? j - 2048 : j; const float rev = (float)((k * l) & 4095) * (1.0f / 4096.0f); v[jj] = isS ? -__builtin_amdgcn_sinf(rev) : __builtin_amdgcn_cosf(rev); }
        v4u w; w.x = pk2(v[0], v[1]); w.y = pk2(v[2], v[3]); w.z = pk2(v[4], v[5]); w.w = pk2(v[6], v[7]);
        *(v4u*)(T + (size_t)k * 4096 + c8) = w; }
    bf16* TC = (bf16*)(p.ws + WS_TRIGC);
    for (int it = gt; it < 256 * 32; it += NGT) { const int k = it >> 5, c8 = (it & 31) * 8;
        float v[8];
#pragma unroll
        for (int jj = 0; jj < 8; ++jj) { const int j = c8 + jj; const bool isS = j > 128; const int l = isS ? j - 128 : j; const float rev = (float)((k * l) & 255) * (1.0f / 256.0f); v[jj] = isS ? -__builtin_amdgcn_sinf(rev) : __builtin_amdgcn_cosf(rev); }
        v4u w; w.x = pk2(v[0], v[1]); w.y = pk2(v[2], v[3]); w.z = pk2(v[4], v[5]); w.w = pk2(v[6], v[7]);
        *(v4u*)(TC + (size_t)k * 256 + c8) = w; }
}
__device__ __forceinline__ void norm_phase(const float* sx, const float* scx, int nrows, const float* g, const float* modl, int shift_chunk, int scale_chunk, bf16* HX, int wave, int lane) {
    constexpr int R = 2;
    const int gw = blockIdx.x * NWAVES + wave, NGW = gridDim.x * NWAVES;
    f32x4 gm[4];
#pragma unroll
    for (int j = 0; j < 4; ++j) gm[j] = *(const f32x4*)(g + 256 * j + 4 * lane);
    for (int m0 = gw * R; m0 < nrows; m0 += NGW * R) {
        f32x4 v[R][4];
#pragma unroll
        for (int e = 0; e < R; ++e) { const int m = m0 + e; const float* xrow = m < MXR ? sx + (size_t)m * 1024 : scx + (size_t)(m - MXR) * 1024;
#pragma unroll
            for (int j = 0; j < 4; ++j) v[e][j] = *(const f32x4*)(xrow + 256 * j + 4 * lane); }
#pragma unroll
        for (int e = 0; e < R; ++e) { const int m = m0 + e; const float* md = modl + (size_t)(m < MXR ? (m >> 12) : 16) * MODW_;
            float s = 0.f;
#pragma unroll
            for (int j = 0; j < 4; ++j) s += (v[e][j].x * v[e][j].x + v[e][j].y * v[e][j].y) + (v[e][j].z * v[e][j].z + v[e][j].w * v[e][j].w);
            const float rstd = 1.0f / sqrtf(wave_sum(s) * (1.0f / 1024.0f) + 1e-6f);
#pragma unroll
            for (int j = 0; j < 4; ++j) { const f32x4 scv = *(const f32x4*)(md + scale_chunk * 1024 + 256 * j + 4 * lane), shv = *(const f32x4*)(md + shift_chunk * 1024 + 256 * j + 4 * lane);
                const f32x4 y = v[e][j] * rstd * gm[j] * (scv + 1.0f) + shv;
                v2u w; w.x = pk2(y.x, y.y); w.y = pk2(y.z, y.w);
                *(v2u*)(HX + (size_t)m * 1024 + 256 * j + 4 * lane) = w; } }
    }
}
__device__ __forceinline__ void norm_phase_bf16(const bf16* XS, int nrows, const float* g, const float* modl, int shift_chunk, int scale_chunk, bf16* HX, int wave, int lane) {
    constexpr int R = 4;
    const int gw = blockIdx.x * NWAVES + wave, NGW = gridDim.x * NWAVES;
    f32x4 gm[4];
#pragma unroll
    for (int j = 0; j < 4; ++j) gm[j] = *(const f32x4*)(g + 16 * lane + 4 * j);
    for (int m0 = gw * R; m0 < nrows; m0 += NGW * R) {
        v4u ra[R][2];
#pragma unroll
        for (int e = 0; e < R; ++e) { const bf16* xr = XS + (size_t)(m0 + e) * 1024 + lane * 16; ra[e][0] = *(const v4u*)xr; ra[e][1] = *(const v4u*)(xr + 8); }
#pragma unroll
        for (int e = 0; e < R; ++e) { const int m = m0 + e; const float* md = modl + (size_t)(m < MXR ? (m >> 12) : 16) * MODW_;
            const v4u r0 = ra[e][0], r1 = ra[e][1];
            f32x4 v[4];
            v[0] = (f32x4){__builtin_bit_cast(float, r0.x << 16), __builtin_bit_cast(float, r0.x & 0xffff0000u), __builtin_bit_cast(float, r0.y << 16), __builtin_bit_cast(float, r0.y & 0xffff0000u)};
            v[1] = (f32x4){__builtin_bit_cast(float, r0.z << 16), __builtin_bit_cast(float, r0.z & 0xffff0000u), __builtin_bit_cast(float, r0.w << 16), __builtin_bit_cast(float, r0.w & 0xffff0000u)};
            v[2] = (f32x4){__builtin_bit_cast(float, r1.x << 16), __builtin_bit_cast(float, r1.x & 0xffff0000u), __builtin_bit_cast(float, r1.y << 16), __builtin_bit_cast(float, r1.y & 0xffff0000u)};
            v[3] = (f32x4){__builtin_bit_cast(float, r1.z << 16), __builtin_bit_cast(float, r1.z & 0xffff0000u), __builtin_bit_cast(float, r1.w << 16), __builtin_bit_cast(float, r1.w & 0xffff0000u)};
            float s = 0.f;
#pragma unroll
            for (int j = 0; j < 4; ++j) s += (v[j].x * v[j].x + v[j].y * v[j].y) + (v[j].z * v[j].z + v[j].w * v[j].w);
            const float rstd = 1.0f / sqrtf(wave_sum(s) * (1.0f / 1024.0f) + 1e-6f);
            unsigned o[8];
#pragma unroll
            for (int j = 0; j < 4; ++j) { const f32x4 scv = *(const f32x4*)(md + scale_chunk * 1024 + 16 * lane + 4 * j), shv = *(const f32x4*)(md + shift_chunk * 1024 + 16 * lane + 4 * j);
                const f32x4 y = v[j] * rstd * gm[j] * (scv + 1.0f) + shv; o[2 * j] = pk2(y.x, y.y); o[2 * j + 1] = pk2(y.z, y.w); }
            bf16* hp = HX + (size_t)m * 1024 + lane * 16;
            *(v4u*)hp = (v4u){o[0], o[1], o[2], o[3]}; *(v4u*)(hp + 8) = (v4u){o[4], o[5], o[6], o[7]}; }
    }
}
__device__ __forceinline__ void prep_phase(const P& p, int layer, LAS unsigned char* lds, int tid, int wave, int lane, int cu, int ncu) {
    const bf16* Z = (const bf16*)(p.ws + WS_Z); bf16* MX = (bf16*)(p.ws + WS_MX);
    const int gw = cu * NWAVES + wave, NGW = ncu * NWAVES;
    { const int nrows = layer == 0 ? MTR : MXR;
      for (int it = gw; it < nrows / 4; it += NGW) {
        const int m = it * 4 + (lane >> 4), c = lane & 15;
        const bool isx = m < MXR;
        const int t = isx ? (m & 4095) : ((m - MXR) & 255), L = isx ? SEQ : CTX;
        const int w = 2 << (c >> 2);
        int lo = t - (w >> 1); if (lo < 0) lo = 0; int hi = t + w - (w >> 1); if (hi > L) hi = L;
        const bf16* zb = Z + (size_t)(m - t) * 1024 + 768 + c * 16;
        float a[16];
#pragma unroll
        for (int f = 0; f < 16; ++f) a[f] = 0.f;
        float sv[16];
        { const v4u q0 = *(const v4u*)(zb + (size_t)t * 1024), q1 = *(const v4u*)(zb + (size_t)t * 1024 + 8);
          const unsigned ww[8] = {q0.x, q0.y, q0.z, q0.w, q1.x, q1.y, q1.z, q1.w};
#pragma unroll
          for (int j = 0; j < 8; ++j) { sv[2 * j] = __builtin_bit_cast(float, ww[j] << 16); sv[2 * j + 1] = __builtin_bit_cast(float, ww[j] & 0xffff0000u); } }
#pragma unroll
        for (int ib = 0; ib < 16; ib += 8) { v4u q0[8], q1[8];
#pragma unroll
            for (int i = 0; i < 8; ++i) { int tt = lo + ib + i; if (tt > hi - 1) tt = hi - 1; q0[i] = *(const v4u*)(zb + (size_t)tt * 1024); q1[i] = *(const v4u*)(zb + (size_t)tt * 1024 + 8); }
#pragma unroll
            for (int i = 0; i < 8; ++i) { const float wgt = (lo + ib + i < hi) ? 1.0f : 0.0f;
                const unsigned ww[8] = {q0[i].x, q0[i].y, q0[i].z, q0[i].w, q1[i].x, q1[i].y, q1[i].z, q1[i].w};
#pragma unroll
                for (int j = 0; j < 8; ++j) { a[2 * j] += wgt * __builtin_bit_cast(float, ww[j] << 16); a[2 * j + 1] += wgt * __builtin_bit_cast(float, ww[j] & 0xffff0000u); } } }
        const float inv = 1.0f / (float)(hi - lo);
        v4u w0, w1;
        w0.x = pk2(a[0] * inv - sv[0], a[1] * inv - sv[1]); w0.y = pk2(a[2] * inv - sv[2], a[3] * inv - sv[3]); w0.z = pk2(a[4] * inv - sv[4], a[5] * inv - sv[5]); w0.w = pk2(a[6] * inv - sv[6], a[7] * inv - sv[7]);
        w1.x = pk2(a[8] * inv - sv[8], a[9] * inv - sv[9]); w1.y = pk2(a[10] * inv - sv[10], a[11] * inv - sv[11]); w1.z = pk2(a[12] * inv - sv[12], a[13] * inv - sv[13]); w1.w = pk2(a[14] * inv - sv[14], a[15] * inv - sv[15]);
        bf16* o = MX + (size_t)m * 1024 + 512 + c * 16; *(v4u*)o = w0; *(v4u*)(o + 8) = w1;
      } }
    __syncthreads();
    { LAS unsigned short* row = (LAS unsigned short*)(lds + wave * 16384);
      const bf16* PQT = (const bf16*)(p.ws + WS_PQT); const bf16* PQTC = (const bf16*)(p.ws + WS_PQTC); bf16* PQF = (bf16*)(p.ws + WS_PQF); bf16* PQFC = (bf16*)(p.ws + WS_PQFC);
      const int ntot = layer == 0 ? 8192 : 4096;
      for (int it = gw; it < ntot; it += NGW) {
        const bool isx = it < 4096; const int n = isx ? it : it - 4096, L = isx ? SEQ : CTX, H2 = L >> 1;
        const bf16* src = isx ? PQT + (size_t)n * 8192 : PQTC + (size_t)n * 512;
        bf16* dst = isx ? PQF + (size_t)n * 4096 : PQFC + (size_t)n * 256;
        for (int c = lane; c < L / 4; c += 64) *(LAS v4u*)(row + c * 8) = *(const v4u*)(src + c * 8);
        asm volatile("s_waitcnt vmcnt(0) lgkmcnt(0)" ::: "memory");
        for (int c = lane; c < L / 8; c += 64) { const int j0 = c * 8; float o[8];
#pragma unroll
            for (int jj = 0; jj < 8; ++jj) { const int j = j0 + jj; const bool lowh = j <= H2; const int l = j - H2;
                const int ia = lowh ? j : L + l, ib = lowh ? L - j : 2 * L - l;
                const float va = bf2f(row[ia]), vb = bf2f(row[ib]);
                const float sg = lowh ? ((j == 0 || j == H2) ? 0.0f : 1.0f) : -1.0f;
                o[jj] = va + sg * vb; }
            v4u w; w.x = pk2(o[0], o[1]); w.y = pk2(o[2], o[3]); w.z = pk2(o[4], o[5]); w.w = pk2(o[6], o[7]);
            *(v4u*)(dst + j0) = w; }
        asm volatile("s_waitcnt lgkmcnt(0)" ::: "memory");
      } }
    __syncthreads();
}

typedef __attribute__((address_space(1))) unsigned gu32;
#define RLX_AGENT __ATOMIC_RELAXED, __HIP_MEMORY_SCOPE_AGENT
#define XB_TMO      128
#define XB_XCNT(j)  (256  + 64 * (j))
#define XB_XSUB(j)  (1280 + 64 * (j))
#define XB_XGEN(j)  (2304 + 64 * (j))
#define XB_TOP      3328
#define XB_TOPGEN   3392
#define XCD_BAR_WORDS 3456
#define XB_SPIN_CAP (1u << 18)

__device__ __forceinline__ unsigned xb_ld(unsigned* p)              { return __hip_atomic_load(p, __ATOMIC_RELAXED, __HIP_MEMORY_SCOPE_AGENT); }
__device__ __forceinline__ unsigned xb_add(unsigned* p, unsigned v) { return __hip_atomic_fetch_add(p, v, __ATOMIC_RELAXED, __HIP_MEMORY_SCOPE_AGENT); }
__device__ __forceinline__ unsigned xb_xcc_id() { return (unsigned)__builtin_amdgcn_s_getreg((3 << 11) | 20) & 0xFu; }
#define XB_SPIN(cond, bar) do { unsigned _sp = 0; while (cond) { __builtin_amdgcn_s_sleep(1); \
    if ((++_sp & 255u) == 0u) { if (xb_ld(&(bar)[XB_TMO])) break; if (_sp > XB_SPIN_CAP) { atomicAdd(&(bar)[XB_TMO], 1u); break; } } } } while (0)

struct XcdBarrier {
    unsigned* bar; unsigned x;
    volatile LAS unsigned* st;
};

__device__ __forceinline__ XcdBarrier xcd_barrier_post(unsigned* bar, volatile LAS unsigned* st) {
    XcdBarrier b; b.bar = bar; b.x = xb_xcc_id(); b.st = st;
    if (threadIdx.x == 0) (void)xb_add(&bar[XB_XCNT(b.x)], 1u);
    return b;
}
__device__ __forceinline__ void xcd_barrier_complete(unsigned* bar, unsigned x, unsigned& nloc, unsigned& nx) {
    const unsigned G = gridDim.x * gridDim.y * gridDim.z;
    unsigned sum, cnt, mine, sp = 0u;
    for (;;) {
        sum = 0u; cnt = 0u; mine = 0u;
#pragma unroll
        for (unsigned j = 0; j < 16; ++j) { const unsigned c = xb_ld(&bar[XB_XCNT(j)]); sum += c; cnt += (c > 0u) ? 1u : 0u; mine = (j == x) ? c : mine; }
        if (sum == G) break;
        __builtin_amdgcn_s_sleep(1);
        if ((++sp & 255u) == 0u) { if (xb_ld(&bar[XB_TMO])) break; if (sp > XB_SPIN_CAP) { atomicAdd(&bar[XB_TMO], 1u); break; } }
    }
    nloc = mine > 0u ? mine : 1u; nx = cnt > 0u ? cnt : 1u;
}

__device__ __forceinline__ void xcd_barrier(const XcdBarrier& b) {
    asm volatile("s_waitcnt vmcnt(0)" ::: "memory");
    __syncthreads();
    if (threadIdx.x == 0) {
        unsigned* bar = b.bar;
        __builtin_amdgcn_s_waitcnt(0);
        unsigned nloc = b.st[0], nx = b.st[1];
        if (nloc == 0u) { xcd_barrier_complete(bar, b.x, nloc, nx); b.st[0] = nloc; b.st[1] = nx; }
        const unsigned old = xb_add(&bar[XB_XSUB(b.x)], 1u);
        const unsigned gen = old / nloc;
        if (old + 1u == (gen + 1u) * nloc) {
            __builtin_amdgcn_fence(__ATOMIC_RELEASE, "agent");
            asm volatile("s_waitcnt vmcnt(0)" ::: "memory");
            const unsigned og = xb_add(&bar[XB_TOP], 1u);
            const unsigned tg = og / nx;
            if (og + 1u == (tg + 1u) * nx) xb_add(&bar[XB_TOPGEN], 1u);
            else XB_SPIN(xb_ld(&bar[XB_TOPGEN]) == tg, bar);
            __builtin_amdgcn_fence(__ATOMIC_ACQUIRE, "agent");
            xb_add(&bar[XB_XGEN(b.x)], 1u);
            asm volatile("s_waitcnt vmcnt(0)" ::: "memory");
        } else {
            XB_SPIN(xb_ld(&bar[XB_XGEN(b.x)]) == gen, bar);
            __builtin_amdgcn_fence(__ATOMIC_ACQUIRE, "agent");
            asm volatile("s_waitcnt vmcnt(0)" ::: "memory");
        }
    }
    __syncthreads();
}

__global__ void __launch_bounds__(NTHR, 2) mk_fwd(P p) {
    extern __shared__ __attribute__((aligned(16))) unsigned char lds_raw[];
    LAS unsigned char* lds = (LAS unsigned char*)lds_raw;
    cg::grid_group grid = cg::this_grid();
    if (p.ws == nullptr) grid.sync();
    volatile LAS unsigned* bst = (volatile LAS unsigned*)(lds + 131072 + 64);
    if (threadIdx.x < 2) bst[threadIdx.x] = 0u;
    __syncthreads();
    const XcdBarrier xbar = xcd_barrier_post((unsigned*)(p.ws + WS_CTL), bst);
#define GRID_SYNC() xcd_barrier(xbar)
#define FRESH_IDS() int tid = threadIdx.x; asm volatile("" : "+v"(tid)); const int lane = tid & 63, wave = __builtin_amdgcn_readfirstlane(tid >> 6); int bx = blockIdx.x; asm volatile("" : "+s"(bx)); \
    const int vcu = (G % 8 == 0) ? (bx % 8) * (G / 8) + bx / 8 : bx; (void)lane; (void)wave; (void)vcu
    const int G = gridDim.x;
    unsigned char* ws = p.ws;
    float* MOD = (float*)(ws + WS_MOD);
    bf16* HX = (bf16*)(ws + WS_HX); bf16* Zb = (bf16*)(ws + WS_Z); bf16* MXb = (bf16*)(ws + WS_MX); bf16* Hb = (bf16*)(ws + WS_H);
    bf16* PQT = (bf16*)(ws + WS_PQT); bf16* PQTC = (bf16*)(ws + WS_PQTC); bf16* XS = (bf16*)(ws + WS_XS);
    const attn_body::bf16* QPb = (const attn_body::bf16*)(ws + WS_QP); const attn_body::bf16* KPb = (const attn_body::bf16*)(ws + WS_KP); const attn_body::bf16* VPb = (const attn_body::bf16*)(ws + WS_VP);

    LAS float* ropeT = (LAS float*)(lds + 131072 + 1024);
    for (int i = threadIdx.x; i < 1024; i += NTHR) { const int pos = i >> 4, f = i & 15; const float fr = expf(-(float)f * (1.0f / 16.0f) * 9.210340371976184f); const float a = (float)pos * fr; float rev = a * 0.15915494309189535f; rev -= floorf(rev);
        ropeT[i] = __builtin_amdgcn_cosf(rev); ropeT[1024 + i] = __builtin_amdgcn_sinf(rev); }
    __syncthreads();
    { FRESH_IDS();
    p0_mod(p, lds, tid, wave, lane);
    __syncthreads();
    p0_comp(p, lds, tid);
    __syncthreads();
    p0_transposes(p, lds, wave, lane);
    p0_trig(p, tid); }
    GRID_SYNC();

    for (int layer = 0; layer < 2; ++layer) {
        const bool upd = layer == 0;
        const float* modl = MOD + (size_t)layer * 17 * MODW_;
        const bf16* WIN = (const bf16*)(ws + WS_WIN) + (size_t)layer * NIN * 1024;
        const bf16* WOUT = (const bf16*)(ws + WS_WOUT) + (size_t)layer * 1024 * 1024;
        const bf16* WGU = (const bf16*)(ws + WS_WGU) + (size_t)layer * NGU * 1024;
        const bf16* WDN = (const bf16*)(ws + WS_WDN) + (size_t)layer * 1024 * DFF;
        { FRESH_IDS(); if (layer == 0) norm_phase(p.x, p.ctx, MTR, p.g_mix, modl, 0, 1, HX, wave, lane); else norm_phase_bf16(XS, MTR, p.g_mix + 1024, modl, 0, 1, HX, wave, lane); }
        GRID_SYNC();
        { FRESH_IDS();
            pg8::EpiIn E{Zb, PQT, PQTC, 0, 0, (bf16*)(ws + WS_QP), (bf16*)(ws + WS_KP), (bf16*)(ws + WS_VP), p.q_gain + layer * 64, p.k_gain + layer * 64, ropeT, QSCALE};
            if (upd) { pg8::Gemm g{HX, WIN, MTR, NIN, 1024}; pg8::StaticOrder S; S.init(MTR, NIN, G, bx); pg8::gemm_phase<pg8::EpiIn, pg8::StaticOrder, true, true>(lds, g, S, E); }
            else {
                { pg8::Gemm g{HX, WIN, MXR, NIN, 1024}; pg8::StaticOrder S; S.init(MXR, NIN, G, bx); pg8::gemm_phase<pg8::EpiIn, pg8::StaticOrder, true, true>(lds, g, S, E); }
            }
        }
        GRID_SYNC();
        { FRESH_IDS();
          const int ngemm = upd ? 0 : 16;
          if (bx >= G - ngemm) { pg8::EpiIn E2{Zb, PQT, PQTC, MXR, 512, (bf16*)(ws + WS_QP), (bf16*)(ws + WS_KP), (bf16*)(ws + WS_VP), p.q_gain + layer * 64, p.k_gain + layer * 64, ropeT, QSCALE};
              pg8::Gemm g{HX + (size_t)MXR * 1024, WIN + (size_t)512 * 1024, MCR, 256, 1024}; pg8::StaticOrder S; S.init(MCR, 256, G, G - 1 - bx);
              pg8::gemm_phase<pg8::EpiIn, pg8::StaticOrder, true, true>(lds, g, S, E2); }
          else prep_phase(p, layer, lds, tid, wave, lane, bx, G - ngemm); }
        GRID_SYNC();
        { FRESH_IDS();
            for (int i = 0; i < (2048 + G - 1) / G; ++i) { const int pu = i * G + vcu; if (pu >= 2048) break;
                const int bg = pu >> 6, u = pu & 63, b = bg >> 1, gk = bg & 1, h = gk * 4 + (u >> 4), qb = u & 15;
                const size_t qrow = (size_t)b * SEQ + qb * 256;
                attn_body::attn_unit<8>(QPb + qrow * 512 + h * 64, KPb + (size_t)b * KVL * 128 + gk * 64, VPb + (size_t)b * KVL * 128 + gk * 64,
                                        (attn_body::bf16*)MXb + qrow * 1024 + h * 64, KVL / 64, (char*)lds_raw); }
            if (upd) for (int cu = vcu; cu < 128; cu += G) { const int b = cu >> 3, h = cu & 7, gk = h >> 2; const size_t qrow = (size_t)MXR + b * CTX;
                attn_body::attn_unit<8>(QPb + qrow * 512 + h * 64, KPb + (size_t)b * KVL * 128 + gk * 64, VPb + (size_t)b * KVL * 128 + gk * 64,
                                        (attn_body::bf16*)MXb + qrow * 1024 + h * 64, CTX / 64, (char*)lds_raw); }
            { pg8::Gemm g{(const bf16*)(ws + WS_TRIG), (const bf16*)(ws + WS_PQF), SEQ, 4096, SEQ}; pg8::StaticOrder S; S.init(SEQ, 4096, G, bx); pg8::EpiFour E{MXb, 0, SEQ, 1.0f / 512.0f};
              pg8::gemm_phase<pg8::EpiFour, pg8::StaticOrder, true, true>(lds, g, S, E); }
            if (upd) { pg8::Gemm g{(const bf16*)(ws + WS_TRIGC), (const bf16*)(ws + WS_PQFC), CTX, 4096, CTX}; pg8::StaticOrder S; S.init(CTX, 4096, G, G - 1 - bx); pg8::EpiFour E{MXb, MXR, CTX, 1.0f / 128.0f};
              pg8::gemm_phase<pg8::EpiFour, pg8::StaticOrder, true, true>(lds, g, S, E); }
        }
        GRID_SYNC();
        { FRESH_IDS(); const int M = upd ? MTR : MXR; pg8::Gemm g{MXb, WOUT, M, 1024, 1024}; pg8::StaticOrder S; S.init(M, 1024, G, bx); pg8::EpiRes E{layer == 0 ? p.x : (const float*)nullptr, p.ctx, XS, XS, (float*)nullptr, modl + 2 * 1024};
          pg8::gemm_phase<pg8::EpiRes, pg8::StaticOrder, true, true>(lds, g, S, E); }
        GRID_SYNC();
        { FRESH_IDS(); norm_phase_bf16(XS, upd ? MTR : MXR, p.g_ffn + layer * 1024, modl, 3, 4, HX, wave, lane); }
        GRID_SYNC();
        { FRESH_IDS(); const int M = upd ? MTR : MXR; pg8::Gemm g{HX, WGU, M, NGU, 1024}; pg8::StaticOrder S; S.init(M, NGU, G, bx); pg8::EpiSwiglu E{Hb};
          pg8::gemm_phase<pg8::EpiSwiglu, pg8::StaticOrder, true, true>(lds, g, S, E); }
        GRID_SYNC();
        { FRESH_IDS(); const int M = upd ? MTR : MXR; pg8::Gemm g{Hb, WDN, M, 1024, DFF}; pg8::StaticOrder S; S.init(M, 1024, G, bx); pg8::EpiRes E{(const float*)nullptr, (const float*)nullptr, XS, upd ? XS : (bf16*)nullptr, p.out, modl + 5 * 1024};
          pg8::gemm_phase<pg8::EpiRes, pg8::StaticOrder, true, true>(lds, g, S, E); }
        if (layer == 0) GRID_SYNC();
    }
}

extern "C" void kernel_launch(void* const* d_in, const int* in_sizes, int n_in, void* d_out, int out_size, void* d_ws, size_t ws_size, hipStream_t stream) {
    static int grid = 0;
    if (grid == 0) {
        if (n_in != 17 || ws_size < WS_END) { fprintf(stderr, "kernel_launch: unexpected n_in %d / ws %zu\n", n_in, ws_size); grid = -1; return; }
        int dev = 0, cus = 0, per_cu = 0;
        hipGetDevice(&dev); hipDeviceGetAttribute(&cus, hipDeviceAttributeMultiprocessorCount, dev);
        hipFuncSetAttribute((const void*)mk_fwd, hipFuncAttributeMaxDynamicSharedMemorySize, LDS_BYTES);
        hipOccupancyMaxActiveBlocksPerMultiprocessor(&per_cu, (const void*)mk_fwd, NTHR, LDS_BYTES);
        (void)hipGetLastError();
        if (per_cu < 1) per_cu = 1;
        grid = cus * per_cu;
    }
    if (grid < 0) return;
    if (hipMemsetAsync((char*)d_ws + WS_CTL, 0, CTL_BYTES, stream) != hipSuccess) { fprintf(stderr, "memset failed\n"); return; }
    P p{};
    const float** pp = (const float**)&p;
    for (int i = 0; i < 17; ++i) pp[i] = (const float*)d_in[i];
    p.out = (float*)d_out; p.ws = (unsigned char*)d_ws;
    void* args[] = {&p};
    hipError_t e = hipLaunchCooperativeKernel((const void*)mk_fwd, dim3(grid), dim3(NTHR), args, LDS_BYTES, stream);
    if (e != hipSuccess) fprintf(stderr, "cooperative launch failed: %s (grid %d)\n", hipGetErrorString(e), grid);
}
```

```cpp
#include <hip/hip_runtime.h>
#include <hip/hip_bf16.h>
#include <hip/hip_cooperative_groups.h>
#include <cstdio>
#include <cstdint>
#include <cmath>
namespace pg8 {
#define PG8_LAS __attribute__((address_space(3)))
typedef unsigned short bf16_t;
typedef short bf16x8 __attribute__((ext_vector_type(8)));
typedef float f32x4 __attribute__((ext_vector_type(4)));
typedef unsigned u32x4 __attribute__((ext_vector_type(4)));
constexpr int BM = 256, BK = 64, HALF = 128, HTB = HALF * BK * 2  , STAGE_BYTES = 8 * HTB, NXCD = 8, WGM = 8;

__host__ __device__ __forceinline__ int lds_byte(int r, int c) { const int st = (r >> 4) * 2 + (c >> 5), rr = r & 15, cc = c & 31, ob = rr * 64 + cc * 2; return st * 1024 + (ob ^ (((ob >> 9) & 1) << 5)); }
__host__ __device__ __forceinline__ void stage_rc(int b, int& R, int& C) { const int st = b / 1024, sb = b % 1024, swz = sb ^ (((sb >> 9) & 1) << 5); R = (st >> 1) * 16 + swz / 64; C = (st & 1) * 32 + (swz % 64) / 2; }
__host__ __device__ __forceinline__ int perm32(int rho) { const int n = rho >> 4, i = rho & 15; return 8 * (i >> 2) + 4 * n + (i & 3); }

struct Unit { int pm, pn; };
struct Gemm { const bf16_t* A; const bf16_t* Bt; int M, N, K; };

struct StaticOrder {
    int nM, nN, nwg, G, c;
    __host__ __device__ void init(int M, int N, int G_, int c_) { nM = M / BM; nN = N / BM; nwg = nM * nN; G = G_; c = c_; }
    __host__ __device__ bool next(int i, Unit& u) const {
        const long L = (long)i * G + c; if (L >= nwg) return false;
        int wgid = (int)L; { const int q = nwg / NXCD, r = nwg % NXCD, xcd = wgid % NXCD, off = wgid / NXCD; wgid = (xcd < r ? xcd * (q + 1) : r * (q + 1) + (xcd - r) * q) + off; }
        const int nig = WGM * nN, gid = wgid / nig, fm = gid * WGM, gsz = (nM - fm) < WGM ? (nM - fm) : WGM;
        u.pm = fm + ((wgid % nig) % gsz); u.pn = (wgid % nig) / gsz; return true;
    }
    __device__ __forceinline__ void a_ready(const Unit&) const {}
    __device__ __forceinline__ void done(const Unit&) const {}
};

__device__ __forceinline__ unsigned cvt_pk_bf16(float lo, float hi) { unsigned r; asm volatile("v_cvt_pk_bf16_f32 %0, %1, %2" : "=v"(r) : "v"(lo), "v"(hi)); return r; }
typedef float f32x2 __attribute__((ext_vector_type(2)));
__device__ __forceinline__ float shx_(float v, int o, int lane) { return __builtin_bit_cast(float, __builtin_amdgcn_ds_bpermute((lane ^ o) << 2, __builtin_bit_cast(int, v))); }
constexpr int XROWS = 65536, CTXL = 256, SEQL = 4096, MODW = 6144;
struct EpiIn {
    static constexpr bool PERM = true, AFTER_DRAIN = false;
    bf16_t* Z; bf16_t* PQt; bf16_t* PQtc; int row_off, col_off;
    bf16_t* QP; bf16_t* KP; bf16_t* VP; const float* qg; const float* kg; const PG8_LAS float* rope; float qscale;
    __device__ __forceinline__ void operator()(const f32x4 (&acc)[2][2][4][2], const Unit& u, int wr, int wc, int fr, int fq) const {
        asm volatile("" : "+v"(fr), "+v"(fq));
        const int gr0 = row_off + u.pm * BM, ct = (col_off >> 8) + u.pn;
        if (ct < 3) {
            const bool isx = gr0 < XROWS, isv = (ct == 2) && (wc >= 2), isq = ct < 2;
            f32x4 gn[2][2];
            { const float* gp = (isq ? qg : kg) + 8 * fq;
#pragma unroll
              for (int bj = 0; bj < 2; ++bj)
#pragma unroll
                  for (int n = 0; n < 2; ++n) gn[bj][n] = *(const f32x4*)(gp + 32 * bj + 4 * n); }
            const float osc = isq ? qscale : 1.0f;
            const int half = fq >> 1, f0 = 8 * (fq & 1);
#pragma unroll
            for (int ai = 0; ai < 2; ++ai)
#pragma unroll
                for (int m = 0; m < 4; ++m) {
                    const int grow = gr0 + ai * HALF + wr * 64 + m * 16 + fr;
                    const int b = isx ? (grow >> 12) : ((grow - XROWS) >> 8), t = isx ? (grow & 4095) : ((grow - XROWS) & 255);
                    const size_t kvrow = (size_t)b * (SEQL + CTXL) + (isx ? CTXL + t : t);
                    if (isv) {
#pragma unroll
                        for (int bj = 0; bj < 2; ++bj) { const f32x4 v0 = acc[ai][bj][m][0], v1 = acc[ai][bj][m][1];
                            u32x4 w; w.x = cvt_pk_bf16(v0[0], v0[1]); w.y = cvt_pk_bf16(v0[2], v0[3]); w.z = cvt_pk_bf16(v1[0], v1[1]); w.w = cvt_pk_bf16(v1[2], v1[3]);
                            *(u32x4*)(VP + kvrow * 128 + (wc - 2) * 64 + 32 * bj + 8 * fq) = w; }
                    } else {
                        float ss = 0.f;
#pragma unroll
                        for (int bj = 0; bj < 2; ++bj)
#pragma unroll
                            for (int n = 0; n < 2; ++n) { const f32x4 v = acc[ai][bj][m][n]; ss += (v[0] * v[0] + v[1] * v[1]) + (v[2] * v[2] + v[3] * v[3]); }
                        ss += shx_(ss, 16, fq * 16 + fr); ss += shx_(ss, 32, fq * 16 + fr);
                        const float rstd = 1.0f / sqrtf(ss * (1.0f / 64.0f) + 1e-6f);
#pragma unroll
                        for (int bj = 0; bj < 2; ++bj) { f32x4 y[2];
#pragma unroll
                            for (int n = 0; n < 2; ++n) y[n] = acc[ai][bj][m][n] * rstd * gn[bj][n];
                            f32x4 pr[2];
#pragma unroll
                            for (int n = 0; n < 2; ++n)
#pragma unroll
                                for (int j = 0; j < 4; ++j) pr[n][j] = shx_(y[n][j], 32, fq * 16 + fr);
                            if (isx) { const int pos = bj == 0 ? (t >> 6) : (t & 63); const PG8_LAS float* cp = rope + pos * 16 + f0;
#pragma unroll
                                for (int n = 0; n < 2; ++n) { const f32x4 c = *(const PG8_LAS f32x4*)(cp + 4 * n), s = *(const PG8_LAS f32x4*)(cp + 1024 + 4 * n);
                                    y[n] = half == 0 ? y[n] * c - pr[n] * s : y[n] * c + pr[n] * s; } }
                            const f32x4 o0 = y[0] * osc, o1 = y[1] * osc;
                            u32x4 w; w.x = cvt_pk_bf16(o0[0], o0[1]); w.y = cvt_pk_bf16(o0[2], o0[3]); w.z = cvt_pk_bf16(o1[0], o1[1]); w.w = cvt_pk_bf16(o1[2], o1[3]);
                            bf16_t* dst = isq ? QP + (size_t)grow * 512 + (ct * 4 + wc) * 64 + 32 * bj + 8 * fq : KP + kvrow * 128 + wc * 64 + 32 * bj + 8 * fq;
                            *(u32x4*)dst = w; }
                    }
                }
        } else if (ct == 3) {
            bf16_t* base = Z + (size_t)(gr0 + wr * 64 + fr) * 1024 + ct * 256 + wc * 32 + 8 * fq;
#pragma unroll
            for (int ai = 0; ai < 2; ++ai)
#pragma unroll
                for (int m = 0; m < 4; ++m) { bf16_t* rowp = base + (size_t)(ai * HALF + m * 16) * 1024;
#pragma unroll
                    for (int bj = 0; bj < 2; ++bj) { const f32x4 v0 = acc[ai][bj][m][0], v1 = acc[ai][bj][m][1];
                        u32x4 w; w.x = cvt_pk_bf16(v0[0], v0[1]); w.y = cvt_pk_bf16(v0[2], v0[3]); w.z = cvt_pk_bf16(v1[0], v1[1]); w.w = cvt_pk_bf16(v1[2], v1[3]);
                        *(u32x4*)(rowp + bj * HALF) = w; } }
        } else {
            const int part = ct - 4; const bool isx = gr0 < XROWS;
            const int b = isx ? (gr0 >> 12) : ((gr0 - XROWS) >> 8);
            const int L = isx ? SEQL : CTXL;
            const int l0 = (isx ? (gr0 & 4095) : 0) + wr * 64 + fr;
            bf16_t* T = isx ? PQt : PQtc;
#pragma unroll
            for (int bj = 0; bj < 2; ++bj)
#pragma unroll
                for (int n = 0; n < 2; ++n)
#pragma unroll
                    for (int j = 0; j < 4; ++j) { const int cc = bj * HALF + wc * 32 + 8 * fq + 4 * n + j;
                        bf16_t* cp = T + ((size_t)((b * 256 + cc) * 2 + part)) * L + l0;
#pragma unroll
                        for (int ai = 0; ai < 2; ++ai)
#pragma unroll
                            for (int m = 0; m < 4; ++m) cp[ai * HALF + m * 16] = (bf16_t)(cvt_pk_bf16(acc[ai][bj][m][n][j], 0.f) & 0xffffu); }
        }
    }
};
struct EpiRes {
    static constexpr bool PERM = true, AFTER_DRAIN = false;
    const float* bx; const float* bc; const bf16_t* bs; bf16_t* os; float* of; const float* gate;
    __device__ __forceinline__ void operator()(const f32x4 (&acc)[2][2][4][2], const Unit& u, int wr, int wc, int fr, int fq) const {
        asm volatile("" : "+v"(fr), "+v"(fq));
        const bool isx = u.pm < 256;
        const float* gt = gate + (size_t)(isx ? (u.pm >> 4) : 16) * MODW;
        const int col0 = u.pn * BM + wc * 32 + 8 * fq;
        f32x4 gv[2][2];
#pragma unroll
        for (int bj = 0; bj < 2; ++bj)
#pragma unroll
            for (int n = 0; n < 2; ++n) gv[bj][n] = *(const f32x4*)(gt + col0 + bj * HALF + 4 * n);
        const bool bf32 = bx != nullptr, obf = os != nullptr;
#pragma unroll
        for (int ai = 0; ai < 2; ++ai)
#pragma unroll
            for (int m = 0; m < 4; ++m) { const size_t grow = (size_t)u.pm * BM + ai * HALF + wr * 64 + m * 16 + fr;
#pragma unroll
                for (int bj = 0; bj < 2; ++bj) { const size_t off = grow * 1024 + col0 + bj * HALF; f32x4 b0, b1;
                    if (bf32) { const float* bp = isx ? bx + off : bc + (off - (size_t)XROWS * 1024); b0 = *(const f32x4*)bp; b1 = *(const f32x4*)(bp + 4); }
                    else { const u32x4 w = *(const u32x4*)(bs + off);
                        b0 = (f32x4){__builtin_bit_cast(float, w.x << 16), __builtin_bit_cast(float, w.x & 0xffff0000u), __builtin_bit_cast(float, w.y << 16), __builtin_bit_cast(float, w.y & 0xffff0000u)};
                        b1 = (f32x4){__builtin_bit_cast(float, w.z << 16), __builtin_bit_cast(float, w.z & 0xffff0000u), __builtin_bit_cast(float, w.w << 16), __builtin_bit_cast(float, w.w & 0xffff0000u)}; }
                    const f32x4 o0 = b0 + gv[bj][0] * acc[ai][bj][m][0], o1 = b1 + gv[bj][1] * acc[ai][bj][m][1];
                    if (obf) { u32x4 w; w.x = cvt_pk_bf16(o0[0], o0[1]); w.y = cvt_pk_bf16(o0[2], o0[3]); w.z = cvt_pk_bf16(o1[0], o1[1]); w.w = cvt_pk_bf16(o1[2], o1[3]); *(u32x4*)(os + off) = w; }
                    else { *(f32x4*)(of + off) = o0; *(f32x4*)(of + off + 4) = o1; } } }
    }
};
struct EpiSwiglu {
    static constexpr bool PERM = true, AFTER_DRAIN = false;
    bf16_t* H;
    __device__ __forceinline__ void operator()(const f32x4 (&acc)[2][2][4][2], const Unit& u, int wr, int wc, int fr, int fq) const {
        asm volatile("" : "+v"(fr), "+v"(fq));
        bf16_t* base = H + (size_t)(u.pm * BM + wr * 64 + fr) * 2816 + u.pn * HALF + wc * 32 + 8 * fq;
#pragma unroll
        for (int ai = 0; ai < 2; ++ai)
#pragma unroll
            for (int m = 0; m < 4; ++m) { float r[8];
#pragma unroll
                for (int n = 0; n < 2; ++n)
#pragma unroll
                    for (int j = 0; j < 4; ++j) { const float g = acc[ai][0][m][n][j], up = acc[ai][1][m][n][j];
                        r[n * 4 + j] = g * __builtin_amdgcn_rcpf(1.0f + __builtin_amdgcn_exp2f(-1.4426950408889634f * g)) * up; }
                u32x4 w; w.x = cvt_pk_bf16(r[0], r[1]); w.y = cvt_pk_bf16(r[2], r[3]); w.z = cvt_pk_bf16(r[4], r[5]); w.w = cvt_pk_bf16(r[6], r[7]);
                *(u32x4*)(base + (size_t)(ai * HALF + m * 16) * 2816) = w; }
    }
};
struct EpiFour {
    static constexpr bool PERM = true, AFTER_DRAIN = false;
    bf16_t* MX; int rowbase, L; float scale;
    __device__ __forceinline__ void operator()(const f32x4 (&acc)[2][2][4][2], const Unit& u, int wr, int wc, int fr, int fq) const {
        asm volatile("" : "+v"(fr), "+v"(fq));
        bf16_t* base = MX + (size_t)(rowbase + u.pn * L + u.pm * BM + wr * 64 + fr) * 1024 + 768 + wc * 32 + 8 * fq;
#pragma unroll
        for (int ai = 0; ai < 2; ++ai)
#pragma unroll
            for (int m = 0; m < 4; ++m) { bf16_t* rowp = base + (size_t)(ai * HALF + m * 16) * 1024;
#pragma unroll
                for (int bj = 0; bj < 2; ++bj) { const f32x4 v0 = acc[ai][bj][m][0] * scale, v1 = acc[ai][bj][m][1] * scale;
                    u32x4 w; w.x = cvt_pk_bf16(v0[0], v0[1]); w.y = cvt_pk_bf16(v0[2], v0[3]); w.z = cvt_pk_bf16(v1[0], v1[1]); w.w = cvt_pk_bf16(v1[2], v1[3]);
                    *(u32x4*)(rowp + bj * HALF) = w; } }
    }
};
template <class Epi, class Sched, bool ALIGN_EPI = false, bool SP2 = false>
__device__ __forceinline__ void gemm_phase(PG8_LAS unsigned char* lds, const Gemm g, const Sched& S, const Epi& E) {
    int tid_l = threadIdx.x; asm volatile("" : "+v"(tid_l)); const int tid = tid_l, wid = __builtin_amdgcn_readfirstlane(tid >> 6), lane = tid & 63, wr = wid >> 2, wc = wid & 3, fr = lane & 15, fq = lane >> 4;
    const int K = g.K, nt = K / BK;
    unsigned voffA[2], voffB[2];
#pragma unroll
    for (int i = 0; i < 2; ++i) { int R, C; stage_rc(tid * 16 + i * 8192, R, C); const int Rb = Epi::PERM ? ((R & ~31) + perm32(R & 31)) : R;
        voffA[i] = (unsigned)(R * K + C) * 2u; voffB[i] = (unsigned)(Rb * K + C) * 2u; }
    const size_t kstep = (size_t)(BK * 2);
    const size_t hstep = (size_t)HALF * K * 2;
    const size_t tstep = 2 * hstep;
    const unsigned ldsw = (unsigned)wid * 1024u;
    const int aoff = lds_byte(wr * 64 + fr, fq * 8), boff = lds_byte(wc * 32 + fr, fq * 8);
#define PG8_SA(b, h) (((b) * 2 + (h)) * HTB)
#define PG8_SB(b, h) ((4 + (b) * 2 + (h)) * HTB)
#define PG8_STAGE(bufoff, gbase, voff) do { _Pragma("unroll") for (int _i = 0; _i < 2; ++_i) \
        __builtin_amdgcn_global_load_lds((const unsigned*)((const char*)(gbase) + (voff)[_i]), (PG8_LAS unsigned*)(lds + (bufoff) + ldsw + _i * 8192), 16, 0, 0); } while (0)
#define PG8_LDA(dst, b, h) do { _Pragma("unroll") for (int m = 0; m < 4; ++m) _Pragma("unroll") for (int k = 0; k < 2; ++k) dst[m][k] = *(const PG8_LAS bf16x8*)(lds + PG8_SA(b, h) + aoff + m * 2048 + k * 1024); } while (0)
#define PG8_LDB(dst, b, h) do { _Pragma("unroll") for (int n = 0; n < 2; ++n) _Pragma("unroll") for (int k = 0; k < 2; ++k) dst[n][k] = *(const PG8_LAS bf16x8*)(lds + PG8_SB(b, h) + boff + n * 2048 + k * 1024); } while (0)
#define PG8_MMA(ai, bj, At, Bt) do { __builtin_amdgcn_s_setprio(1); _Pragma("unroll") for (int m = 0; m < 4; ++m) _Pragma("unroll") for (int n = 0; n < 2; ++n) _Pragma("unroll") for (int k = 0; k < 2; ++k) \
        acc[ai][bj][m][n] = __builtin_amdgcn_mfma_f32_16x16x32_bf16(Bt[n][k], At[m][k], acc[ai][bj][m][n], 0, 0, 0); __builtin_amdgcn_s_setprio(0); } while (0)
#define PG8_WAIT_V(n) asm volatile("s_waitcnt vmcnt(" #n ")" ::: "memory")
#define PG8_WAIT_L(n) asm volatile("s_waitcnt lgkmcnt(" #n ")" ::: "memory")
#define PG8_BAR __builtin_amdgcn_s_barrier()
#define PG8_SCHED __builtin_amdgcn_sched_barrier(0)
    Unit cur, nxt; int ui = 0;
    if (!S.next(0, cur)) return;
    f32x4 acc[2][2][4][2];
#pragma unroll
    for (int a = 0; a < 2; ++a)
#pragma unroll
        for (int b = 0; b < 2; ++b)
#pragma unroll
            for (int m = 0; m < 4; ++m)
#pragma unroll
                for (int n = 0; n < 2; ++n) acc[a][b][m][n] = (f32x4){0.f, 0.f, 0.f, 0.f};
    bf16x8 At[4][2], B0[2][2], B1[2][2];
    const char* cA = (const char*)g.A + (size_t)cur.pm * tstep; const char* cB = (const char*)g.Bt + (size_t)cur.pn * tstep;
    S.a_ready(cur);
    if constexpr (SP2) {
        PG8_STAGE(PG8_SB(0, 0), cB, voffB); PG8_STAGE(PG8_SB(0, 1), cB + hstep, voffB); PG8_STAGE(PG8_SA(0, 0), cA, voffA); PG8_STAGE(PG8_SA(0, 1), cA + hstep, voffA);
        if (wr == 1) PG8_BAR;
        PG8_WAIT_V(2); PG8_BAR;
        PG8_STAGE(PG8_SB(1, 0), cB + kstep, voffB); PG8_STAGE(PG8_SA(1, 0), cA + kstep, voffA); PG8_STAGE(PG8_SB(1, 1), cB + hstep + kstep, voffB);
        PG8_WAIT_V(6); PG8_BAR;
    } else {
        PG8_STAGE(PG8_SB(0, 0), cB, voffB); PG8_STAGE(PG8_SA(0, 0), cA, voffA); PG8_STAGE(PG8_SB(0, 1), cB + hstep, voffB); PG8_STAGE(PG8_SA(0, 1), cA + hstep, voffA);
        if (wr == 1) PG8_BAR;
        PG8_WAIT_V(4); PG8_BAR;
        PG8_STAGE(PG8_SB(1, 0), cB + kstep, voffB); PG8_STAGE(PG8_SA(1, 0), cA + kstep, voffA); PG8_STAGE(PG8_SB(1, 1), cB + hstep + kstep, voffB);
        PG8_WAIT_V(6); PG8_BAR;
    }
    for (;;) {
        const bool has_next = S.next(ui + 1, nxt);
        const char* nA = has_next ? (const char*)g.A + (size_t)nxt.pm * tstep : cA; const char* nB = has_next ? (const char*)g.Bt + (size_t)nxt.pn * tstep : cB;
        for (int t = 0; t < nt; t += 2) {
            const bool last = (t == nt - 2);
            const char* a1 = cA + (size_t)(t + 1) * kstep;
            const char* a2 = last ? nA : cA + (size_t)(t + 2) * kstep; const char* b2 = last ? nB : cB + (size_t)(t + 2) * kstep;
            const char* a3 = a2 + kstep; const char* b3 = b2 + kstep;
            if (last && has_next) S.a_ready(nxt);
            if constexpr (SP2) {
            PG8_LDB(B0, 0, 0); PG8_LDB(B1, 0, 1); PG8_SCHED; PG8_LDA(At, 0, 0); PG8_STAGE(PG8_SA(1, 1), a1 + hstep, voffA);
            PG8_WAIT_V(8); PG8_WAIT_L(0); PG8_BAR; PG8_MMA(0, 0, At, B0); PG8_MMA(0, 1, At, B1); PG8_BAR; PG8_SCHED;
            PG8_LDA(At, 0, 1); PG8_STAGE(PG8_SB(0, 0), b2, voffB); PG8_STAGE(PG8_SB(0, 1), b2 + hstep, voffB); PG8_STAGE(PG8_SA(0, 0), a2, voffA);
            PG8_WAIT_V(8); PG8_WAIT_L(0); PG8_BAR; PG8_MMA(1, 0, At, B0); PG8_MMA(1, 1, At, B1); PG8_BAR; PG8_SCHED;
            PG8_LDB(B0, 1, 0); PG8_LDB(B1, 1, 1); PG8_SCHED; PG8_LDA(At, 1, 0); PG8_STAGE(PG8_SA(0, 1), a2 + hstep, voffA);
            PG8_WAIT_V(8); PG8_WAIT_L(0); PG8_BAR; PG8_MMA(0, 0, At, B0); PG8_MMA(0, 1, At, B1); PG8_BAR; PG8_SCHED;
            PG8_LDA(At, 1, 1); PG8_STAGE(PG8_SB(1, 0), b3, voffB); PG8_STAGE(PG8_SB(1, 1), b3 + hstep, voffB); PG8_STAGE(PG8_SA(1, 0), a3, voffA);
            PG8_WAIT_V(8); PG8_WAIT_L(0); PG8_BAR; PG8_MMA(1, 0, At, B0); PG8_MMA(1, 1, At, B1); PG8_BAR; PG8_SCHED;
            } else {
            PG8_LDB(B0, 0, 0); PG8_SCHED; PG8_LDA(At, 0, 0); PG8_STAGE(PG8_SA(1, 1), a1 + hstep, voffA);
            PG8_WAIT_L(8); PG8_BAR; PG8_WAIT_L(0); PG8_MMA(0, 0, At, B0); PG8_BAR; PG8_SCHED;
            PG8_LDB(B1, 0, 1); PG8_STAGE(PG8_SB(0, 0), b2, voffB);
            PG8_BAR; PG8_WAIT_L(0); PG8_MMA(0, 1, At, B1); PG8_BAR;
            PG8_LDA(At, 0, 1); PG8_STAGE(PG8_SA(0, 0), a2, voffA);
            PG8_BAR; PG8_WAIT_L(0); PG8_MMA(1, 0, At, B0); PG8_BAR; PG8_SCHED;
            PG8_STAGE(PG8_SB(0, 1), b2 + hstep, voffB);
            PG8_WAIT_V(6); PG8_BAR; PG8_MMA(1, 1, At, B1); PG8_BAR;
            PG8_LDB(B0, 1, 0); PG8_SCHED; PG8_LDA(At, 1, 0); PG8_STAGE(PG8_SA(0, 1), a2 + hstep, voffA);
            PG8_WAIT_L(8); PG8_BAR; PG8_WAIT_L(0); PG8_MMA(0, 0, At, B0); PG8_BAR; PG8_SCHED;
            PG8_LDB(B1, 1, 1); PG8_STAGE(PG8_SB(1, 0), b3, voffB);
            PG8_BAR; PG8_WAIT_L(0); PG8_MMA(0, 1, At, B1); PG8_BAR;
            PG8_LDA(At, 1, 1); PG8_STAGE(PG8_SA(1, 0), a3, voffA);
            PG8_BAR; PG8_WAIT_L(0); PG8_MMA(1, 0, At, B0); PG8_BAR; PG8_SCHED;
            PG8_STAGE(PG8_SB(1, 1), b3 + hstep, voffB);
            PG8_WAIT_V(6); PG8_BAR; PG8_MMA(1, 1, At, B1); PG8_BAR;
            }
        }
        if constexpr (ALIGN_EPI) { if (wr == 0) PG8_BAR; }
        if constexpr (!Epi::AFTER_DRAIN) { E(acc, cur, wr, wc, fr, fq); S.done(cur); }
        if (!has_next) break;
#pragma unroll
        for (int a = 0; a < 2; ++a)
#pragma unroll
            for (int b = 0; b < 2; ++b)
#pragma unroll
                for (int m = 0; m < 4; ++m)
#pragma unroll
                    for (int n = 0; n < 2; ++n) acc[a][b][m][n] = (f32x4){0.f, 0.f, 0.f, 0.f};
        cur = nxt; cA = nA; cB = nB; ++ui;
        if constexpr (ALIGN_EPI) { if (wr == 1) PG8_BAR; }
    }
    PG8_WAIT_V(0);
    if constexpr (!ALIGN_EPI) { if (wr == 0) PG8_BAR; }
    PG8_BAR;
    if constexpr (Epi::AFTER_DRAIN) { E.fused(acc, cur, wr, wc, fr, fq, lds, wid, lane); S.done(cur); }
#undef PG8_SA
#undef PG8_SB
#undef PG8_STAGE
#undef PG8_LDA
#undef PG8_LDB
#undef PG8_MMA
#undef PG8_WAIT_V
#undef PG8_WAIT_L
#undef PG8_BAR
#undef PG8_SCHED
}
}
namespace attn_body {
using bf16=__hip_bfloat16;
using bf16x8=__attribute__((ext_vector_type(8)))short;
using s16x4=__attribute__((ext_vector_type(4)))short;
using f32x16=__attribute__((ext_vector_type(16)))float;
using u32x4=__attribute__((ext_vector_type(4)))unsigned;
constexpr int D=64,QPITCH=512,KVPITCH=128,OPITCH=1024;
constexpr int NW=8,QBLK=32,QB=QBLK*NW,KVBLK=64;

__device__ __forceinline__ int crow(int r,int hi){return (r&3)+8*(r>>2)+4*hi;}
#define SBAR() __builtin_amdgcn_sched_barrier(0)
__device__ __forceinline__ void cmask(f32x16&p0,f32x16&p1,int jb,int qrel,int hi){
  const float NEG=-INFINITY; int kb=64*jb+4*hi;
  #pragma unroll
  for(int r=0;r<16;++r){int kv=kb+(r&3)+8*(r>>2); if(kv>qrel)p0[r]=NEG; if(kv+32>qrel)p1[r]=NEG;}
}

constexpr int NSLOT=3, SLOTB=8192;
constexpr int LDS_K=0, LDS_V=NSLOT*SLOTB, LDS_WS=2*NSLOT*SLOTB, LDS_OST=LDS_WS+NW*64*4, LDS_BYTES=LDS_OST+NW*4096;
constexpr float C2=0.125f*1.4426950408889634f;
__device__ __forceinline__ void glds16(const void*gsrc,unsigned lds_dst){unsigned keep;
  asm volatile("s_mov_b32 %0, m0\n\ts_mov_b32 m0, %2\n\ts_nop 0\n\tglobal_load_lds_dwordx4 %1, off\n\ts_mov_b32 m0, %0":"=&s"(keep):"v"(gsrc),"s"(lds_dst):"memory");}
__device__ __forceinline__ float max3f(float a,float b,float c){float r;asm("v_max3_f32 %0, %1, %2, %3":"=v"(r):"v"(a),"v"(b),"v"(c));return r;}
__device__ __forceinline__ float max2f(float a,float b){float r;asm("v_max_f32_e32 %0, %1, %2":"=v"(r):"v"(a),"v"(b));return r;}
__device__ __forceinline__ float fadd_s(float a,float b){float r;asm("v_add_f32_e32 %0, %1, %2":"=v"(r):"v"(a),"v"(b));return r;}
__device__ __forceinline__ float fsub_s(float a,float b){float r;asm("v_sub_f32_e32 %0, %1, %2":"=v"(r):"v"(a),"v"(b));return r;}
typedef float f32x2_t __attribute__((ext_vector_type(2))); typedef __bf16 bf16x2_t __attribute__((ext_vector_type(2)));
__device__ __forceinline__ unsigned cvtpk_s(float lo,float hi){f32x2_t v={lo,hi};bf16x2_t b=__builtin_convertvector(v,bf16x2_t);return __builtin_bit_cast(unsigned,b);}
#define WAIT_BAR(N) asm volatile("s_waitcnt vmcnt(" #N ") lgkmcnt(0)\n\ts_barrier":::"memory")

__device__ __forceinline__ void qkt(f32x16&p0,f32x16&p1,const char*Kslot,const bf16x8*qr,const f32x16&negm,int r32,int hi){
  const char*kb=Kslot+hi*1024+r32*16;
  #pragma unroll
  for(int d0=0;d0<4;++d0){
    const bf16x8 b0=*reinterpret_cast<const bf16x8*>(kb+d0*2048);
    const bf16x8 b1=*reinterpret_cast<const bf16x8*>(kb+d0*2048+512);
    if(d0==0){p0=__builtin_amdgcn_mfma_f32_32x32x16_bf16(b0,qr[0],negm,0,0,0);p1=__builtin_amdgcn_mfma_f32_32x32x16_bf16(b1,qr[0],negm,0,0,0);}
    else{p0=__builtin_amdgcn_mfma_f32_32x32x16_bf16(b0,qr[d0],p0,0,0,0);p1=__builtin_amdgcn_mfma_f32_32x32x16_bf16(b1,qr[d0],p1,0,0,0);}}
}
typedef __attribute__((address_space(3))) const char* lds_cptr;
typedef short v4i16_t __attribute__((ext_vector_type(4)));
__device__ __forceinline__ void kload8(bf16x8*kf,lds_cptr kp){
  kf[0]=*(const __attribute__((address_space(3))) bf16x8*)(kp);      kf[1]=*(const __attribute__((address_space(3))) bf16x8*)(kp+512);
  kf[2]=*(const __attribute__((address_space(3))) bf16x8*)(kp+2048); kf[3]=*(const __attribute__((address_space(3))) bf16x8*)(kp+2560);
  kf[4]=*(const __attribute__((address_space(3))) bf16x8*)(kp+4096); kf[5]=*(const __attribute__((address_space(3))) bf16x8*)(kp+4608);
  kf[6]=*(const __attribute__((address_space(3))) bf16x8*)(kp+6144); kf[7]=*(const __attribute__((address_space(3))) bf16x8*)(kp+6656);
}
__device__ __forceinline__ void kload2(bf16x8*kf,lds_cptr kp,int j){ kf[2*j]=*(const __attribute__((address_space(3))) bf16x8*)(kp+j*2048); kf[2*j+1]=*(const __attribute__((address_space(3))) bf16x8*)(kp+j*2048+512); }
__device__ __forceinline__ s16x4 vtr(lds_cptr p){ return __builtin_bit_cast(s16x4,__builtin_amdgcn_ds_read_tr16_b64_v4i16((__attribute__((address_space(3))) v4i16_t*)p)); }
__device__ __forceinline__ float rowmax(const f32x16&p0,const f32x16&p1){
  float a=max3f(p0[0],p0[1],p1[0]),b=max3f(p0[2],p0[3],p1[1]);a=max3f(a,p1[2],p1[3]);
  #pragma unroll
  for(int r=4;r<16;r+=4){a=max3f(a,p0[r],p0[r+1]);b=max3f(b,p0[r+2],p0[r+3]);a=max3f(a,p1[r],p1[r+1]);b=max3f(b,p1[r+2],p1[r+3]);}
  const float m=max2f(a,b);
  auto rr=__builtin_amdgcn_permlane32_swap(__float_as_uint(m),__float_as_uint(m),false,false);
  return max2f(__uint_as_float(rr[0]),__uint_as_float(rr[1]));
}
__device__ __forceinline__ void pv(f32x16*o,int vb,bf16x8 pa0,bf16x8 pa1,bf16x8 pa2,bf16x8 pa3){
  #pragma unroll
  for(int d0=0;d0<2;++d0){s16x4 lo[4],hi[4];
    #pragma unroll
    for(int ks=0;ks<4;++ks){
      asm volatile("ds_read_b64_tr_b16 %0,%1 offset:%c2":"=&v"(lo[ks]):"v"(vb),"i"(d0*4096+ks*1024):"memory");
      asm volatile("ds_read_b64_tr_b16 %0,%1 offset:%c2":"=&v"(hi[ks]):"v"(vb),"i"(d0*4096+ks*1024+512):"memory");}
    asm volatile("s_waitcnt lgkmcnt(0)":::"memory");SBAR();
    #define PK(k) (bf16x8){lo[k][0],lo[k][1],lo[k][2],lo[k][3],hi[k][0],hi[k][1],hi[k][2],hi[k][3]}
    o[d0]=__builtin_amdgcn_mfma_f32_32x32x16_bf16(pa0,PK(0),o[d0],0,0,0);
    o[d0]=__builtin_amdgcn_mfma_f32_32x32x16_bf16(pa1,PK(1),o[d0],0,0,0);
    o[d0]=__builtin_amdgcn_mfma_f32_32x32x16_bf16(pa2,PK(2),o[d0],0,0,0);
    o[d0]=__builtin_amdgcn_mfma_f32_32x32x16_bf16(pa3,PK(3),o[d0],0,0,0);
    #undef PK
  }
}

#ifndef ATTN_STORE16
#define ATTN_STORE16(p,v) (*(u32x4*)(p)=(v))
#endif
template<int THRL> __device__ __forceinline__ void attn_unit(const bf16*Qu,const bf16*__restrict__ Kh,const bf16*__restrict__ Vh,bf16*Ou,const int NT,char*shm){
  int tid_l=threadIdx.x; asm volatile("":"+v"(tid_l)); const int tid=tid_l,lane=tid&63,r32=lane&31,hi=lane>>5; const int wid=__builtin_amdgcn_readfirstlane(tid>>6);
  const bf16*Qw=Qu+(long)(wid*QBLK)*QPITCH;
  const unsigned lds0=(unsigned)(uintptr_t)shm;
  float*wsf=(float*)(shm+LDS_WS)+wid*64;
  const bf16*ksrc=Kh+(long)lane*KVPITCH+wid*8;
  const bf16*vsrc=Vh+(long)(16*(wid&3)+(lane>>2))*KVPITCH+(wid>>2)*32+(lane&3)*8;
  const unsigned kdst=lds0+LDS_K+wid*1024, vdst=lds0+LDS_V+wid*1024;
  #define DMA_K(t,slot) glds16(ksrc+(long)(t)*KVBLK*KVPITCH,(unsigned)__builtin_amdgcn_readfirstlane(kdst+(slot)))
  #define DMA_V(t,slot) glds16(vsrc+(long)(t)*KVBLK*KVPITCH,(unsigned)__builtin_amdgcn_readfirstlane(vdst+(slot)))
  const int vb0=(int)(lds0+LDS_V)+((lane>>4)&1)*32+(lane&3)*8+(4*hi+((lane&15)>>2))*64;
  const char*Kbase=shm+LDS_K; bf16x8 kf[8];
  const lds_cptr shm3=(lds_cptr)shm; const lds_cptr kp0=shm3+LDS_K+hi*1024+r32*16; const lds_cptr vp0=shm3+LDS_V+((lane>>4)&1)*32+(lane&3)*8+(4*hi+((lane&15)>>2))*64;
  DMA_K(0,0);DMA_V(0,0);DMA_K(1,SLOTB);
  bf16x8 qr[4];
  #pragma unroll
  for(int d0=0;d0<4;++d0)qr[d0]=*reinterpret_cast<const bf16x8*>(&Qw[(long)r32*QPITCH+d0*16+hi*8]);
  float mhat=0.f,l_reg=0.f;f32x16 o[2];o[0]=f32x16{};o[1]=f32x16{};f32x16 negm=f32x16{};asm volatile("":"+v"(negm));
  #define CMASK(P0,P1,t) do{}while(0)
  bool resc=false;
  #define START(P0,P1) do{ const float rm=rowmax(P0,P1); resc=false; \
    { const float dl=rm; mhat=fadd_s(mhat,dl); \
      _Pragma("unroll") for(int r=0;r<16;++r){P0[r]=fsub_s(P0[r],dl);P1[r]=fsub_s(P1[r],dl);} \
      _Pragma("unroll") for(int r=0;r<16;++r)negm[r]=-mhat; asm volatile("":"+v"(negm)); } \
    _Pragma("unroll") for(int r=0;r<16;++r)P0[r]=__builtin_amdgcn_exp2f(P0[r]); }while(0)
  #define RESC() do{ if(resc){ asm volatile("s_waitcnt lgkmcnt(0)":::"memory"); \
      _Pragma("unroll") for(int d_=0;d_<2;++d_) _Pragma("unroll") for(int r=0;r<16;++r)o[d_][r]*=wsf[crow(r,hi)]; } }while(0)
  f32x16 pA0,pA1,pB0,pB1;
  int sl_prev=0,sl_cur=0,sl_next=SLOTB;
  #define ROT() do{sl_prev=sl_cur;sl_cur=sl_next;sl_next=(sl_next==(NSLOT-1)*SLOTB)?0:sl_next+SLOTB;}while(0)
  DMA_K(2,2*SLOTB);
  WAIT_BAR(3);
  qkt(pA0,pA1,Kbase,qr,negm,r32,hi);asm volatile("s_nop 15\n\ts_nop 7":"+v"(pA0),"+v"(pA1));CMASK(pA0,pA1,0);
  START(pA0,pA1);
  _Pragma("unroll") for(int r=0;r<16;++r)pA1[r]=__builtin_amdgcn_exp2f(pA1[r]);
  WAIT_BAR(0);
  DMA_K(3,0);DMA_V(1,SLOTB);
  ROT();
  kload8(kf,kp0+sl_cur);
  WAIT_BAR(2);
  s16x4 vlo[8],vhi[8]; u32x4 pw0,pw1,pw2,pw3;
  #define PKW(P,B) cvtpk_s(P[B],P[B+1])
  #define PAF(k) __builtin_bit_cast(bf16x8,pw##k)
  #define VFR(i) (bf16x8){vlo[i][0],vlo[i][1],vlo[i][2],vlo[i][3],vhi[i][0],vhi[i][1],vhi[i][2],vhi[i][3]}
  #define PIN(x) asm volatile("":"+v"(x))
  #define MX3(a,b,c) __builtin_fmaxf(__builtin_fmaxf((a),(b)),(c))
  #define GAPA(MF,A0,A1,A2,A3,W0,W1,PW) do{ MF; sacc+=A0; sacc+=A1; sacc+=A2; sacc+=A3; PIN(sacc); W0; W1; PIN(PW); SBAR(); }while(0)
  #define EX(v) __builtin_amdgcn_exp2f(v)
  #define GAPB(MF,X,B) do{ MF; X[B]=EX(X[B]); X[B+1]=EX(X[B+1]); X[B+2]=EX(X[B+2]); X[B+3]=EX(X[B+3]); PIN(X); SBAR(); }while(0)
  #define VRD(i) do{ vlo[i]=vtr(vp_+(((i)>>2)*4096+((i)&3)*1024)); vhi[i]=vtr(vp_+(((i)>>2)*4096+((i)&3)*1024+512)); }while(0)
  #define KRD(G,j) do{ if(G){ kload2(kf,kp0+sl_next,j); SBAR(); } }while(0)
  #define STEP(C0,C1,P0,P1,t,GK,GV,GL) do{ SBAR(); \
    const lds_cptr vp_=vp0+sl_prev; \
    VRD(0); SBAR(); float sacc=(P0[0]+P0[1]); \
    GAPA(C0=__builtin_amdgcn_mfma_f32_32x32x16_bf16(kf[0],qr[0],negm,0,0,0), P0[2],P0[3],P0[4],P0[5],     pw0[0]=PKW(P0,0), pw0[1]=PKW(P0,2), pw0); \
    VRD(4); SBAR(); GAPA(C1=__builtin_amdgcn_mfma_f32_32x32x16_bf16(kf[1],qr[0],negm,0,0,0), P0[6],P0[7],P0[8],P0[9],     pw0[2]=PKW(P0,4), pw0[3]=PKW(P0,6), pw0); \
    VRD(1); SBAR(); GAPA(C0=__builtin_amdgcn_mfma_f32_32x32x16_bf16(kf[2],qr[1],C0,0,0,0),   P0[10],P0[11],P0[12],P0[13], pw1[0]=PKW(P0,8), pw1[1]=PKW(P0,10), pw1); \
    VRD(5); SBAR(); GAPA(C1=__builtin_amdgcn_mfma_f32_32x32x16_bf16(kf[3],qr[1],C1,0,0,0),   P0[14],P0[15],P1[0],P1[1],   pw1[2]=PKW(P0,12),pw1[3]=PKW(P0,14), pw1); \
    VRD(2); SBAR(); GAPA(C0=__builtin_amdgcn_mfma_f32_32x32x16_bf16(kf[4],qr[2],C0,0,0,0),   P1[2],P1[3],P1[4],P1[5],     pw2[0]=PKW(P1,0), pw2[1]=PKW(P1,2), pw2); \
    VRD(6); SBAR(); GAPA(C1=__builtin_amdgcn_mfma_f32_32x32x16_bf16(kf[5],qr[2],C1,0,0,0),   P1[6],P1[7],P1[8],P1[9],     pw2[2]=PKW(P1,4), pw2[3]=PKW(P1,6), pw2); \
    VRD(3); SBAR(); GAPA(C0=__builtin_amdgcn_mfma_f32_32x32x16_bf16(kf[6],qr[3],C0,0,0,0),   P1[10],P1[11],P1[12],P1[13], pw3[0]=PKW(P1,8), pw3[1]=PKW(P1,10), pw3); \
    VRD(7); SBAR(); GAPA(C1=__builtin_amdgcn_mfma_f32_32x32x16_bf16(kf[7],qr[3],C1,0,0,0),   P1[14],P1[15],0.f,0.f,       pw3[2]=PKW(P1,12),pw3[3]=PKW(P1,14), pw3); \
    l_reg+=sacc; \
    if(GK){DMA_K((t)+3,sl_cur);} if(GV){DMA_V((t)+1,sl_next);} \
    CMASK(C0,C1,t); \
    { float a=MX3(C0[0],C0[1],C1[0]),b=MX3(C0[2],C0[3],C1[1]); a=MX3(a,C1[2],C1[3]); \
      _Pragma("unroll") for(int r=4;r<16;r+=4){a=MX3(a,C0[r],C0[r+1]);b=MX3(b,C0[r+2],C0[r+3]);a=MX3(a,C1[r],C1[r+1]);b=MX3(b,C1[r+2],C1[r+3]);} \
      float rm=__builtin_fmaxf(a,b); { auto rr=__builtin_amdgcn_permlane32_swap(__float_as_uint(rm),__float_as_uint(rm),false,false); rm=__builtin_fmaxf(__uint_as_float(rr[0]),__uint_as_float(rr[1])); } \
      resc=false; \
      if(__builtin_expect(__any(rm>(float)THRL),0)){ const float dl=__builtin_fmaxf(rm,0.f); mhat+=dl; \
        _Pragma("unroll") for(int r=0;r<16;++r){C0[r]-=dl;C1[r]-=dl;} \
        _Pragma("unroll") for(int r=0;r<16;++r)negm[r]=-mhat; asm volatile("":"+v"(negm)); \
        const float f=__builtin_amdgcn_exp2f(-dl); l_reg*=f; if(hi==0)wsf[r32]=f; resc=true; } } \
    SBAR(); \
    GAPB(o[0]=__builtin_amdgcn_mfma_f32_32x32x16_bf16(PAF(0),VFR(0),o[0],0,0,0), C0,0); \
    GAPB(o[1]=__builtin_amdgcn_mfma_f32_32x32x16_bf16(PAF(0),VFR(4),o[1],0,0,0), C0,4); \
    KRD(GL,0); GAPB(o[0]=__builtin_amdgcn_mfma_f32_32x32x16_bf16(PAF(1),VFR(1),o[0],0,0,0), C0,8); \
    KRD(GL,1); GAPB(o[1]=__builtin_amdgcn_mfma_f32_32x32x16_bf16(PAF(1),VFR(5),o[1],0,0,0), C0,12); \
    KRD(GL,2); GAPB(o[0]=__builtin_amdgcn_mfma_f32_32x32x16_bf16(PAF(2),VFR(2),o[0],0,0,0), C1,0); \
    KRD(GL,3); GAPB(o[1]=__builtin_amdgcn_mfma_f32_32x32x16_bf16(PAF(2),VFR(6),o[1],0,0,0), C1,4); \
    GAPB(o[0]=__builtin_amdgcn_mfma_f32_32x32x16_bf16(PAF(3),VFR(3),o[0],0,0,0), C1,8); \
    GAPB(o[1]=__builtin_amdgcn_mfma_f32_32x32x16_bf16(PAF(3),VFR(7),o[1],0,0,0), C1,12); \
    }while(0)
  int t=1;
  #undef CMASK
  #define CMASK(P0,P1,t) do{}while(0)
  for(;t+5<NT;t+=2){
    STEP(pB0,pB1,pA0,pA1,t,true,true,true);     WAIT_BAR(2); RESC(); ROT();
    STEP(pA0,pA1,pB0,pB1,t+1,true,true,true);   WAIT_BAR(2); RESC(); ROT();
  }
  #undef CMASK
  #define CMASK(P0,P1,t) do{}while(0)
  #define ENDW(tt) do{ if((tt)+3<NT){WAIT_BAR(2);} else if((tt)+2<NT){WAIT_BAR(1);} else {WAIT_BAR(0);} }while(0)
  for(;t+1<NT;t+=2){
    STEP(pB0,pB1,pA0,pA1,t,(t+3<NT),(t+1<NT),(t+1<NT));       ENDW(t);   RESC(); ROT();
    STEP(pA0,pA1,pB0,pB1,t+1,(t+4<NT),(t+2<NT),(t+2<NT));     ENDW(t+1); RESC(); ROT();
  }
  STEP(pB0,pB1,pA0,pA1,NT-1,false,false,false); RESC();
  { float sacc=pB0[0]+pB0[1]; _Pragma("unroll") for(int r=2;r<16;++r)sacc+=pB0[r]; _Pragma("unroll") for(int r=0;r<16;++r)sacc+=pB1[r]; l_reg+=sacc;
    pw0=(u32x4){PKW(pB0,0),PKW(pB0,2),PKW(pB0,4),PKW(pB0,6)};pw1=(u32x4){PKW(pB0,8),PKW(pB0,10),PKW(pB0,12),PKW(pB0,14)};pw2=(u32x4){PKW(pB1,0),PKW(pB1,2),PKW(pB1,4),PKW(pB1,6)};pw3=(u32x4){PKW(pB1,8),PKW(pB1,10),PKW(pB1,12),PKW(pB1,14)};
    SBAR(); pv(o,vb0+sl_cur,PAF(0),PAF(1),PAF(2),PAF(3)); }
  #undef PKW
  #undef PAF
  #undef VFR
  #undef PIN
  #undef MX3
  #undef GAPA
  #undef GAPB
  #undef EX
  #undef VRD
  #undef KRD
  #undef STEP
  #undef ENDW
  {auto rr=__builtin_amdgcn_permlane32_swap(__float_as_uint(l_reg),__float_as_uint(l_reg),false,false);l_reg=__uint_as_float(rr[0])+__uint_as_float(rr[1]);}
  if(hi==0)wsf[32+r32]=l_reg;asm volatile("s_waitcnt lgkmcnt(0)":::"memory");
  float rli[16];
  #pragma unroll
  for(int r=0;r<16;++r)rli[r]=__builtin_amdgcn_rcpf(wsf[32+crow(r,hi)]);
  bf16*Ow=Ou+(long)(wid*QBLK)*OPITCH;
  { bf16*stg=(bf16*)(shm+LDS_OST)+wid*2048;
    #pragma unroll
    for(int r=0;r<16;++r){const int orow=crow(r,hi);
      #pragma unroll
      for(int d0=0;d0<2;++d0)stg[orow*64+d0*32+r32]=__float2bfloat16(o[d0][r]*rli[r]);}
    asm volatile("s_waitcnt lgkmcnt(0)":::"memory");
    #pragma unroll
    for(int i=0;i<4;++i){const int row=i*8+(lane>>3),ch=lane&7; const u32x4 v=*(const u32x4*)(stg+row*64+ch*8); ATTN_STORE16(Ow+(long)row*OPITCH+ch*8,v);} }
  asm volatile("s_waitcnt lgkmcnt(0)\n\ts_barrier":::"memory");
  #undef DMA_K
  #undef DMA_V
  #undef CMASK
  #undef START
  #undef RESC
  #undef ROT
}
#undef SBAR
#undef WAIT_BAR
}
namespace cg = cooperative_groups;
#define LAS __attribute__((address_space(3)))
typedef unsigned short bf16;
typedef unsigned v4u __attribute__((ext_vector_type(4)));
typedef unsigned v2u __attribute__((ext_vector_type(2)));
typedef float f32x4 __attribute__((ext_vector_type(4)));
constexpr int NWAVES = 8, NTHR = 512;
constexpr int DMODEL = 1024, NBATCH = 16, SEQ = 4096, CTX = 256, MXR = NBATCH * SEQ, MCR = NBATCH * CTX, MTR = MXR + MCR;
constexpr int NIN = 1536, DFF = 2816, NGU = 5632, KVL = SEQ + CTX, INW = 1280, MODW_ = 6144;
constexpr size_t MiB = 1u << 20;
constexpr size_t WS_MOD = 0, WS_WIN = 1 * MiB, WS_WOUT = 7 * MiB, WS_WGU = 11 * MiB, WS_WDN = 33 * MiB, WS_TRIG = 44 * MiB, WS_TRIGC = 108 * MiB,
                 WS_CX = 109 * MiB, WS_KP = 125 * MiB, WS_VP = 142 * MiB, WS_HX = 159 * MiB, WS_Z = 295 * MiB, WS_PQT = 431 * MiB, WS_PQTC = 495 * MiB,
                 WS_QP = 499 * MiB, WS_MX = 567 * MiB, WS_H = 295 * MiB, WS_XS = 703 * MiB, WS_PQF = 839 * MiB, WS_PQFC = 871 * MiB, WS_END = 873 * MiB, WS_CTL = 896 * 1024, CTL_BYTES = 16384;
static_assert(WS_H + (size_t)MTR * DFF * 2 <= WS_END && WS_MX + (size_t)MTR * 1024 * 2 <= WS_END && WS_KP + (size_t)NBATCH * KVL * 128 * 2 <= WS_VP, "ws map");
constexpr int LDS_BYTES = 147456;
constexpr float QSCALE = 0.125f * 1.4426950408889634f;

struct P { const float *x, *c, *ctx, *c_ctx, *w_ada, *b_ada, *g_mix, *g_ffn, *w_in, *q_gain, *k_gain, *w_pool, *pool_scale, *w_four, *w_out, *w_gate_up, *w_down; float* out; unsigned char* ws; };

__device__ __forceinline__ unsigned f2bf(float f) { unsigned u = __builtin_bit_cast(unsigned, f); return (u + 0x7fffu + ((u >> 16) & 1u)) >> 16; }
__device__ __forceinline__ unsigned pk2(float lo, float hi) { return f2bf(lo) | (f2bf(hi) << 16); }
__device__ __forceinline__ float bf2f(unsigned short h) { return __builtin_bit_cast(float, (unsigned)h << 16); }
__device__ __forceinline__ float shx(float v, int o, int lane) { return __builtin_bit_cast(float, __builtin_amdgcn_ds_bpermute((lane ^ o) << 2, __builtin_bit_cast(int, v))); }
__device__ __forceinline__ float wave_sum(float v, int lane) {
    v += shx(v, 1, lane); v += shx(v, 2, lane); v += shx(v, 4, lane); v += shx(v, 8, lane); v += shx(v, 16, lane); v += shx(v, 32, lane);
    return v;
}

__device__ __forceinline__ void p0_mod(const P& p, LAS unsigned char* lds, int tid, int wave, int lane) {
    LAS float* sc = (LAS float*)lds;
    LAS float* red = (LAS float*)(lds + 69632);
    float* MOD = (float*)(p.ws + WS_MOD);
    if ((int)blockIdx.x >= 192) return;
    for (int i = tid; i < 17 * 1024; i += NTHR) { const int r = i >> 10, k = i & 1023; const float v = r < 16 ? p.c[r * 1024 + k] : p.c_ctx[k]; sc[i] = v / (1.0f + __expf(-v)); }
    __syncthreads();
    for (int it = blockIdx.x; it < 192; it += gridDim.x) {
        const int layer = it / 96, n0 = (it % 96) * 64;
        float acc[17];
#pragma unroll
        for (int r = 0; r < 17; ++r) acc[r] = 0.f;
        const float* W = p.w_ada + ((size_t)layer * 1024 + wave * 128) * MODW_ + n0 + lane;
        for (int kc = 0; kc < 128; kc += 16) { float wv[16];
#pragma unroll
            for (int j = 0; j < 16; ++j) wv[j] = W[(size_t)(kc + j) * MODW_];
#pragma unroll
            for (int j = 0; j < 16; ++j)
#pragma unroll
                for (int r = 0; r < 17; ++r) acc[r] += sc[r * 1024 + wave * 128 + kc + j] * wv[j]; }
#pragma unroll
        for (int r = 0; r < 17; ++r) red[(wave * 17 + r) * 64 + lane] = acc[r];
        __syncthreads();
        for (int i = tid; i < 17 * 64; i += NTHR) { const int r = i >> 6, l = i & 63; float s = p.b_ada[layer * MODW_ + n0 + l];
#pragma unroll
            for (int w = 0; w < 8; ++w) s += red[(w * 17 + r) * 64 + l];
            MOD[((size_t)layer * 17 + r) * MODW_ + n0 + l] = s; }
        __syncthreads();
    }
}
__device__ __forceinline__ void p0_comp(const P& p, LAS unsigned char* lds, int tid) {
    LAS float* M2 = (LAS float*)lds;
    LAS float* tile = (LAS float*)(lds + 16384);
    for (int it = (int)gridDim.x - 1 - (int)blockIdx.x; it < 192; it += gridDim.x) {
        const int kc = it & 7, g = (it >> 3) & 3, ty = (it >> 5) % 3, layer = it / 96;
        const int k0 = kc * 128;
        LAS float* wfs = (LAS float*)(lds + 49664);
        if (ty != 0) { for (int i = tid; i < 4096; i += NTHR) wfs[i] = p.w_four[(size_t)(layer * 4 + g) * 4096 + i]; __syncthreads(); }
        for (int i = tid; i < 4096; i += NTHR) { const int c = i >> 6, d = i & 63; float v;
            if (ty == 0) v = p.w_pool[((size_t)(layer * 4 + g) * 64 + c) * 64 + d] * p.pool_scale[layer * 256 + g * 64 + d];
            else { v = 0.f;
#pragma unroll 8
                for (int m = 0; m < 64; ++m) { const float rev = (float)((m * c) & 63) * (1.0f / 64.0f); const float t = ty == 1 ? __builtin_amdgcn_cosf(rev) : __builtin_amdgcn_sinf(rev); v += t * wfs[m * 64 + d]; } }
            M2[i] = v; }
        const int srccol = (ty == 0 ? 768 : 1024) + g * 64;
        for (int i = tid; i < 128 * 64; i += NTHR) { const int kk = i >> 6, c = i & 63; tile[kk * 65 + c] = p.w_in[((size_t)layer * 1024 + k0 + kk) * INW + srccol + c]; }
        __syncthreads();
        { const int d = tid & 63, kg = tid >> 6;
          bf16* dst = (bf16*)(p.ws + WS_WIN) + ((size_t)layer * NIN + 768 + ty * 256 + g * 64 + d) * 1024 + k0 + kg * 16;
          float o[16];
#pragma unroll
          for (int j = 0; j < 16; ++j) o[j] = 0.f;
          for (int c = 0; c < 64; ++c) { const float mv = M2[c * 64 + d];
#pragma unroll
              for (int j = 0; j < 16; ++j) o[j] += tile[(kg * 16 + j) * 65 + c] * mv; }
          v4u w0, w1; w0.x = pk2(o[0], o[1]); w0.y = pk2(o[2], o[3]); w0.z = pk2(o[4], o[5]); w0.w = pk2(o[6], o[7]);
          w1.x = pk2(o[8], o[9]); w1.y = pk2(o[10], o[11]); w1.z = pk2(o[12], o[13]); w1.w = pk2(o[14], o[15]);
          *(v4u*)dst = w0; *(v4u*)(dst + 8) = w1; }
        __syncthreads();
    }
}
__device__ __forceinline__ void tr_item(const float* W, int ldw, int c0, int k0, bf16* WT, int K, int r0, LAS float* scr, int lane) {
#pragma unroll 8
    for (int i = 0; i < 32; ++i) { const int kk = 2 * i + (lane >> 5); scr[kk * 33 + (lane & 31)] = W[(size_t)(k0 + kk) * ldw + c0 + (lane & 31)]; }
    asm volatile("s_waitcnt lgkmcnt(0)" ::: "memory");
    const int c = lane & 7;
#pragma unroll
    for (int j = 0; j < 4; ++j) { const int n = (lane >> 3) + 8 * j; const LAS float* s = scr + (8 * c) * 33 + n;
        v4u o; o.x = pk2(s[0 * 33], s[1 * 33]); o.y = pk2(s[2 * 33], s[3 * 33]); o.z = pk2(s[4 * 33], s[5 * 33]); o.w = pk2(s[6 * 33], s[7 * 33]);
        *(v4u*)(WT + (size_t)(r0 + n) * K + k0 + 8 * c) = o; }
    asm volatile("s_waitcnt lgkmcnt(0)" ::: "memory");
}
__device__ __forceinline__ void p0_transposes(const P& p, LAS unsigned char* lds, int wave, int lane) {
    LAS float* scr = (LAS float*)(lds + wave * 16384);
    const int gw = blockIdx.x * NWAVES + wave, NGW = gridDim.x * NWAVES;
    constexpr int I_IN = 24 * 16, I_OUT = 32 * 16, I_GU = 176 * 16, I_DN = 32 * 44, I_L = I_IN + I_OUT + I_GU + I_DN;
    for (int it = gw; it < 2 * I_L; it += NGW) {
        const int layer = it / I_L; int r = it % I_L;
        if (r < I_IN) { const int nb = r % 24, kb = r / 24; tr_item(p.w_in + (size_t)layer * 1024 * INW, INW, nb * 32, kb * 64, (bf16*)(p.ws + WS_WIN) + (size_t)layer * NIN * 1024, 1024, (nb >> 3) * 256 + 128 * (nb & 1) + 32 * ((nb & 7) >> 1), scr, lane); continue; } r -= I_IN;
        if (r < I_OUT) { const int nb = r % 32, kb = r / 32; tr_item(p.w_out + (size_t)layer * 1024 * 1024, 1024, nb * 32, kb * 64, (bf16*)(p.ws + WS_WOUT) + (size_t)layer * 1024 * 1024, 1024, nb * 32, scr, lane); continue; } r -= I_OUT;
        if (r < I_GU) { const int nb = r % 176, kb = r / 176; const int n0 = nb * 32; const int j = n0 < DFF ? n0 : n0 - DFF; const int drow = (j >> 7) * 256 + (n0 < DFF ? 0 : 128) + (j & 127);
            tr_item(p.w_gate_up + (size_t)layer * 1024 * NGU, NGU, n0, kb * 64, (bf16*)(p.ws + WS_WGU) + (size_t)layer * NGU * 1024, 1024, drow, scr, lane); continue; } r -= I_GU;
        { const int nb = r % 32, kb = r / 32; tr_item(p.w_down + (size_t)layer * DFF * 1024, 1024, nb * 32, kb * 64, (bf16*)(p.ws + WS_WDN) + (size_t)layer * 1024 * DFF, DFF, nb * 32, scr, lane); }
    }
}
__device__ __forceinline__ void p0_trig(const P& p, int tid) {
    const int gt = blockIdx.x * NTHR + tid, NGT = gridDim.x * NTHR;
    bf16* TC = (bf16*)(p.ws + WS_TRIGC);
    for (int it = gt; it < 256 * 32; it += NGT) { const int k = it >> 5, c8 = (it & 31) * 8;
        float v[8];
#pragma unroll
        for (int jj = 0; jj < 8; ++jj) { const int j = c8 + jj; const bool isS = j > 128; const int l = isS ? j - 128 : j; const float rev = (float)((k * l) & 255) * (1.0f / 256.0f); v[jj] = isS ? -__builtin_amdgcn_sinf(rev) : __builtin_amdgcn_cosf(rev); }
        v4u w; w.x = pk2(v[0], v[1]); w.y = pk2(v[2], v[3]); w.z = pk2(v[4], v[5]); w.w = pk2(v[6], v[7]);
        *(v4u*)(TC + (size_t)k * 256 + c8) = w; }
}
__device__ __forceinline__ void norm_phase(const float* sx, const float* scx, int nrows, const float* g, const float* modl, int shift_chunk, int scale_chunk, bf16* HX, int wave, int lane) {
    constexpr int R = 2;
    const int gw = blockIdx.x * NWAVES + wave, NGW = gridDim.x * NWAVES;
    f32x4 gm[4];
#pragma unroll
    for (int j = 0; j < 4; ++j) gm[j] = *(const f32x4*)(g + 256 * j + 4 * lane);
    for (int m0 = gw * R; m0 < nrows; m0 += NGW * R) {
        f32x4 v[R][4];
#pragma unroll
        for (int e = 0; e < R; ++e) { const int m = m0 + e; const float* xrow = m < MXR ? sx + (size_t)m * 1024 : scx + (size_t)(m - MXR) * 1024;
#pragma unroll
            for (int j = 0; j < 4; ++j) v[e][j] = *(const f32x4*)(xrow + 256 * j + 4 * lane); }
#pragma unroll
        for (int e = 0; e < R; ++e) { const int m = m0 + e; const float* md = modl + (size_t)(m < MXR ? (m >> 12) : 16) * MODW_;
            float s = 0.f;
#pragma unroll
            for (int j = 0; j < 4; ++j) s += (v[e][j].x * v[e][j].x + v[e][j].y * v[e][j].y) + (v[e][j].z * v[e][j].z + v[e][j].w * v[e][j].w);
            const float rstd = 1.0f / sqrtf(wave_sum(s, lane) * (1.0f / 1024.0f) + 1e-6f);
#pragma unroll
            for (int j = 0; j < 4; ++j) { const f32x4 scv = *(const f32x4*)(md + scale_chunk * 1024 + 256 * j + 4 * lane), shv = *(const f32x4*)(md + shift_chunk * 1024 + 256 * j + 4 * lane);
                const f32x4 y = v[e][j] * rstd * gm[j] * (scv + 1.0f) + shv;
                v2u w; w.x = pk2(y.x, y.y); w.y = pk2(y.z, y.w);
                *(v2u*)(HX + (size_t)m * 1024 + 256 * j + 4 * lane) = w; } }
    }
}
__device__ __forceinline__ void norm_phase_bf16(const bf16* XS, int nrows, const float* g, const float* modl, int shift_chunk, int scale_chunk, bf16* HX, int wave, int lane) {
    constexpr int R = 4;
    const int gw = blockIdx.x * NWAVES + wave, NGW = gridDim.x * NWAVES;
    f32x4 gm[4];
#pragma unroll
    for (int j = 0; j < 4; ++j) gm[j] = *(const f32x4*)(g + 16 * lane + 4 * j);
    for (int m0 = gw * R; m0 < nrows; m0 += NGW * R) {
        v4u ra[R][2];
#pragma unroll
        for (int e = 0; e < R; ++e) { const bf16* xr = XS + (size_t)(m0 + e) * 1024 + lane * 16; ra[e][0] = *(const v4u*)xr; ra[e][1] = *(const v4u*)(xr + 8); }
#pragma unroll
        for (int e = 0; e < R; ++e) { const int m = m0 + e; const float* md = modl + (size_t)(m < MXR ? (m >> 12) : 16) * MODW_;
            const v4u r0 = ra[e][0], r1 = ra[e][1];
            f32x4 v[4];
            v[0] = (f32x4){__builtin_bit_cast(float, r0.x << 16), __builtin_bit_cast(float, r0.x & 0xffff0000u), __builtin_bit_cast(float, r0.y << 16), __builtin_bit_cast(float, r0.y & 0xffff0000u)};
            v[1] = (f32x4){__builtin_bit_cast(float, r0.z << 16), __builtin_bit_cast(float, r0.z & 0xffff0000u), __builtin_bit_cast(float, r0.w << 16), __builtin_bit_cast(float, r0.w & 0xffff0000u)};
            v[2] = (f32x4){__builtin_bit_cast(float, r1.x << 16), __builtin_bit_cast(float, r1.x & 0xffff0000u), __builtin_bit_cast(float, r1.y << 16), __builtin_bit_cast(float, r1.y & 0xffff0000u)};
            v[3] = (f32x4){__builtin_bit_cast(float, r1.z << 16), __builtin_bit_cast(float, r1.z & 0xffff0000u), __builtin_bit_cast(float, r1.w << 16), __builtin_bit_cast(float, r1.w & 0xffff0000u)};
            float s = 0.f;
#pragma unroll
            for (int j = 0; j < 4; ++j) s += (v[j].x * v[j].x + v[j].y * v[j].y) + (v[j].z * v[j].z + v[j].w * v[j].w);
            const float rstd = 1.0f / sqrtf(wave_sum(s, lane) * (1.0f / 1024.0f) + 1e-6f);
            unsigned o[8];
#pragma unroll
            for (int j = 0; j < 4; ++j) { const f32x4 scv = *(const f32x4*)(md + scale_chunk * 1024 + 16 * lane + 4 * j), shv = *(const f32x4*)(md + shift_chunk * 1024 + 16 * lane + 4 * j);
                const f32x4 y = v[j] * rstd * gm[j] * (scv + 1.0f) + shv; o[2 * j] = pk2(y.x, y.y); o[2 * j + 1] = pk2(y.z, y.w); }
            bf16* hp = HX + (size_t)m * 1024 + lane * 16;
            *(v4u*)hp = (v4u){o[0], o[1], o[2], o[3]}; *(v4u*)(hp + 8) = (v4u){o[4], o[5], o[6], o[7]}; }
    }
}
__device__ __forceinline__ void prep_phase(const P& p, int layer, LAS unsigned char* lds, int tid, int wave, int lane, int cu, int ncu) {
    const bf16* Z = (const bf16*)(p.ws + WS_Z); bf16* MX = (bf16*)(p.ws + WS_MX);
    const int gw = cu * NWAVES + wave, NGW = ncu * NWAVES;
    { const int nrows = layer == 0 ? MTR : MXR;
      for (int it = gw; it < nrows / 4; it += NGW) {
        const int m = it * 4 + (lane >> 4), c = lane & 15;
        const bool isx = m < MXR;
        const int t = isx ? (m & 4095) : ((m - MXR) & 255), L = isx ? SEQ : CTX;
        const int w = 2 << (c >> 2);
        int lo = t - (w >> 1); if (lo < 0) lo = 0; int hi = t + w - (w >> 1); if (hi > L) hi = L;
        const bf16* zb = Z + (size_t)(m - t) * 1024 + 768 + c * 16;
        float a[16];
#pragma unroll
        for (int f = 0; f < 16; ++f) a[f] = 0.f;
        float sv[16];
        { const v4u q0 = *(const v4u*)(zb + (size_t)t * 1024), q1 = *(const v4u*)(zb + (size_t)t * 1024 + 8);
          const unsigned ww[8] = {q0.x, q0.y, q0.z, q0.w, q1.x, q1.y, q1.z, q1.w};
#pragma unroll
          for (int j = 0; j < 8; ++j) { sv[2 * j] = __builtin_bit_cast(float, ww[j] << 16); sv[2 * j + 1] = __builtin_bit_cast(float, ww[j] & 0xffff0000u); } }
#pragma unroll
        for (int ib = 0; ib < 16; ib += 8) { v4u q0[8], q1[8];
#pragma unroll
            for (int i = 0; i < 8; ++i) { int tt = lo + ib + i; if (tt > hi - 1) tt = hi - 1; q0[i] = *(const v4u*)(zb + (size_t)tt * 1024); q1[i] = *(const v4u*)(zb + (size_t)tt * 1024 + 8); }
#pragma unroll
            for (int i = 0; i < 8; ++i) { const float wgt = (lo + ib + i < hi) ? 1.0f : 0.0f;
                const unsigned ww[8] = {q0[i].x, q0[i].y, q0[i].z, q0[i].w, q1[i].x, q1[i].y, q1[i].z, q1[i].w};
#pragma unroll
                for (int j = 0; j < 8; ++j) { a[2 * j] += wgt * __builtin_bit_cast(float, ww[j] << 16); a[2 * j + 1] += wgt * __builtin_bit_cast(float, ww[j] & 0xffff0000u); } } }
        const float inv = 1.0f / (float)(hi - lo);
        v4u w0, w1;
        w0.x = pk2(a[0] * inv - sv[0], a[1] * inv - sv[1]); w0.y = pk2(a[2] * inv - sv[2], a[3] * inv - sv[3]); w0.z = pk2(a[4] * inv - sv[4], a[5] * inv - sv[5]); w0.w = pk2(a[6] * inv - sv[6], a[7] * inv - sv[7]);
        w1.x = pk2(a[8] * inv - sv[8], a[9] * inv - sv[9]); w1.y = pk2(a[10] * inv - sv[10], a[11] * inv - sv[11]); w1.z = pk2(a[12] * inv - sv[12], a[13] * inv - sv[13]); w1.w = pk2(a[14] * inv - sv[14], a[15] * inv - sv[15]);
        bf16* o = MX + (size_t)m * 1024 + 512 + c * 16; *(v4u*)o = w0; *(v4u*)(o + 8) = w1;
      } }
    __syncthreads();
    { LAS unsigned short* row = (LAS unsigned short*)(lds + wave * 16384);
      const bf16* PQT = (const bf16*)(p.ws + WS_PQT); const bf16* PQTC = (const bf16*)(p.ws + WS_PQTC); bf16* PQF = (bf16*)(p.ws + WS_PQF); bf16* PQFC = (bf16*)(p.ws + WS_PQFC);
      const int ntot = layer == 0 ? 8192 : 4096;
      for (int it = 4096 + gw; it < ntot; it += NGW) {
        const bool isx = it < 4096; const int n = isx ? it : it - 4096, L = isx ? SEQ : CTX, H2 = L >> 1;
        const bf16* src = isx ? PQT + (size_t)n * 8192 : PQTC + (size_t)n * 512;
        bf16* dst = isx ? PQF + (size_t)n * 4096 : PQFC + (size_t)n * 256;
        for (int c = lane; c < L / 4; c += 64) *(LAS v4u*)(row + c * 8) = *(const v4u*)(src + c * 8);
        asm volatile("s_waitcnt vmcnt(0) lgkmcnt(0)" ::: "memory");
        for (int c = lane; c < L / 8; c += 64) { const int j0 = c * 8; float o[8];
#pragma unroll
            for (int jj = 0; jj < 8; ++jj) { const int j = j0 + jj; const bool lowh = j <= H2; const int l = j - H2;
                const int ia = lowh ? j : L + l, ib = lowh ? L - j : 2 * L - l;
                const float va = bf2f(row[ia]), vb = bf2f(row[ib]);
                const float sg = lowh ? ((j == 0 || j == H2) ? 0.0f : 1.0f) : -1.0f;
                o[jj] = va + sg * vb; }
            v4u w; w.x = pk2(o[0], o[1]); w.y = pk2(o[2], o[3]); w.z = pk2(o[4], o[5]); w.w = pk2(o[6], o[7]);
            *(v4u*)(dst + j0) = w; }
        asm volatile("s_waitcnt lgkmcnt(0)" ::: "memory");
      } }
    __syncthreads();
}

__device__ __forceinline__ constexpr int bitrev6(int i) { return ((i & 1) << 5) | ((i & 2) << 3) | ((i & 4) << 1) | ((i & 8) >> 1) | ((i & 16) >> 3) | ((i & 32) >> 5); }
template <int HALF> __device__ __forceinline__ void fft64_stage(float (&xr)[64], float (&xi)[64]) {
constexpr float FC[32] = {1.000000000e+00f, 9.951847267e-01f, 9.807852804e-01f, 9.569403357e-01f, 9.238795325e-01f, 8.819212643e-01f, 8.314696123e-01f, 7.730104534e-01f, 7.071067812e-01f, 6.343932842e-01f, 5.555702330e-01f, 4.713967368e-01f, 3.826834324e-01f, 2.902846773e-01f, 1.950903220e-01f, 9.801714033e-02f, 6.123233996e-17f, -9.801714033e-02f, -1.950903220e-01f, -2.902846773e-01f, -3.826834324e-01f, -4.713967368e-01f, -5.555702330e-01f, -6.343932842e-01f, -7.071067812e-01f, -7.730104534e-01f, -8.314696123e-01f, -8.819212643e-01f, -9.238795325e-01f, -9.569403357e-01f, -9.807852804e-01f, -9.951847267e-01f};
    constexpr float FS[32] = {0.000000000e+00f, 9.801714033e-02f, 1.950903220e-01f, 2.902846773e-01f, 3.826834324e-01f, 4.713967368e-01f, 5.555702330e-01f, 6.343932842e-01f, 7.071067812e-01f, 7.730104534e-01f, 8.314696123e-01f, 8.819212643e-01f, 9.238795325e-01f, 9.569403357e-01f, 9.807852804e-01f, 9.951847267e-01f, 1.000000000e+00f, 9.951847267e-01f, 9.807852804e-01f, 9.569403357e-01f, 9.238795325e-01f, 8.819212643e-01f, 8.314696123e-01f, 7.730104534e-01f, 7.071067812e-01f, 6.343932842e-01f, 5.555702330e-01f, 4.713967368e-01f, 3.826834324e-01f, 2.902846773e-01f, 1.950903220e-01f, 9.801714033e-02f};
#pragma unroll
    for (int b0 = 0; b0 < 64; b0 += 2 * HALF)
#pragma unroll
        for (int j = 0; j < HALF; ++j) { const int e = j * (32 / HALF), i0 = b0 + j, i1 = b0 + j + HALF;
            const float ar = xr[i0], ai = xi[i0], br = xr[i1], bi = xi[i1];
            xr[i0] = ar + br; xi[i0] = ai + bi;
            const float dr = ar - br, di = ai - bi;
            if (e == 0) { xr[i1] = dr; xi[i1] = di; }
            else if (e == 16) { xr[i1] = di; xi[i1] = -dr; }
            else { xr[i1] = dr * FC[e] + di * FS[e]; xi[i1] = di * FC[e] - dr * FS[e]; } }
}
__device__ __forceinline__ void fft64_dif(float (&xr)[64], float (&xi)[64]) {
    fft64_stage<32>(xr, xi); __builtin_amdgcn_sched_barrier(0); fft64_stage<16>(xr, xi); __builtin_amdgcn_sched_barrier(0); fft64_stage<8>(xr, xi); __builtin_amdgcn_sched_barrier(0);
    fft64_stage<4>(xr, xi); __builtin_amdgcn_sched_barrier(0); fft64_stage<2>(xr, xi); __builtin_amdgcn_sched_barrier(0); fft64_stage<1>(xr, xi); __builtin_amdgcn_sched_barrier(0);
}
__device__ __forceinline__ void fft_phase(const P& p, LAS unsigned char* lds, int tid, int wave, int lane, int cu, int ncu) {
    const bf16* PQT = (const bf16*)(p.ws + WS_PQT); bf16* MX = (bf16*)(p.ws + WS_MX);
    LAS unsigned short* row = (LAS unsigned short*)(lds + wave * 16640);
    LAS float* T = (LAS float*)(lds + wave * 16640);
    LAS unsigned short* OUT = (LAS unsigned short*)lds;
    for (int it = cu; it < 512; it += ncu) {
        const int bgi = it >> 3, db = it & 7, n = bgi * 64 + db * 8 + wave;
        int lane_t = lane; asm volatile("" : "+v"(lane_t));
        const bf16* src = PQT + (size_t)n * 8192;
        for (int c = lane; c < 1024; c += 64) *(LAS v4u*)(row + c * 8) = *(const v4u*)(src + c * 8);
        asm volatile("s_waitcnt vmcnt(0) lgkmcnt(0)" ::: "memory"); __builtin_amdgcn_sched_barrier(0);
        float xr[64], xi[64];
#pragma unroll
        for (int r = 0; r < 64; ++r) { xr[r] = bf2f(row[64 * r + lane]); xi[r] = -bf2f(row[4096 + 64 * r + lane]); }
        asm volatile("s_waitcnt lgkmcnt(0)" ::: "memory"); __builtin_amdgcn_sched_barrier(0);
        fft64_dif(xr, xi);
#pragma unroll
        for (int r = 0; r < 64; ++r) { const int k1 = bitrev6(r); const float rev = (float)((k1 * lane_t) & 4095) * (1.0f / 4096.0f);
            const float c = __builtin_amdgcn_cosf(rev), s = __builtin_amdgcn_sinf(rev);
            const float tr = xr[r] * c + xi[r] * s, ti = xi[r] * c - xr[r] * s; T[k1 * 65 + lane] = tr; xi[r] = ti; }
        float br[64], bi[64];
        asm volatile("s_waitcnt lgkmcnt(0)" ::: "memory"); __builtin_amdgcn_sched_barrier(0);
#pragma unroll
        for (int r = 0; r < 64; ++r) br[r] = T[lane * 65 + r];
        asm volatile("s_waitcnt lgkmcnt(0)" ::: "memory"); __builtin_amdgcn_sched_barrier(0);
#pragma unroll
        for (int r = 0; r < 64; ++r) { const int k1 = bitrev6(r); T[k1 * 65 + lane] = xi[r]; }
        asm volatile("s_waitcnt lgkmcnt(0)" ::: "memory"); __builtin_amdgcn_sched_barrier(0);
#pragma unroll
        for (int r = 0; r < 64; ++r) bi[r] = T[lane * 65 + r];
        asm volatile("s_waitcnt lgkmcnt(0)" ::: "memory"); __builtin_amdgcn_sched_barrier(0);
        fft64_dif(br, bi);
        __syncthreads();
#pragma unroll
        for (int r = 0; r < 64; ++r) { const int k2 = bitrev6(r); OUT[(lane + 64 * k2) * 8 + wave] = (unsigned short)f2bf(br[r] * (1.0f / 512.0f)); }
        __syncthreads();
        { const int b = bgi >> 2, g = bgi & 3;
#pragma unroll
          for (int i = 0; i < 8; ++i) { const int k = tid + 512 * i; const v4u v = *(const LAS v4u*)(OUT + k * 8);
              *(v4u*)(MX + ((size_t)(b * SEQ + k)) * 1024 + 768 + g * 64 + db * 8) = v; } }
        __syncthreads();
    }
}
typedef __attribute__((address_space(1))) unsigned gu32;
#define RLX_AGENT __ATOMIC_RELAXED, __HIP_MEMORY_SCOPE_AGENT
#define XB_TMO      128
#define XB_XCNT(j)  (256  + 64 * (j))
#define XB_XSUB(j)  (1280 + 64 * (j))
#define XB_XGEN(j)  (2304 + 64 * (j))
#define XB_TOP      3328
#define XB_TOPGEN   3392
#define XCD_BAR_WORDS 3456
#define XB_SPIN_CAP (1u << 18)

__device__ __forceinline__ unsigned xb_ld(unsigned* p)              { return __hip_atomic_load(p, __ATOMIC_RELAXED, __HIP_MEMORY_SCOPE_AGENT); }
__device__ __forceinline__ unsigned xb_add(unsigned* p, unsigned v) { return __hip_atomic_fetch_add(p, v, __ATOMIC_RELAXED, __HIP_MEMORY_SCOPE_AGENT); }
__device__ __forceinline__ unsigned xb_xcc_id() { return (unsigned)__builtin_amdgcn_s_getreg((3 << 11) | 20) & 0xFu; }
#define XB_SPIN(cond, bar) do { unsigned _sp = 0; while (cond) { __builtin_amdgcn_s_sleep(1); \
    if ((++_sp & 255u) == 0u) { if (xb_ld(&(bar)[XB_TMO])) break; if (_sp > XB_SPIN_CAP) { atomicAdd(&(bar)[XB_TMO], 1u); break; } } } } while (0)

struct XcdBarrier {
    unsigned* bar; unsigned x;
    volatile LAS unsigned* st;
};

__device__ __forceinline__ XcdBarrier xcd_barrier_post(unsigned* bar, volatile LAS unsigned* st) {
    XcdBarrier b; b.bar = bar; b.x = (unsigned)__builtin_amdgcn_readfirstlane((int)xb_xcc_id()); b.st = st;
    if (threadIdx.x == 0) (void)xb_add(&bar[XB_XCNT(b.x)], 1u);
    return b;
}
__device__ __forceinline__ void xcd_barrier_complete(unsigned* bar, unsigned x, unsigned& nloc, unsigned& nx) {
    const unsigned G = gridDim.x * gridDim.y * gridDim.z;
    unsigned sum, cnt, mine, sp = 0u;
    for (;;) {
        sum = 0u; cnt = 0u; mine = 0u;
#pragma unroll
        for (unsigned j = 0; j < 16; ++j) { const unsigned c = xb_ld(&bar[XB_XCNT(j)]); sum += c; cnt += (c > 0u) ? 1u : 0u; mine = (j == x) ? c : mine; }
        if (sum == G) break;
        __builtin_amdgcn_s_sleep(1);
        if ((++sp & 255u) == 0u) { if (xb_ld(&bar[XB_TMO])) break; if (sp > XB_SPIN_CAP) { atomicAdd(&bar[XB_TMO], 1u); break; } }
    }
    nloc = mine > 0u ? mine : 1u; nx = cnt > 0u ? cnt : 1u;
}

__device__ __forceinline__ void xcd_barrier(const XcdBarrier& b) {
    asm volatile("s_waitcnt vmcnt(0)" ::: "memory");
    __syncthreads();
    if (threadIdx.x == 0) {
        unsigned* bar = b.bar; unsigned bx_ = b.x; asm volatile("" : "+s"(bx_));
        __builtin_amdgcn_s_waitcnt(0);
        unsigned nloc = b.st[0], nx = b.st[1];
        if (nloc == 0u) { xcd_barrier_complete(bar, bx_, nloc, nx); b.st[0] = nloc; b.st[1] = nx; }
        const unsigned old = xb_add(&bar[XB_XSUB(bx_)], 1u);
        const unsigned gen = old / nloc;
        if (old + 1u == (gen + 1u) * nloc) {
            __builtin_amdgcn_fence(__ATOMIC_RELEASE, "agent");
            asm volatile("s_waitcnt vmcnt(0)" ::: "memory");
            const unsigned og = xb_add(&bar[XB_TOP], 1u);
            const unsigned tg = og / nx;
            if (og + 1u == (tg + 1u) * nx) xb_add(&bar[XB_TOPGEN], 1u);
            else XB_SPIN(xb_ld(&bar[XB_TOPGEN]) == tg, bar);
            __builtin_amdgcn_fence(__ATOMIC_ACQUIRE, "agent");
            xb_add(&bar[XB_XGEN(bx_)], 1u);
            asm volatile("s_waitcnt vmcnt(0)" ::: "memory");
        } else {
            XB_SPIN(xb_ld(&bar[XB_XGEN(bx_)]) == gen, bar);
            __builtin_amdgcn_fence(__ATOMIC_ACQUIRE, "agent");
            asm volatile("s_waitcnt vmcnt(0)" ::: "memory");
        }
    }
    __syncthreads();
}

__global__ void __launch_bounds__(NTHR, 2) mk_fwd(P p) {
    extern __shared__ __attribute__((aligned(16))) unsigned char lds_raw[];
    LAS unsigned char* lds = (LAS unsigned char*)lds_raw;
    cg::grid_group grid = cg::this_grid();
    if (p.ws == nullptr) grid.sync();
    volatile LAS unsigned* bst = (volatile LAS unsigned*)(lds + 138240);
    if (threadIdx.x < 2) bst[threadIdx.x] = 0u;
    __syncthreads();
    const XcdBarrier xbar = xcd_barrier_post((unsigned*)(p.ws + WS_CTL), bst);
#define GRID_SYNC() xcd_barrier(xbar)
#define FRESH_IDS() int tid = threadIdx.x; asm volatile("" : "+v"(tid)); const int lane = tid & 63, wave = __builtin_amdgcn_readfirstlane(tid >> 6); int bx = blockIdx.x; asm volatile("" : "+s"(bx)); \
    const int vcu = (G % 8 == 0) ? (bx % 8) * (G / 8) + bx / 8 : bx; (void)lane; (void)wave; (void)vcu
    const int G = gridDim.x;
    unsigned char* ws = p.ws;
    float* MOD = (float*)(ws + WS_MOD);
    bf16* HX = (bf16*)(ws + WS_HX); bf16* Zb = (bf16*)(ws + WS_Z); bf16* MXb = (bf16*)(ws + WS_MX); bf16* Hb = (bf16*)(ws + WS_H);
    bf16* PQT = (bf16*)(ws + WS_PQT); bf16* PQTC = (bf16*)(ws + WS_PQTC); bf16* XS = (bf16*)(ws + WS_XS);
    const attn_body::bf16* QPb = (const attn_body::bf16*)(ws + WS_QP); const attn_body::bf16* KPb = (const attn_body::bf16*)(ws + WS_KP); const attn_body::bf16* VPb = (const attn_body::bf16*)(ws + WS_VP);

    LAS float* ropeT = (LAS float*)(lds + 139264);
    for (int i = threadIdx.x; i < 1024; i += NTHR) { const int pos = i >> 4, f = i & 15; const float fr = expf(-(float)f * (1.0f / 16.0f) * 9.210340371976184f); const float a = (float)pos * fr; float rev = a * 0.15915494309189535f; rev -= floorf(rev);
        ropeT[i] = __builtin_amdgcn_cosf(rev); ropeT[1024 + i] = __builtin_amdgcn_sinf(rev); }
    __syncthreads();
    { FRESH_IDS();
    p0_mod(p, lds, tid, wave, lane);
    __syncthreads();
    p0_comp(p, lds, tid);
    __syncthreads();
    p0_transposes(p, lds, wave, lane);
    p0_trig(p, tid); }
    GRID_SYNC();

    for (int layer = 0; layer < 2; ++layer) {
        const bool upd = layer == 0;
        const float* modl = MOD + (size_t)layer * 17 * MODW_;
        const bf16* WIN = (const bf16*)(ws + WS_WIN) + (size_t)layer * NIN * 1024;
        const bf16* WOUT = (const bf16*)(ws + WS_WOUT) + (size_t)layer * 1024 * 1024;
        const bf16* WGU = (const bf16*)(ws + WS_WGU) + (size_t)layer * NGU * 1024;
        const bf16* WDN = (const bf16*)(ws + WS_WDN) + (size_t)layer * 1024 * DFF;
        { FRESH_IDS(); if (layer == 0) norm_phase(p.x, p.ctx, MTR, p.g_mix, modl, 0, 1, HX, wave, lane); else norm_phase_bf16(XS, MTR, p.g_mix + 1024, modl, 0, 1, HX, wave, lane); }
        GRID_SYNC();
        { FRESH_IDS();
            pg8::EpiIn E{Zb, PQT, PQTC, 0, 0, (bf16*)(ws + WS_QP), (bf16*)(ws + WS_KP), (bf16*)(ws + WS_VP), p.q_gain + layer * 64, p.k_gain + layer * 64, ropeT, QSCALE};
            if (upd) { pg8::Gemm g{HX, WIN, MTR, NIN, 1024}; pg8::StaticOrder S; S.init(MTR, NIN, G, bx); pg8::gemm_phase<pg8::EpiIn, pg8::StaticOrder, true, true>(lds, g, S, E); }
            else {
                { pg8::Gemm g{HX, WIN, MXR, NIN, 1024}; pg8::StaticOrder S; S.init(MXR, NIN, G, bx); pg8::gemm_phase<pg8::EpiIn, pg8::StaticOrder, true, true>(lds, g, S, E); }
            }
        }
        GRID_SYNC();
        { FRESH_IDS();
          const int ngemm = upd ? 0 : 16;
          if (bx >= G - ngemm) { pg8::EpiIn E2{Zb, PQT, PQTC, MXR, 512, (bf16*)(ws + WS_QP), (bf16*)(ws + WS_KP), (bf16*)(ws + WS_VP), p.q_gain + layer * 64, p.k_gain + layer * 64, ropeT, QSCALE};
              pg8::Gemm g{HX + (size_t)MXR * 1024, WIN + (size_t)512 * 1024, MCR, 256, 1024}; pg8::StaticOrder S; S.init(MCR, 256, G, G - 1 - bx);
              pg8::gemm_phase<pg8::EpiIn, pg8::StaticOrder, true, true>(lds, g, S, E2); }
          else prep_phase(p, layer, lds, tid, wave, lane, bx, G - ngemm); }
        GRID_SYNC();
        { FRESH_IDS();
            for (int i = 0; i < (2048 + G - 1) / G; ++i) { const int pu = i * G + vcu; if (pu >= 2048) break;
                const int bg = pu >> 6, u = pu & 63, b = bg >> 1, gk = bg & 1, h = gk * 4 + (u >> 4), qb = u & 15;
                const size_t qrow = (size_t)b * SEQ + qb * 256;
                attn_body::attn_unit<8>(QPb + qrow * 512 + h * 64, KPb + (size_t)b * KVL * 128 + gk * 64, VPb + (size_t)b * KVL * 128 + gk * 64,
                                        (attn_body::bf16*)MXb + qrow * 1024 + h * 64, KVL / 64, (char*)lds_raw); }
            if (upd) for (int cu = vcu; cu < 128; cu += G) { const int b = cu >> 3, h = cu & 7, gk = h >> 2; const size_t qrow = (size_t)MXR + b * CTX;
                attn_body::attn_unit<8>(QPb + qrow * 512 + h * 64, KPb + (size_t)b * KVL * 128 + gk * 64, VPb + (size_t)b * KVL * 128 + gk * 64,
                                        (attn_body::bf16*)MXb + qrow * 1024 + h * 64, CTX / 64, (char*)lds_raw); }
            fft_phase(p, lds, tid, wave, lane, bx, G);
            if (upd) { pg8::Gemm g{(const bf16*)(ws + WS_TRIGC), (const bf16*)(ws + WS_PQFC), CTX, 4096, CTX}; pg8::StaticOrder S; S.init(CTX, 4096, G, G - 1 - bx); pg8::EpiFour E{MXb, MXR, CTX, 1.0f / 128.0f};
              pg8::gemm_phase<pg8::EpiFour, pg8::StaticOrder, true, true>(lds, g, S, E); }
        }
        GRID_SYNC();
        { FRESH_IDS(); const int M = upd ? MTR : MXR; pg8::Gemm g{MXb, WOUT, M, 1024, 1024}; pg8::StaticOrder S; S.init(M, 1024, G, bx); pg8::EpiRes E{layer == 0 ? p.x : (const float*)nullptr, p.ctx, XS, XS, (float*)nullptr, modl + 2 * 1024};
          pg8::gemm_phase<pg8::EpiRes, pg8::StaticOrder, true, true>(lds, g, S, E); }
        GRID_SYNC();
        { FRESH_IDS(); norm_phase_bf16(XS, upd ? MTR : MXR, p.g_ffn + layer * 1024, modl, 3, 4, HX, wave, lane); }
        GRID_SYNC();
        { FRESH_IDS(); const int M = upd ? MTR : MXR; pg8::Gemm g{HX, WGU, M, NGU, 1024}; pg8::StaticOrder S; S.init(M, NGU, G, bx); pg8::EpiSwiglu E{Hb};
          pg8::gemm_phase<pg8::EpiSwiglu, pg8::StaticOrder, true, true>(lds, g, S, E); }
        GRID_SYNC();
        { FRESH_IDS(); const int M = upd ? MTR : MXR; pg8::Gemm g{Hb, WDN, M, 1024, DFF}; pg8::StaticOrder S; S.init(M, 1024, G, bx); pg8::EpiRes E{(const float*)nullptr, (const float*)nullptr, XS, upd ? XS : (bf16*)nullptr, p.out, modl + 5 * 1024};
          pg8::gemm_phase<pg8::EpiRes, pg8::StaticOrder, true, true>(lds, g, S, E); }
        if (layer == 0) GRID_SYNC();
    }
}

extern "C" void kernel_launch(void* const* d_in, const int* in_sizes, int n_in, void* d_out, int out_size, void* d_ws, size_t ws_size, hipStream_t stream) {
    static int grid = 0;
    if (grid == 0) {
        if (n_in != 17 || ws_size < WS_END) { fprintf(stderr, "kernel_launch: unexpected n_in %d / ws %zu\n", n_in, ws_size); grid = -1; return; }
        int dev = 0, cus = 0, per_cu = 0;
        hipGetDevice(&dev); hipDeviceGetAttribute(&cus, hipDeviceAttributeMultiprocessorCount, dev);
        hipFuncSetAttribute((const void*)mk_fwd, hipFuncAttributeMaxDynamicSharedMemorySize, LDS_BYTES);
        hipOccupancyMaxActiveBlocksPerMultiprocessor(&per_cu, (const void*)mk_fwd, NTHR, LDS_BYTES);
        (void)hipGetLastError();
        if (per_cu < 1) per_cu = 1;
        grid = cus * per_cu;
    }
    if (grid < 0) return;
    if (hipMemsetAsync((char*)d_ws + WS_CTL, 0, CTL_BYTES, stream) != hipSuccess) { fprintf(stderr, "memset failed\n"); return; }
    P p{};
    const float** pp = (const float**)&p;
    for (int i = 0; i < 17; ++i) pp[i] = (const float*)d_in[i];
    p.out = (float*)d_out; p.ws = (unsigned char*)d_ws;
    void* args[] = {&p};
    hipError_t e = hipLaunchCooperativeKernel((const void*)mk_fwd, dim3(grid), dim3(NTHR), args, LDS_BYTES, stream);
    if (e != hipSuccess) fprintf(stderr, "cooperative launch failed: %s (grid %d)\n", hipGetErrorString(e), grid);
}
```

```cpp
#include <hip/hip_runtime.h>
#include <hip/hip_bf16.h>
#include <hip/hip_cooperative_groups.h>
#include <cstdio>
#include <cstdint>
#include <cmath>
namespace pg8 {
#define PG8_LAS __attribute__((address_space(3)))
typedef unsigned short bf16_t;
typedef short bf16x8 __attribute__((ext_vector_type(8)));
typedef float f32x4 __attribute__((ext_vector_type(4)));
typedef unsigned u32x4 __attribute__((ext_vector_type(4)));
constexpr int BM = 256, BK = 64, HALF = 128, HTB = HALF * BK * 2  , STAGE_BYTES = 8 * HTB, NXCD = 8, WGM = 8;

__host__ __device__ __forceinline__ int lds_byte(int r, int c) { const int st = (r >> 4) * 2 + (c >> 5), rr = r & 15, cc = c & 31, ob = rr * 64 + cc * 2; return st * 1024 + (ob ^ (((ob >> 9) & 1) << 5)); }
__host__ __device__ __forceinline__ void stage_rc(int b, int& R, int& C) { const int st = b / 1024, sb = b % 1024, swz = sb ^ (((sb >> 9) & 1) << 5); R = (st >> 1) * 16 + swz / 64; C = (st & 1) * 32 + (swz % 64) / 2; }
__host__ __device__ __forceinline__ int perm32(int rho) { const int n = rho >> 4, i = rho & 15; return 8 * (i >> 2) + 4 * n + (i & 3); }

struct Unit { int pm, pn; };
struct Gemm { const bf16_t* A; const bf16_t* Bt; int M, N, K; };

struct StaticOrder {
    int nM, nN, nwg, G, c;
    __host__ __device__ void init(int M, int N, int G_, int c_) { nM = M / BM; nN = N / BM; nwg = nM * nN; G = G_; c = c_; }
    __host__ __device__ bool next(int i, Unit& u) const {
        const long L = (long)i * G + c; if (L >= nwg) return false;
        int wgid = (int)L; { const int q = nwg / NXCD, r = nwg % NXCD, xcd = wgid % NXCD, off = wgid / NXCD; wgid = (xcd < r ? xcd * (q + 1) : r * (q + 1) + (xcd - r) * q) + off; }
        const int nig = WGM * nN, gid = wgid / nig, fm = gid * WGM, gsz = (nM - fm) < WGM ? (nM - fm) : WGM;
        u.pm = fm + ((wgid % nig) % gsz); u.pn = (wgid % nig) / gsz; return true;
    }
    __device__ __forceinline__ void a_ready(const Unit&) const {}
    __device__ __forceinline__ void done(const Unit&) const {}
};

__device__ __forceinline__ unsigned cvt_pk_bf16(float lo, float hi) { unsigned r; asm volatile("v_cvt_pk_bf16_f32 %0, %1, %2" : "=v"(r) : "v"(lo), "v"(hi)); return r; }
typedef float f32x2 __attribute__((ext_vector_type(2)));
__device__ __forceinline__ float shx_(float v, int o, int lane) { return __builtin_bit_cast(float, __builtin_amdgcn_ds_bpermute((lane ^ o) << 2, __builtin_bit_cast(int, v))); }
constexpr int XROWS = 65536, CTXL = 256, SEQL = 4096, MODW = 6144;
struct EpiIn {
    static constexpr bool PERM = true, AFTER_DRAIN = false;
    bf16_t* Z; bf16_t* PQt; bf16_t* PQtc; int row_off, col_off;
    bf16_t* QP; bf16_t* KP; bf16_t* VP; const float* qg; const float* kg; const PG8_LAS float* rope; float qscale;
    __device__ __forceinline__ void operator()(const f32x4 (&acc)[2][2][4][2], const Unit& u, int wr, int wc, int fr, int fq) const {
        asm volatile("" : "+v"(fr), "+v"(fq));
        const int gr0 = row_off + u.pm * BM, ct = (col_off >> 8) + u.pn;
        if (ct < 3) {
            const bool isx = gr0 < XROWS, isv = (ct == 2) && (wc >= 2), isq = ct < 2;
            f32x4 gn[2][2];
            { const float* gp = (isq ? qg : kg) + 8 * fq;
#pragma unroll
              for (int bj = 0; bj < 2; ++bj)
#pragma unroll
                  for (int n = 0; n < 2; ++n) gn[bj][n] = *(const f32x4*)(gp + 32 * bj + 4 * n); }
            const float osc = isq ? qscale : 1.0f;
            const int half = fq >> 1, f0 = 8 * (fq & 1);
#pragma unroll
            for (int ai = 0; ai < 2; ++ai)
#pragma unroll
                for (int m = 0; m < 4; ++m) {
                    const int grow = gr0 + ai * HALF + wr * 64 + m * 16 + fr;
                    const int b = isx ? (grow >> 12) : ((grow - XROWS) >> 8), t = isx ? (grow & 4095) : ((grow - XROWS) & 255);
                    const size_t kvrow = (size_t)b * (SEQL + CTXL) + (isx ? CTXL + t : t);
                    if (isv) {
#pragma unroll
                        for (int bj = 0; bj < 2; ++bj) { const f32x4 v0 = acc[ai][bj][m][0], v1 = acc[ai][bj][m][1];
                            u32x4 w; w.x = cvt_pk_bf16(v0[0], v0[1]); w.y = cvt_pk_bf16(v0[2], v0[3]); w.z = cvt_pk_bf16(v1[0], v1[1]); w.w = cvt_pk_bf16(v1[2], v1[3]);
                            *(u32x4*)(VP + kvrow * 128 + (wc - 2) * 64 + 32 * bj + 8 * fq) = w; }
                    } else {
                        float ss = 0.f;
#pragma unroll
                        for (int bj = 0; bj < 2; ++bj)
#pragma unroll
                            for (int n = 0; n < 2; ++n) { const f32x4 v = acc[ai][bj][m][n]; ss += (v[0] * v[0] + v[1] * v[1]) + (v[2] * v[2] + v[3] * v[3]); }
                        ss += shx_(ss, 16, fq * 16 + fr); ss += shx_(ss, 32, fq * 16 + fr);
                        const float rstd = 1.0f / sqrtf(ss * (1.0f / 64.0f) + 1e-6f);
#pragma unroll
                        for (int bj = 0; bj < 2; ++bj) { f32x4 y[2];
#pragma unroll
                            for (int n = 0; n < 2; ++n) y[n] = acc[ai][bj][m][n] * rstd * gn[bj][n];
                            f32x4 pr[2];
#pragma unroll
                            for (int n = 0; n < 2; ++n)
#pragma unroll
                                for (int j = 0; j < 4; ++j) pr[n][j] = shx_(y[n][j], 32, fq * 16 + fr);
                            if (isx) { const int pos = bj == 0 ? (t >> 6) : (t & 63); const PG8_LAS float* cp = rope + pos * 16 + f0;
#pragma unroll
                                for (int n = 0; n < 2; ++n) { const f32x4 c = *(const PG8_LAS f32x4*)(cp + 4 * n), s = *(const PG8_LAS f32x4*)(cp + 1024 + 4 * n);
                                    y[n] = half == 0 ? y[n] * c - pr[n] * s : y[n] * c + pr[n] * s; } }
                            const f32x4 o0 = y[0] * osc, o1 = y[1] * osc;
                            u32x4 w; w.x = cvt_pk_bf16(o0[0], o0[1]); w.y = cvt_pk_bf16(o0[2], o0[3]); w.z = cvt_pk_bf16(o1[0], o1[1]); w.w = cvt_pk_bf16(o1[2], o1[3]);
                            bf16_t* dst = isq ? QP + (size_t)grow * 512 + (ct * 4 + wc) * 64 + 32 * bj + 8 * fq : KP + kvrow * 128 + wc * 64 + 32 * bj + 8 * fq;
                            *(u32x4*)dst = w; }
                    }
                }
        } else if (ct == 3) {
            bf16_t* base = Z + (size_t)(gr0 + wr * 64 + fr) * 1024 + ct * 256 + wc * 32 + 8 * fq;
#pragma unroll
            for (int ai = 0; ai < 2; ++ai)
#pragma unroll
                for (int m = 0; m < 4; ++m) { bf16_t* rowp = base + (size_t)(ai * HALF + m * 16) * 1024;
#pragma unroll
                    for (int bj = 0; bj < 2; ++bj) { const f32x4 v0 = acc[ai][bj][m][0], v1 = acc[ai][bj][m][1];
                        u32x4 w; w.x = cvt_pk_bf16(v0[0], v0[1]); w.y = cvt_pk_bf16(v0[2], v0[3]); w.z = cvt_pk_bf16(v1[0], v1[1]); w.w = cvt_pk_bf16(v1[2], v1[3]);
                        *(u32x4*)(rowp + bj * HALF) = w; } }
        } else {
            const int part = ct - 4; const bool isx = gr0 < XROWS;
            const int b = isx ? (gr0 >> 12) : ((gr0 - XROWS) >> 8);
            const int L = isx ? SEQL : CTXL;
            const int l0 = (isx ? (gr0 & 4095) : 0) + wr * 64 + fr;
            bf16_t* T = isx ? PQt : PQtc;
#pragma unroll
            for (int bj = 0; bj < 2; ++bj)
#pragma unroll
                for (int n = 0; n < 2; ++n)
#pragma unroll
                    for (int j = 0; j < 4; ++j) { const int cc = bj * HALF + wc * 32 + 8 * fq + 4 * n + j;
                        bf16_t* cp = T + ((size_t)((b * 256 + cc) * 2 + part)) * L + l0;
#pragma unroll
                        for (int ai = 0; ai < 2; ++ai)
#pragma unroll
                            for (int m = 0; m < 4; ++m) cp[ai * HALF + m * 16] = (bf16_t)(cvt_pk_bf16(acc[ai][bj][m][n][j], 0.f) & 0xffffu); }
        }
    }
};
struct EpiRes {
    static constexpr bool PERM = true, AFTER_DRAIN = false;
    const float* bx; const float* bc; const bf16_t* bs; bf16_t* os; float* of; const float* gate;
    __device__ __forceinline__ void operator()(const f32x4 (&acc)[2][2][4][2], const Unit& u, int wr, int wc, int fr, int fq) const {
        asm volatile("" : "+v"(fr), "+v"(fq));
        const bool isx = u.pm < 256;
        const float* gt = gate + (size_t)(isx ? (u.pm >> 4) : 16) * MODW;
        const int col0 = u.pn * BM + wc * 32 + 8 * fq;
        f32x4 gv[2][2];
#pragma unroll
        for (int bj = 0; bj < 2; ++bj)
#pragma unroll
            for (int n = 0; n < 2; ++n) gv[bj][n] = *(const f32x4*)(gt + col0 + bj * HALF + 4 * n);
        const bool bf32 = bx != nullptr, obf = os != nullptr;
#pragma unroll
        for (int ai = 0; ai < 2; ++ai)
#pragma unroll
            for (int m = 0; m < 4; ++m) { const size_t grow = (size_t)u.pm * BM + ai * HALF + wr * 64 + m * 16 + fr;
#pragma unroll
                for (int bj = 0; bj < 2; ++bj) { const size_t off = grow * 1024 + col0 + bj * HALF; f32x4 b0, b1;
                    if (bf32) { const float* bp = isx ? bx + off : bc + (off - (size_t)XROWS * 1024); b0 = *(const f32x4*)bp; b1 = *(const f32x4*)(bp + 4); }
                    else { const u32x4 w = *(const u32x4*)(bs + off);
                        b0 = (f32x4){__builtin_bit_cast(float, w.x << 16), __builtin_bit_cast(float, w.x & 0xffff0000u), __builtin_bit_cast(float, w.y << 16), __builtin_bit_cast(float, w.y & 0xffff0000u)};
                        b1 = (f32x4){__builtin_bit_cast(float, w.z << 16), __builtin_bit_cast(float, w.z & 0xffff0000u), __builtin_bit_cast(float, w.w << 16), __builtin_bit_cast(float, w.w & 0xffff0000u)}; }
                    const f32x4 o0 = b0 + gv[bj][0] * acc[ai][bj][m][0], o1 = b1 + gv[bj][1] * acc[ai][bj][m][1];
                    if (obf) { u32x4 w; w.x = cvt_pk_bf16(o0[0], o0[1]); w.y = cvt_pk_bf16(o0[2], o0[3]); w.z = cvt_pk_bf16(o1[0], o1[1]); w.w = cvt_pk_bf16(o1[2], o1[3]); *(u32x4*)(os + off) = w; }
                    else { *(f32x4*)(of + off) = o0; *(f32x4*)(of + off + 4) = o1; } } }
    }
};
struct EpiSwiglu {
    static constexpr bool PERM = true, AFTER_DRAIN = false;
    bf16_t* H;
    __device__ __forceinline__ void operator()(const f32x4 (&acc)[2][2][4][2], const Unit& u, int wr, int wc, int fr, int fq) const {
        asm volatile("" : "+v"(fr), "+v"(fq));
        bf16_t* base = H + (size_t)(u.pm * BM + wr * 64 + fr) * 2816 + u.pn * HALF + wc * 32 + 8 * fq;
#pragma unroll
        for (int ai = 0; ai < 2; ++ai)
#pragma unroll
            for (int m = 0; m < 4; ++m) { float r[8];
#pragma unroll
                for (int n = 0; n < 2; ++n)
#pragma unroll
                    for (int j = 0; j < 4; ++j) { const float g = acc[ai][0][m][n][j], up = acc[ai][1][m][n][j];
                        r[n * 4 + j] = g * __builtin_amdgcn_rcpf(1.0f + __builtin_amdgcn_exp2f(-1.4426950408889634f * g)) * up; }
                u32x4 w; w.x = cvt_pk_bf16(r[0], r[1]); w.y = cvt_pk_bf16(r[2], r[3]); w.z = cvt_pk_bf16(r[4], r[5]); w.w = cvt_pk_bf16(r[6], r[7]);
                *(u32x4*)(base + (size_t)(ai * HALF + m * 16) * 2816) = w; }
    }
};
struct EpiFour {
    static constexpr bool PERM = true, AFTER_DRAIN = false;
    bf16_t* MX; int rowbase, L; float scale;
    __device__ __forceinline__ void operator()(const f32x4 (&acc)[2][2][4][2], const Unit& u, int wr, int wc, int fr, int fq) const {
        asm volatile("" : "+v"(fr), "+v"(fq));
        bf16_t* base = MX + (size_t)(rowbase + u.pn * L + u.pm * BM + wr * 64 + fr) * 1024 + 768 + wc * 32 + 8 * fq;
#pragma unroll
        for (int ai = 0; ai < 2; ++ai)
#pragma unroll
            for (int m = 0; m < 4; ++m) { bf16_t* rowp = base + (size_t)(ai * HALF + m * 16) * 1024;
#pragma unroll
                for (int bj = 0; bj < 2; ++bj) { const f32x4 v0 = acc[ai][bj][m][0] * scale, v1 = acc[ai][bj][m][1] * scale;
                    u32x4 w; w.x = cvt_pk_bf16(v0[0], v0[1]); w.y = cvt_pk_bf16(v0[2], v0[3]); w.z = cvt_pk_bf16(v1[0], v1[1]); w.w = cvt_pk_bf16(v1[2], v1[3]);
                    *(u32x4*)(rowp + bj * HALF) = w; } }
    }
};
template <class Epi, class Sched, bool ALIGN_EPI = false, bool SP2 = false>
__device__ __forceinline__ void gemm_phase(PG8_LAS unsigned char* lds, const Gemm g, const Sched& S, const Epi& E) {
    int tid_l = threadIdx.x; asm volatile("" : "+v"(tid_l)); const int tid = tid_l, wid = __builtin_amdgcn_readfirstlane(tid >> 6), lane = tid & 63, wr = wid >> 2, wc = wid & 3, fr = lane & 15, fq = lane >> 4;
    const int K = g.K, nt = K / BK;
    unsigned voffA[2], voffB[2];
#pragma unroll
    for (int i = 0; i < 2; ++i) { int R, C; stage_rc(tid * 16 + i * 8192, R, C); const int Rb = Epi::PERM ? ((R & ~31) + perm32(R & 31)) : R;
        voffA[i] = (unsigned)(R * K + C) * 2u; voffB[i] = (unsigned)(Rb * K + C) * 2u; }
    const size_t kstep = (size_t)(BK * 2);
    const size_t hstep = (size_t)HALF * K * 2;
    const size_t tstep = 2 * hstep;
    const unsigned ldsw = (unsigned)wid * 1024u;
    const int aoff = lds_byte(wr * 64 + fr, fq * 8), boff = lds_byte(wc * 32 + fr, fq * 8);
#define PG8_SA(b, h) (((b) * 2 + (h)) * HTB)
#define PG8_SB(b, h) ((4 + (b) * 2 + (h)) * HTB)
#define PG8_STAGE(bufoff, gbase, voff) do { _Pragma("unroll") for (int _i = 0; _i < 2; ++_i) \
        __builtin_amdgcn_global_load_lds((const unsigned*)((const char*)(gbase) + (voff)[_i]), (PG8_LAS unsigned*)(lds + (bufoff) + ldsw + _i * 8192), 16, 0, 0); } while (0)
#define PG8_LDA(dst, b, h) do { _Pragma("unroll") for (int m = 0; m < 4; ++m) _Pragma("unroll") for (int k = 0; k < 2; ++k) dst[m][k] = *(const PG8_LAS bf16x8*)(lds + PG8_SA(b, h) + aoff + m * 2048 + k * 1024); } while (0)
#define PG8_LDB(dst, b, h) do { _Pragma("unroll") for (int n = 0; n < 2; ++n) _Pragma("unroll") for (int k = 0; k < 2; ++k) dst[n][k] = *(const PG8_LAS bf16x8*)(lds + PG8_SB(b, h) + boff + n * 2048 + k * 1024); } while (0)
#define PG8_MMA(ai, bj, At, Bt) do { __builtin_amdgcn_s_setprio(1); _Pragma("unroll") for (int m = 0; m < 4; ++m) _Pragma("unroll") for (int n = 0; n < 2; ++n) _Pragma("unroll") for (int k = 0; k < 2; ++k) \
        acc[ai][bj][m][n] = __builtin_amdgcn_mfma_f32_16x16x32_bf16(Bt[n][k], At[m][k], acc[ai][bj][m][n], 0, 0, 0); __builtin_amdgcn_s_setprio(0); } while (0)
#define PG8_WAIT_V(n) asm volatile("s_waitcnt vmcnt(" #n ")" ::: "memory")
#define PG8_WAIT_L(n) asm volatile("s_waitcnt lgkmcnt(" #n ")" ::: "memory")
#define PG8_BAR __builtin_amdgcn_s_barrier()
#define PG8_SCHED __builtin_amdgcn_sched_barrier(0)
    Unit cur, nxt; int ui = 0;
    if (!S.next(0, cur)) return;
    f32x4 acc[2][2][4][2];
#pragma unroll
    for (int a = 0; a < 2; ++a)
#pragma unroll
        for (int b = 0; b < 2; ++b)
#pragma unroll
            for (int m = 0; m < 4; ++m)
#pragma unroll
                for (int n = 0; n < 2; ++n) acc[a][b][m][n] = (f32x4){0.f, 0.f, 0.f, 0.f};
    bf16x8 At[4][2], B0[2][2], B1[2][2];
    const char* cA = (const char*)g.A + (size_t)cur.pm * tstep; const char* cB = (const char*)g.Bt + (size_t)cur.pn * tstep;
    S.a_ready(cur);
    if constexpr (SP2) {
        PG8_STAGE(PG8_SB(0, 0), cB, voffB); PG8_STAGE(PG8_SB(0, 1), cB + hstep, voffB); PG8_STAGE(PG8_SA(0, 0), cA, voffA); PG8_STAGE(PG8_SA(0, 1), cA + hstep, voffA);
        if (wr == 1) PG8_BAR;
        PG8_WAIT_V(2); PG8_BAR;
        PG8_STAGE(PG8_SB(1, 0), cB + kstep, voffB); PG8_STAGE(PG8_SA(1, 0), cA + kstep, voffA); PG8_STAGE(PG8_SB(1, 1), cB + hstep + kstep, voffB);
        PG8_WAIT_V(6); PG8_BAR;
    } else {
        PG8_STAGE(PG8_SB(0, 0), cB, voffB); PG8_STAGE(PG8_SA(0, 0), cA, voffA); PG8_STAGE(PG8_SB(0, 1), cB + hstep, voffB); PG8_STAGE(PG8_SA(0, 1), cA + hstep, voffA);
        if (wr == 1) PG8_BAR;
        PG8_WAIT_V(4); PG8_BAR;
        PG8_STAGE(PG8_SB(1, 0), cB + kstep, voffB); PG8_STAGE(PG8_SA(1, 0), cA + kstep, voffA); PG8_STAGE(PG8_SB(1, 1), cB + hstep + kstep, voffB);
        PG8_WAIT_V(6); PG8_BAR;
    }
    for (;;) {
        const bool has_next = S.next(ui + 1, nxt);
        const char* nA = has_next ? (const char*)g.A + (size_t)nxt.pm * tstep : cA; const char* nB = has_next ? (const char*)g.Bt + (size_t)nxt.pn * tstep : cB;
        for (int t = 0; t < nt; t += 2) {
            const bool last = (t == nt - 2);
            const char* a1 = cA + (size_t)(t + 1) * kstep;
            const char* a2 = last ? nA : cA + (size_t)(t + 2) * kstep; const char* b2 = last ? nB : cB + (size_t)(t + 2) * kstep;
            const char* a3 = a2 + kstep; const char* b3 = b2 + kstep;
            if (last && has_next) S.a_ready(nxt);
            if constexpr (SP2) {
            PG8_LDB(B0, 0, 0); PG8_LDB(B1, 0, 1); PG8_SCHED; PG8_LDA(At, 0, 0); PG8_STAGE(PG8_SA(1, 1), a1 + hstep, voffA);
            PG8_WAIT_V(8); PG8_WAIT_L(0); PG8_BAR; PG8_MMA(0, 0, At, B0); PG8_MMA(0, 1, At, B1); PG8_BAR; PG8_SCHED;
            PG8_LDA(At, 0, 1); PG8_STAGE(PG8_SB(0, 0), b2, voffB); PG8_STAGE(PG8_SB(0, 1), b2 + hstep, voffB); PG8_STAGE(PG8_SA(0, 0), a2, voffA);
            PG8_WAIT_V(8); PG8_WAIT_L(0); PG8_BAR; PG8_MMA(1, 0, At, B0); PG8_MMA(1, 1, At, B1); PG8_BAR; PG8_SCHED;
            PG8_LDB(B0, 1, 0); PG8_LDB(B1, 1, 1); PG8_SCHED; PG8_LDA(At, 1, 0); PG8_STAGE(PG8_SA(0, 1), a2 + hstep, voffA);
            PG8_WAIT_V(8); PG8_WAIT_L(0); PG8_BAR; PG8_MMA(0, 0, At, B0); PG8_MMA(0, 1, At, B1); PG8_BAR; PG8_SCHED;
            PG8_LDA(At, 1, 1); PG8_STAGE(PG8_SB(1, 0), b3, voffB); PG8_STAGE(PG8_SB(1, 1), b3 + hstep, voffB); PG8_STAGE(PG8_SA(1, 0), a3, voffA);
            PG8_WAIT_V(8); PG8_WAIT_L(0); PG8_BAR; PG8_MMA(1, 0, At, B0); PG8_MMA(1, 1, At, B1); PG8_BAR; PG8_SCHED;
            } else {
            PG8_LDB(B0, 0, 0); PG8_SCHED; PG8_LDA(At, 0, 0); PG8_STAGE(PG8_SA(1, 1), a1 + hstep, voffA);
            PG8_WAIT_L(8); PG8_BAR; PG8_WAIT_L(0); PG8_MMA(0, 0, At, B0); PG8_BAR; PG8_SCHED;
            PG8_LDB(B1, 0, 1); PG8_STAGE(PG8_SB(0, 0), b2, voffB);
            PG8_BAR; PG8_WAIT_L(0); PG8_MMA(0, 1, At, B1); PG8_BAR;
            PG8_LDA(At, 0, 1); PG8_STAGE(PG8_SA(0, 0), a2, voffA);
            PG8_BAR; PG8_WAIT_L(0); PG8_MMA(1, 0, At, B0); PG8_BAR; PG8_SCHED;
            PG8_STAGE(PG8_SB(0, 1), b2 + hstep, voffB);
            PG8_WAIT_V(6); PG8_BAR; PG8_MMA(1, 1, At, B1); PG8_BAR;
            PG8_LDB(B0, 1, 0); PG8_SCHED; PG8_LDA(At, 1, 0); PG8_STAGE(PG8_SA(0, 1), a2 + hstep, voffA);
            PG8_WAIT_L(8); PG8_BAR; PG8_WAIT_L(0); PG8_MMA(0, 0, At, B0); PG8_BAR; PG8_SCHED;
            PG8_LDB(B1, 1, 1); PG8_STAGE(PG8_SB(1, 0), b3, voffB);
            PG8_BAR; PG8_WAIT_L(0); PG8_MMA(0, 1, At, B1); PG8_BAR;
            PG8_LDA(At, 1, 1); PG8_STAGE(PG8_SA(1, 0), a3, voffA);
            PG8_BAR; PG8_WAIT_L(0); PG8_MMA(1, 0, At, B0); PG8_BAR; PG8_SCHED;
            PG8_STAGE(PG8_SB(1, 1), b3 + hstep, voffB);
            PG8_WAIT_V(6); PG8_BAR; PG8_MMA(1, 1, At, B1); PG8_BAR;
            }
        }
        if constexpr (ALIGN_EPI) { if (wr == 0) PG8_BAR; }
        if constexpr (!Epi::AFTER_DRAIN) { E(acc, cur, wr, wc, fr, fq); S.done(cur); }
        if (!has_next) break;
#pragma unroll
        for (int a = 0; a < 2; ++a)
#pragma unroll
            for (int b = 0; b < 2; ++b)
#pragma unroll
                for (int m = 0; m < 4; ++m)
#pragma unroll
                    for (int n = 0; n < 2; ++n) acc[a][b][m][n] = (f32x4){0.f, 0.f, 0.f, 0.f};
        cur = nxt; cA = nA; cB = nB; ++ui;
        if constexpr (ALIGN_EPI) { if (wr == 1) PG8_BAR; }
    }
    PG8_WAIT_V(0);
    if constexpr (!ALIGN_EPI) { if (wr == 0) PG8_BAR; }
    PG8_BAR;
    if constexpr (Epi::AFTER_DRAIN) { E.fused(acc, cur, wr, wc, fr, fq, lds, wid, lane); S.done(cur); }
#undef PG8_SA
#undef PG8_SB
#undef PG8_STAGE
#undef PG8_LDA
#undef PG8_LDB
#undef PG8_MMA
#undef PG8_WAIT_V
#undef PG8_WAIT_L
#undef PG8_BAR
#undef PG8_SCHED
}
}
namespace attn_body {
using bf16=__hip_bfloat16;
using bf16x8=__attribute__((ext_vector_type(8)))short;
using s16x4=__attribute__((ext_vector_type(4)))short;
using f32x16=__attribute__((ext_vector_type(16)))float;
using u32x4=__attribute__((ext_vector_type(4)))unsigned;
constexpr int D=64,QPITCH=512,KVPITCH=128,OPITCH=1024;
constexpr int NW=8,QBLK=32,QB=QBLK*NW,KVBLK=64;

__device__ __forceinline__ int crow(int r,int hi){return (r&3)+8*(r>>2)+4*hi;}
#define SBAR() __builtin_amdgcn_sched_barrier(0)
__device__ __forceinline__ void cmask(f32x16&p0,f32x16&p1,int jb,int qrel,int hi){
  const float NEG=-INFINITY; int kb=64*jb+4*hi;
  #pragma unroll
  for(int r=0;r<16;++r){int kv=kb+(r&3)+8*(r>>2); if(kv>qrel)p0[r]=NEG; if(kv+32>qrel)p1[r]=NEG;}
}

constexpr int NSLOT=3, SLOTB=8192;
constexpr int LDS_K=0, LDS_V=NSLOT*SLOTB, LDS_WS=2*NSLOT*SLOTB, LDS_OST=LDS_WS+NW*64*4, LDS_BYTES=LDS_OST+NW*4096;
constexpr float C2=0.125f*1.4426950408889634f;
__device__ __forceinline__ void glds16(const void*gsrc,unsigned lds_dst){unsigned keep;
  asm volatile("s_mov_b32 %0, m0\n\ts_mov_b32 m0, %2\n\ts_nop 0\n\tglobal_load_lds_dwordx4 %1, off\n\ts_mov_b32 m0, %0":"=&s"(keep):"v"(gsrc),"s"(lds_dst):"memory");}
__device__ __forceinline__ float max3f(float a,float b,float c){float r;asm("v_max3_f32 %0, %1, %2, %3":"=v"(r):"v"(a),"v"(b),"v"(c));return r;}
__device__ __forceinline__ float max2f(float a,float b){float r;asm("v_max_f32_e32 %0, %1, %2":"=v"(r):"v"(a),"v"(b));return r;}
__device__ __forceinline__ float fadd_s(float a,float b){float r;asm("v_add_f32_e32 %0, %1, %2":"=v"(r):"v"(a),"v"(b));return r;}
__device__ __forceinline__ float fsub_s(float a,float b){float r;asm("v_sub_f32_e32 %0, %1, %2":"=v"(r):"v"(a),"v"(b));return r;}
typedef float f32x2_t __attribute__((ext_vector_type(2))); typedef __bf16 bf16x2_t __attribute__((ext_vector_type(2)));
__device__ __forceinline__ unsigned cvtpk_s(float lo,float hi){f32x2_t v={lo,hi};bf16x2_t b=__builtin_convertvector(v,bf16x2_t);return __builtin_bit_cast(unsigned,b);}
#define WAIT_BAR(N) asm volatile("s_waitcnt vmcnt(" #N ") lgkmcnt(0)\n\ts_barrier":::"memory")

__device__ __forceinline__ void qkt(f32x16&p0,f32x16&p1,const char*Kslot,const bf16x8*qr,const f32x16&negm,int r32,int hi){
  const char*kb=Kslot+hi*1024+r32*16;
  #pragma unroll
  for(int d0=0;d0<4;++d0){
    const bf16x8 b0=*reinterpret_cast<const bf16x8*>(kb+d0*2048);
    const bf16x8 b1=*reinterpret_cast<const bf16x8*>(kb+d0*2048+512);
    if(d0==0){p0=__builtin_amdgcn_mfma_f32_32x32x16_bf16(b0,qr[0],negm,0,0,0);p1=__builtin_amdgcn_mfma_f32_32x32x16_bf16(b1,qr[0],negm,0,0,0);}
    else{p0=__builtin_amdgcn_mfma_f32_32x32x16_bf16(b0,qr[d0],p0,0,0,0);p1=__builtin_amdgcn_mfma_f32_32x32x16_bf16(b1,qr[d0],p1,0,0,0);}}
}
typedef __attribute__((address_space(3))) const char* lds_cptr;
typedef short v4i16_t __attribute__((ext_vector_type(4)));
__device__ __forceinline__ void kload8(bf16x8*kf,lds_cptr kp){
  kf[0]=*(const __attribute__((address_space(3))) bf16x8*)(kp);      kf[1]=*(const __attribute__((address_space(3))) bf16x8*)(kp+512);
  kf[2]=*(const __attribute__((address_space(3))) bf16x8*)(kp+2048); kf[3]=*(const __attribute__((address_space(3))) bf16x8*)(kp+2560);
  kf[4]=*(const __attribute__((address_space(3))) bf16x8*)(kp+4096); kf[5]=*(const __attribute__((address_space(3))) bf16x8*)(kp+4608);
  kf[6]=*(const __attribute__((address_space(3))) bf16x8*)(kp+6144); kf[7]=*(const __attribute__((address_space(3))) bf16x8*)(kp+6656);
}
__device__ __forceinline__ void kload2(bf16x8*kf,lds_cptr kp,int j){ kf[2*j]=*(const __attribute__((address_space(3))) bf16x8*)(kp+j*2048); kf[2*j+1]=*(const __attribute__((address_space(3))) bf16x8*)(kp+j*2048+512); }
__device__ __forceinline__ s16x4 vtr(lds_cptr p){ return __builtin_bit_cast(s16x4,__builtin_amdgcn_ds_read_tr16_b64_v4i16((__attribute__((address_space(3))) v4i16_t*)p)); }
__device__ __forceinline__ float rowmax(const f32x16&p0,const f32x16&p1){
  float a=max3f(p0[0],p0[1],p1[0]),b=max3f(p0[2],p0[3],p1[1]);a=max3f(a,p1[2],p1[3]);
  #pragma unroll
  for(int r=4;r<16;r+=4){a=max3f(a,p0[r],p0[r+1]);b=max3f(b,p0[r+2],p0[r+3]);a=max3f(a,p1[r],p1[r+1]);b=max3f(b,p1[r+2],p1[r+3]);}
  const float m=max2f(a,b);
  auto rr=__builtin_amdgcn_permlane32_swap(__float_as_uint(m),__float_as_uint(m),false,false);
  return max2f(__uint_as_float(rr[0]),__uint_as_float(rr[1]));
}
__device__ __forceinline__ void pv(f32x16*o,int vb,bf16x8 pa0,bf16x8 pa1,bf16x8 pa2,bf16x8 pa3){
  #pragma unroll
  for(int d0=0;d0<2;++d0){s16x4 lo[4],hi[4];
    #pragma unroll
    for(int ks=0;ks<4;++ks){
      asm volatile("ds_read_b64_tr_b16 %0,%1 offset:%c2":"=&v"(lo[ks]):"v"(vb),"i"(d0*4096+ks*1024):"memory");
      asm volatile("ds_read_b64_tr_b16 %0,%1 offset:%c2":"=&v"(hi[ks]):"v"(vb),"i"(d0*4096+ks*1024+512):"memory");}
    asm volatile("s_waitcnt lgkmcnt(0)":::"memory");SBAR();
    #define PK(k) (bf16x8){lo[k][0],lo[k][1],lo[k][2],lo[k][3],hi[k][0],hi[k][1],hi[k][2],hi[k][3]}
    o[d0]=__builtin_amdgcn_mfma_f32_32x32x16_bf16(pa0,PK(0),o[d0],0,0,0);
    o[d0]=__builtin_amdgcn_mfma_f32_32x32x16_bf16(pa1,PK(1),o[d0],0,0,0);
    o[d0]=__builtin_amdgcn_mfma_f32_32x32x16_bf16(pa2,PK(2),o[d0],0,0,0);
    o[d0]=__builtin_amdgcn_mfma_f32_32x32x16_bf16(pa3,PK(3),o[d0],0,0,0);
    #undef PK
  }
}

#ifndef ATTN_STORE16
#define ATTN_STORE16(p,v) (*(u32x4*)(p)=(v))
#endif
template<int THRL> __device__ __forceinline__ void attn_unit(const bf16*Qu,const bf16*__restrict__ Kh,const bf16*__restrict__ Vh,bf16*Ou,const int NT,char*shm){
  int tid_l=threadIdx.x; asm volatile("":"+v"(tid_l)); const int tid=tid_l,lane=tid&63,r32=lane&31,hi=lane>>5; const int wid=__builtin_amdgcn_readfirstlane(tid>>6);
  const bf16*Qw=Qu+(long)(wid*QBLK)*QPITCH;
  const unsigned lds0=(unsigned)(uintptr_t)shm;
  float*wsf=(float*)(shm+LDS_WS)+wid*64;
  const bf16*ksrc=Kh+(long)lane*KVPITCH+wid*8;
  const bf16*vsrc=Vh+(long)(16*(wid&3)+(lane>>2))*KVPITCH+(wid>>2)*32+(lane&3)*8;
  const unsigned kdst=lds0+LDS_K+wid*1024, vdst=lds0+LDS_V+wid*1024;
  #define DMA_K(t,slot) glds16(ksrc+(long)(t)*KVBLK*KVPITCH,(unsigned)__builtin_amdgcn_readfirstlane(kdst+(slot)))
  #define DMA_V(t,slot) glds16(vsrc+(long)(t)*KVBLK*KVPITCH,(unsigned)__builtin_amdgcn_readfirstlane(vdst+(slot)))
  const int vb0=(int)(lds0+LDS_V)+((lane>>4)&1)*32+(lane&3)*8+(4*hi+((lane&15)>>2))*64;
  const char*Kbase=shm+LDS_K; bf16x8 kf[8];
  const lds_cptr shm3=(lds_cptr)shm; const lds_cptr kp0=shm3+LDS_K+hi*1024+r32*16; const lds_cptr vp0=shm3+LDS_V+((lane>>4)&1)*32+(lane&3)*8+(4*hi+((lane&15)>>2))*64;
  DMA_K(0,0);DMA_V(0,0);DMA_K(1,SLOTB);
  bf16x8 qr[4];
  #pragma unroll
  for(int d0=0;d0<4;++d0)qr[d0]=*reinterpret_cast<const bf16x8*>(&Qw[(long)r32*QPITCH+d0*16+hi*8]);
  float mhat=0.f,l_reg=0.f;f32x16 o[2];o[0]=f32x16{};o[1]=f32x16{};f32x16 negm=f32x16{};asm volatile("":"+v"(negm));
  #define CMASK(P0,P1,t) do{}while(0)
  bool resc=false;
  #define START(P0,P1) do{ const float rm=rowmax(P0,P1); resc=false; \
    { const float dl=rm; mhat=fadd_s(mhat,dl); \
      _Pragma("unroll") for(int r=0;r<16;++r){P0[r]=fsub_s(P0[r],dl);P1[r]=fsub_s(P1[r],dl);} \
      _Pragma("unroll") for(int r=0;r<16;++r)negm[r]=-mhat; asm volatile("":"+v"(negm)); } \
    _Pragma("unroll") for(int r=0;r<16;++r)P0[r]=__builtin_amdgcn_exp2f(P0[r]); }while(0)
  #define RESC() do{ if(resc){ asm volatile("s_waitcnt lgkmcnt(0)":::"memory"); \
      _Pragma("unroll") for(int d_=0;d_<2;++d_) _Pragma("unroll") for(int r=0;r<16;++r)o[d_][r]*=wsf[crow(r,hi)]; } }while(0)
  f32x16 pA0,pA1,pB0,pB1;
  int sl_prev=0,sl_cur=0,sl_next=SLOTB;
  #define ROT() do{sl_prev=sl_cur;sl_cur=sl_next;sl_next=(sl_next==(NSLOT-1)*SLOTB)?0:sl_next+SLOTB;}while(0)
  DMA_K(2,2*SLOTB);
  WAIT_BAR(3);
  qkt(pA0,pA1,Kbase,qr,negm,r32,hi);asm volatile("s_nop 15\n\ts_nop 7":"+v"(pA0),"+v"(pA1));CMASK(pA0,pA1,0);
  START(pA0,pA1);
  _Pragma("unroll") for(int r=0;r<16;++r)pA1[r]=__builtin_amdgcn_exp2f(pA1[r]);
  WAIT_BAR(0);
  DMA_K(3,0);DMA_V(1,SLOTB);
  ROT();
  kload8(kf,kp0+sl_cur);
  WAIT_BAR(2);
  s16x4 vlo[8],vhi[8]; u32x4 pw0,pw1,pw2,pw3;
  #define PKW(P,B) cvtpk_s(P[B],P[B+1])
  #define PAF(k) __builtin_bit_cast(bf16x8,pw##k)
  #define VFR(i) (bf16x8){vlo[i][0],vlo[i][1],vlo[i][2],vlo[i][3],vhi[i][0],vhi[i][1],vhi[i][2],vhi[i][3]}
  #define PIN(x) asm volatile("":"+v"(x))
  #define MX3(a,b,c) __builtin_fmaxf(__builtin_fmaxf((a),(b)),(c))
  #define GAPA(MF,A0,A1,A2,A3,W0,W1,PW) do{ MF; sacc+=A0; sacc+=A1; sacc+=A2; sacc+=A3; PIN(sacc); W0; W1; PIN(PW); SBAR(); }while(0)
  #define EX(v) __builtin_amdgcn_exp2f(v)
  #define GAPB(MF,X,B) do{ MF; X[B]=EX(X[B]); X[B+1]=EX(X[B+1]); X[B+2]=EX(X[B+2]); X[B+3]=EX(X[B+3]); PIN(X); SBAR(); }while(0)
  #define VRD(i) do{ vlo[i]=vtr(vp_+(((i)>>2)*4096+((i)&3)*1024)); vhi[i]=vtr(vp_+(((i)>>2)*4096+((i)&3)*1024+512)); }while(0)
  #define KRD(G,j) do{ if(G){ kload2(kf,kp0+sl_next,j); SBAR(); } }while(0)
  #define STEP(C0,C1,P0,P1,t,GK,GV,GL) do{ SBAR(); \
    const lds_cptr vp_=vp0+sl_prev; \
    VRD(0); SBAR(); float sacc=(P0[0]+P0[1]); \
    GAPA(C0=__builtin_amdgcn_mfma_f32_32x32x16_bf16(kf[0],qr[0],negm,0,0,0), P0[2],P0[3],P0[4],P0[5],     pw0[0]=PKW(P0,0), pw0[1]=PKW(P0,2), pw0); \
    VRD(4); SBAR(); GAPA(C1=__builtin_amdgcn_mfma_f32_32x32x16_bf16(kf[1],qr[0],negm,0,0,0), P0[6],P0[7],P0[8],P0[9],     pw0[2]=PKW(P0,4), pw0[3]=PKW(P0,6), pw0); \
    VRD(1); SBAR(); GAPA(C0=__builtin_amdgcn_mfma_f32_32x32x16_bf16(kf[2],qr[1],C0,0,0,0),   P0[10],P0[11],P0[12],P0[13], pw1[0]=PKW(P0,8), pw1[1]=PKW(P0,10), pw1); \
    VRD(5); SBAR(); GAPA(C1=__builtin_amdgcn_mfma_f32_32x32x16_bf16(kf[3],qr[1],C1,0,0,0),   P0[14],P0[15],P1[0],P1[1],   pw1[2]=PKW(P0,12),pw1[3]=PKW(P0,14), pw1); \
    VRD(2); SBAR(); GAPA(C0=__builtin_amdgcn_mfma_f32_32x32x16_bf16(kf[4],qr[2],C0,0,0,0),   P1[2],P1[3],P1[4],P1[5],     pw2[0]=PKW(P1,0), pw2[1]=PKW(P1,2), pw2); \
    VRD(6); SBAR(); GAPA(C1=__builtin_amdgcn_mfma_f32_32x32x16_bf16(kf[5],qr[2],C1,0,0,0),   P1[6],P1[7],P1[8],P1[9],     pw2[2]=PKW(P1,4), pw2[3]=PKW(P1,6), pw2); \
    VRD(3); SBAR(); GAPA(C0=__builtin_amdgcn_mfma_f32_32x32x16_bf16(kf[6],qr[3],C0,0,0,0),   P1[10],P1[11],P1[12],P1[13], pw3[0]=PKW(P1,8), pw3[1]=PKW(P1,10), pw3); \
    VRD(7); SBAR(); GAPA(C1=__builtin_amdgcn_mfma_f32_32x32x16_bf16(kf[7],qr[3],C1,0,0,0),   P1[14],P1[15],0.f,0.f,       pw3[2]=PKW(P1,12),pw3[3]=PKW(P1,14), pw3); \
    l_reg+=sacc; \
    if(GK){DMA_K((t)+3,sl_cur);} if(GV){DMA_V((t)+1,sl_next);} \
    CMASK(C0,C1,t); \
    { float a=MX3(C0[0],C0[1],C1[0]),b=MX3(C0[2],C0[3],C1[1]); a=MX3(a,C1[2],C1[3]); \
      _Pragma("unroll") for(int r=4;r<16;r+=4){a=MX3(a,C0[r],C0[r+1]);b=MX3(b,C0[r+2],C0[r+3]);a=MX3(a,C1[r],C1[r+1]);b=MX3(b,C1[r+2],C1[r+3]);} \
      float rm=__builtin_fmaxf(a,b); { auto rr=__builtin_amdgcn_permlane32_swap(__float_as_uint(rm),__float_as_uint(rm),false,false); rm=__builtin_fmaxf(__uint_as_float(rr[0]),__uint_as_float(rr[1])); } \
      resc=false; \
      if(__builtin_expect(__any(rm>(float)THRL),0)){ const float dl=__builtin_fmaxf(rm,0.f); mhat+=dl; \
        _Pragma("unroll") for(int r=0;r<16;++r){C0[r]-=dl;C1[r]-=dl;} \
        _Pragma("unroll") for(int r=0;r<16;++r)negm[r]=-mhat; asm volatile("":"+v"(negm)); \
        const float f=__builtin_amdgcn_exp2f(-dl); l_reg*=f; if(hi==0)wsf[r32]=f; resc=true; } } \
    SBAR(); \
    GAPB(o[0]=__builtin_amdgcn_mfma_f32_32x32x16_bf16(PAF(0),VFR(0),o[0],0,0,0), C0,0); \
    GAPB(o[1]=__builtin_amdgcn_mfma_f32_32x32x16_bf16(PAF(0),VFR(4),o[1],0,0,0), C0,4); \
    KRD(GL,0); GAPB(o[0]=__builtin_amdgcn_mfma_f32_32x32x16_bf16(PAF(1),VFR(1),o[0],0,0,0), C0,8); \
    KRD(GL,1); GAPB(o[1]=__builtin_amdgcn_mfma_f32_32x32x16_bf16(PAF(1),VFR(5),o[1],0,0,0), C0,12); \
    KRD(GL,2); GAPB(o[0]=__builtin_amdgcn_mfma_f32_32x32x16_bf16(PAF(2),VFR(2),o[0],0,0,0), C1,0); \
    KRD(GL,3); GAPB(o[1]=__builtin_amdgcn_mfma_f32_32x32x16_bf16(PAF(2),VFR(6),o[1],0,0,0), C1,4); \
    GAPB(o[0]=__builtin_amdgcn_mfma_f32_32x32x16_bf16(PAF(3),VFR(3),o[0],0,0,0), C1,8); \
    GAPB(o[1]=__builtin_amdgcn_mfma_f32_32x32x16_bf16(PAF(3),VFR(7),o[1],0,0,0), C1,12); \
    }while(0)
  int t=1;
  #undef CMASK
  #define CMASK(P0,P1,t) do{}while(0)
  for(;t+5<NT;t+=2){
    STEP(pB0,pB1,pA0,pA1,t,true,true,true);     WAIT_BAR(2); RESC(); ROT();
    STEP(pA0,pA1,pB0,pB1,t+1,true,true,true);   WAIT_BAR(2); RESC(); ROT();
  }
  #undef CMASK
  #define CMASK(P0,P1,t) do{}while(0)
  #define ENDW(tt) do{ if((tt)+3<NT){WAIT_BAR(2);} else if((tt)+2<NT){WAIT_BAR(1);} else {WAIT_BAR(0);} }while(0)
  for(;t+1<NT;t+=2){
    STEP(pB0,pB1,pA0,pA1,t,(t+3<NT),(t+1<NT),(t+1<NT));       ENDW(t);   RESC(); ROT();
    STEP(pA0,pA1,pB0,pB1,t+1,(t+4<NT),(t+2<NT),(t+2<NT));     ENDW(t+1); RESC(); ROT();
  }
  STEP(pB0,pB1,pA0,pA1,NT-1,false,false,false); RESC();
  { float sacc=pB0[0]+pB0[1]; _Pragma("unroll") for(int r=2;r<16;++r)sacc+=pB0[r]; _Pragma("unroll") for(int r=0;r<16;++r)sacc+=pB1[r]; l_reg+=sacc;
    pw0=(u32x4){PKW(pB0,0),PKW(pB0,2),PKW(pB0,4),PKW(pB0,6)};pw1=(u32x4){PKW(pB0,8),PKW(pB0,10),PKW(pB0,12),PKW(pB0,14)};pw2=(u32x4){PKW(pB1,0),PKW(pB1,2),PKW(pB1,4),PKW(pB1,6)};pw3=(u32x4){PKW(pB1,8),PKW(pB1,10),PKW(pB1,12),PKW(pB1,14)};
    SBAR(); pv(o,vb0+sl_cur,PAF(0),PAF(1),PAF(2),PAF(3)); }
  #undef PKW
  #undef PAF
  #undef VFR
  #undef PIN
  #undef MX3
  #undef GAPA
  #undef GAPB
  #undef EX
  #undef VRD
  #undef KRD
  #undef STEP
  #undef ENDW
  {auto rr=__builtin_amdgcn_permlane32_swap(__float_as_uint(l_reg),__float_as_uint(l_reg),false,false);l_reg=__uint_as_float(rr[0])+__uint_as_float(rr[1]);}
  if(hi==0)wsf[32+r32]=l_reg;asm volatile("s_waitcnt lgkmcnt(0)":::"memory");
  float rli[16];
  #pragma unroll
  for(int r=0;r<16;++r)rli[r]=__builtin_amdgcn_rcpf(wsf[32+crow(r,hi)]);
  bf16*Ow=Ou+(long)(wid*QBLK)*OPITCH;
  { bf16*stg=(bf16*)(shm+LDS_OST)+wid*2048;
    #pragma unroll
    for(int r=0;r<16;++r){const int orow=crow(r,hi);
      #pragma unroll
      for(int d0=0;d0<2;++d0)stg[orow*64+d0*32+r32]=__float2bfloat16(o[d0][r]*rli[r]);}
    asm volatile("s_waitcnt lgkmcnt(0)":::"memory");
    #pragma unroll
    for(int i=0;i<4;++i){const int row=i*8+(lane>>3),ch=lane&7; const u32x4 v=*(const u32x4*)(stg+row*64+ch*8); ATTN_STORE16(Ow+(long)row*OPITCH+ch*8,v);} }
  asm volatile("s_waitcnt lgkmcnt(0)\n\ts_barrier":::"memory");
  #undef DMA_K
  #undef DMA_V
  #undef CMASK
  #undef START
  #undef RESC
  #undef ROT
}
#undef SBAR
#undef WAIT_BAR
}
namespace cg = cooperative_groups;
#define LAS __attribute__((address_space(3)))
typedef unsigned short bf16;
typedef unsigned v4u __attribute__((ext_vector_type(4)));
typedef unsigned v2u __attribute__((ext_vector_type(2)));
typedef float f32x4 __attribute__((ext_vector_type(4)));
constexpr int NWAVES = 8, NTHR = 512;
constexpr int DMODEL = 1024, NBATCH = 16, SEQ = 4096, CTX = 256, MXR = NBATCH * SEQ, MCR = NBATCH * CTX, MTR = MXR + MCR;
constexpr int NIN = 1536, DFF = 2816, NGU = 5632, KVL = SEQ + CTX, INW = 1280, MODW_ = 6144;
constexpr size_t MiB = 1u << 20;
constexpr size_t WS_MOD = 0, WS_WIN = 1 * MiB, WS_WOUT = 7 * MiB, WS_WGU = 11 * MiB, WS_WDN = 33 * MiB, WS_TRIG = 44 * MiB, WS_TRIGC = 108 * MiB,
                 WS_CX = 109 * MiB, WS_KP = 125 * MiB, WS_VP = 142 * MiB, WS_HX = 159 * MiB, WS_Z = 295 * MiB, WS_PQT = 431 * MiB, WS_PQTC = 495 * MiB,
                 WS_QP = 499 * MiB, WS_MX = 567 * MiB, WS_H = 295 * MiB, WS_XS = 703 * MiB, WS_PQF = 839 * MiB, WS_PQFC = 871 * MiB, WS_END = 873 * MiB, WS_CTL = 896 * 1024, CTL_BYTES = 16384;
static_assert(WS_H + (size_t)MTR * DFF * 2 <= WS_END && WS_MX + (size_t)MTR * 1024 * 2 <= WS_END && WS_KP + (size_t)NBATCH * KVL * 128 * 2 <= WS_VP, "ws map");
constexpr int LDS_BYTES = 147456;
constexpr float QSCALE = 0.125f * 1.4426950408889634f;

struct P { const float *x, *c, *ctx, *c_ctx, *w_ada, *b_ada, *g_mix, *g_ffn, *w_in, *q_gain, *k_gain, *w_pool, *pool_scale, *w_four, *w_out, *w_gate_up, *w_down; float* out; unsigned char* ws; };

__device__ __forceinline__ unsigned f2bf(float f) { unsigned u = __builtin_bit_cast(unsigned, f); return (u + 0x7fffu + ((u >> 16) & 1u)) >> 16; }
__device__ __forceinline__ unsigned pk2(float lo, float hi) { return f2bf(lo) | (f2bf(hi) << 16); }
__device__ __forceinline__ float bf2f(unsigned short h) { return __builtin_bit_cast(float, (unsigned)h << 16); }
__device__ __forceinline__ float shx(float v, int o, int lane) { return __builtin_bit_cast(float, __builtin_amdgcn_ds_bpermute((lane ^ o) << 2, __builtin_bit_cast(int, v))); }
__device__ __forceinline__ float wave_sum(float v, int lane) {
    v += shx(v, 1, lane); v += shx(v, 2, lane); v += shx(v, 4, lane); v += shx(v, 8, lane); v += shx(v, 16, lane); v += shx(v, 32, lane);
    return v;
}

__device__ __forceinline__ void p0_mod(const P& p, LAS unsigned char* lds, int tid, int wave, int lane) {
    LAS float* sc = (LAS float*)lds;
    LAS float* red = (LAS float*)(lds + 69632);
    float* MOD = (float*)(p.ws + WS_MOD);
    if ((int)blockIdx.x >= 192) return;
    for (int i = tid; i < 17 * 1024; i += NTHR) { const int r = i >> 10, k = i & 1023; const float v = r < 16 ? p.c[r * 1024 + k] : p.c_ctx[k]; sc[i] = v / (1.0f + __expf(-v)); }
    __syncthreads();
    for (int it = blockIdx.x; it < 192; it += gridDim.x) {
        const int layer = it / 96, n0 = (it % 96) * 64;
        float acc[17];
#pragma unroll
        for (int r = 0; r < 17; ++r) acc[r] = 0.f;
        const float* W = p.w_ada + ((size_t)layer * 1024 + wave * 128) * MODW_ + n0 + lane;
        for (int kc = 0; kc < 128; kc += 16) { float wv[16];
#pragma unroll
            for (int j = 0; j < 16; ++j) wv[j] = W[(size_t)(kc + j) * MODW_];
#pragma unroll
            for (int j = 0; j < 16; ++j)
#pragma unroll
                for (int r = 0; r < 17; ++r) acc[r] += sc[r * 1024 + wave * 128 + kc + j] * wv[j]; }
#pragma unroll
        for (int r = 0; r < 17; ++r) red[(wave * 17 + r) * 64 + lane] = acc[r];
        __syncthreads();
        for (int i = tid; i < 17 * 64; i += NTHR) { const int r = i >> 6, l = i & 63; float s = p.b_ada[layer * MODW_ + n0 + l];
#pragma unroll
            for (int w = 0; w < 8; ++w) s += red[(w * 17 + r) * 64 + l];
            MOD[((size_t)layer * 17 + r) * MODW_ + n0 + l] = s; }
        __syncthreads();
    }
}
__device__ __forceinline__ void p0_comp(const P& p, LAS unsigned char* lds, int tid) {
    LAS float* M2 = (LAS float*)lds;
    LAS float* tile = (LAS float*)(lds + 16384);
    for (int it = (int)gridDim.x - 1 - (int)blockIdx.x; it < 192; it += gridDim.x) {
        const int kc = it & 7, g = (it >> 3) & 3, ty = (it >> 5) % 3, layer = it / 96;
        const int k0 = kc * 128;
        LAS float* wfs = (LAS float*)(lds + 49664);
        if (ty != 0) { for (int i = tid; i < 4096; i += NTHR) wfs[i] = p.w_four[(size_t)(layer * 4 + g) * 4096 + i]; __syncthreads(); }
        for (int i = tid; i < 4096; i += NTHR) { const int c = i >> 6, d = i & 63; float v;
            if (ty == 0) v = p.w_pool[((size_t)(layer * 4 + g) * 64 + c) * 64 + d] * p.pool_scale[layer * 256 + g * 64 + d];
            else { v = 0.f;
#pragma unroll 8
                for (int m = 0; m < 64; ++m) { const float rev = (float)((m * c) & 63) * (1.0f / 64.0f); const float t = ty == 1 ? __builtin_amdgcn_cosf(rev) : __builtin_amdgcn_sinf(rev); v += t * wfs[m * 64 + d]; } }
            M2[i] = v; }
        const int srccol = (ty == 0 ? 768 : 1024) + g * 64;
        for (int i = tid; i < 128 * 64; i += NTHR) { const int kk = i >> 6, c = i & 63; tile[kk * 65 + c] = p.w_in[((size_t)layer * 1024 + k0 + kk) * INW + srccol + c]; }
        __syncthreads();
        { const int d = tid & 63, kg = tid >> 6;
          bf16* dst = (bf16*)(p.ws + WS_WIN) + ((size_t)layer * NIN + 768 + ty * 256 + g * 64 + d) * 1024 + k0 + kg * 16;
          float o[16];
#pragma unroll
          for (int j = 0; j < 16; ++j) o[j] = 0.f;
          for (int c = 0; c < 64; ++c) { const float mv = M2[c * 64 + d];
#pragma unroll
              for (int j = 0; j < 16; ++j) o[j] += tile[(kg * 16 + j) * 65 + c] * mv; }
          v4u w0, w1; w0.x = pk2(o[0], o[1]); w0.y = pk2(o[2], o[3]); w0.z = pk2(o[4], o[5]); w0.w = pk2(o[6], o[7]);
          w1.x = pk2(o[8], o[9]); w1.y = pk2(o[10], o[11]); w1.z = pk2(o[12], o[13]); w1.w = pk2(o[14], o[15]);
          *(v4u*)dst = w0; *(v4u*)(dst + 8) = w1; }
        __syncthreads();
    }
}
__device__ __forceinline__ void tr_item(const float* W, int ldw, int c0, int k0, bf16* WT, int K, int r0, LAS float* scr, int lane) {
#pragma unroll 8
    for (int i = 0; i < 32; ++i) { const int kk = 2 * i + (lane >> 5); scr[kk * 33 + (lane & 31)] = W[(size_t)(k0 + kk) * ldw + c0 + (lane & 31)]; }
    asm volatile("s_waitcnt lgkmcnt(0)" ::: "memory");
    const int c = lane & 7;
#pragma unroll
    for (int j = 0; j < 4; ++j) { const int n = (lane >> 3) + 8 * j; const LAS float* s = scr + (8 * c) * 33 + n;
        v4u o; o.x = pk2(s[0 * 33], s[1 * 33]); o.y = pk2(s[2 * 33], s[3 * 33]); o.z = pk2(s[4 * 33], s[5 * 33]); o.w = pk2(s[6 * 33], s[7 * 33]);
        *(v4u*)(WT + (size_t)(r0 + n) * K + k0 + 8 * c) = o; }
    asm volatile("s_waitcnt lgkmcnt(0)" ::: "memory");
}
__device__ __forceinline__ void p0_transposes(const P& p, LAS unsigned char* lds, int wave, int lane) {
    LAS float* scr = (LAS float*)(lds + wave * 16384);
    const int gw = blockIdx.x * NWAVES + wave, NGW = gridDim.x * NWAVES;
    constexpr int I_IN = 24 * 16, I_OUT = 32 * 16, I_GU = 176 * 16, I_DN = 32 * 44, I_L = I_IN + I_OUT + I_GU + I_DN;
    for (int it = gw; it < 2 * I_L; it += NGW) {
        const int layer = it / I_L; int r = it % I_L;
        if (r < I_IN) { const int nb = r % 24, kb = r / 24; tr_item(p.w_in + (size_t)layer * 1024 * INW, INW, nb * 32, kb * 64, (bf16*)(p.ws + WS_WIN) + (size_t)layer * NIN * 1024, 1024, (nb >> 3) * 256 + 128 * (nb & 1) + 32 * ((nb & 7) >> 1), scr, lane); continue; } r -= I_IN;
        if (r < I_OUT) { const int nb = r % 32, kb = r / 32; tr_item(p.w_out + (size_t)layer * 1024 * 1024, 1024, nb * 32, kb * 64, (bf16*)(p.ws + WS_WOUT) + (size_t)layer * 1024 * 1024, 1024, nb * 32, scr, lane); continue; } r -= I_OUT;
        if (r < I_GU) { const int nb = r % 176, kb = r / 176; const int n0 = nb * 32; const int j = n0 < DFF ? n0 : n0 - DFF; const int drow = (j >> 7) * 256 + (n0 < DFF ? 0 : 128) + (j & 127);
            tr_item(p.w_gate_up + (size_t)layer * 1024 * NGU, NGU, n0, kb * 64, (bf16*)(p.ws + WS_WGU) + (size_t)layer * NGU * 1024, 1024, drow, scr, lane); continue; } r -= I_GU;
        { const int nb = r % 32, kb = r / 32; tr_item(p.w_down + (size_t)layer * DFF * 1024, 1024, nb * 32, kb * 64, (bf16*)(p.ws + WS_WDN) + (size_t)layer * 1024 * DFF, DFF, nb * 32, scr, lane); }
    }
}
__device__ __forceinline__ void p0_trig(const P& p, int tid) {
    const int gt = blockIdx.x * NTHR + tid, NGT = gridDim.x * NTHR;
    bf16* TC = (bf16*)(p.ws + WS_TRIGC);
    for (int it = gt; it < 256 * 32; it += NGT) { const int k = it >> 5, c8 = (it & 31) * 8;
        float v[8];
#pragma unroll
        for (int jj = 0; jj < 8; ++jj) { const int j = c8 + jj; const bool isS = j > 128; const int l = isS ? j - 128 : j; const float rev = (float)((k * l) & 255) * (1.0f / 256.0f); v[jj] = isS ? -__builtin_amdgcn_sinf(rev) : __builtin_amdgcn_cosf(rev); }
        v4u w; w.x = pk2(v[0], v[1]); w.y = pk2(v[2], v[3]); w.z = pk2(v[4], v[5]); w.w = pk2(v[6], v[7]);
        *(v4u*)(TC + (size_t)k * 256 + c8) = w; }
}
__device__ __forceinline__ void norm_phase(const float* sx, const float* scx, int nrows, const float* g, const float* modl, int shift_chunk, int scale_chunk, bf16* HX, int wave, int lane) {
    constexpr int R = 2;
    const int gw = blockIdx.x * NWAVES + wave, NGW = gridDim.x * NWAVES;
    f32x4 gm[4];
#pragma unroll
    for (int j = 0; j < 4; ++j) gm[j] = *(const f32x4*)(g + 256 * j + 4 * lane);
    for (int m0 = gw * R; m0 < nrows; m0 += NGW * R) {
        f32x4 v[R][4];
#pragma unroll
        for (int e = 0; e < R; ++e) { const int m = m0 + e; const float* xrow = m < MXR ? sx + (size_t)m * 1024 : scx + (size_t)(m - MXR) * 1024;
#pragma unroll
            for (int j = 0; j < 4; ++j) v[e][j] = *(const f32x4*)(xrow + 256 * j + 4 * lane); }
#pragma unroll
        for (int e = 0; e < R; ++e) { const int m = m0 + e; const float* md = modl + (size_t)(m < MXR ? (m >> 12) : 16) * MODW_;
            float s = 0.f;
#pragma unroll
            for (int j = 0; j < 4; ++j) s += (v[e][j].x * v[e][j].x + v[e][j].y * v[e][j].y) + (v[e][j].z * v[e][j].z + v[e][j].w * v[e][j].w);
            const float rstd = 1.0f / sqrtf(wave_sum(s, lane) * (1.0f / 1024.0f) + 1e-6f);
#pragma unroll
            for (int j = 0; j < 4; ++j) { const f32x4 scv = *(const f32x4*)(md + scale_chunk * 1024 + 256 * j + 4 * lane), shv = *(const f32x4*)(md + shift_chunk * 1024 + 256 * j + 4 * lane);
                const f32x4 y = v[e][j] * rstd * gm[j] * (scv + 1.0f) + shv;
                v2u w; w.x = pk2(y.x, y.y); w.y = pk2(y.z, y.w);
                *(v2u*)(HX + (size_t)m * 1024 + 256 * j + 4 * lane) = w; } }
    }
}
__device__ __forceinline__ void norm_phase_bf16(const bf16* XS, int nrows, const float* g, const float* modl, int shift_chunk, int scale_chunk, bf16* HX, int wave, int lane) {
    constexpr int R = 4;
    const int gw = blockIdx.x * NWAVES + wave, NGW = gridDim.x * NWAVES;
    f32x4 gm[4];
#pragma unroll
    for (int j = 0; j < 4; ++j) gm[j] = *(const f32x4*)(g + 16 * lane + 4 * j);
    for (int m0 = gw * R; m0 < nrows; m0 += NGW * R) {
        v4u ra[R][2];
#pragma unroll
        for (int e = 0; e < R; ++e) { const bf16* xr = XS + (size_t)(m0 + e) * 1024 + lane * 16; ra[e][0] = *(const v4u*)xr; ra[e][1] = *(const v4u*)(xr + 8); }
#pragma unroll
        for (int e = 0; e < R; ++e) { const int m = m0 + e; const float* md = modl + (size_t)(m < MXR ? (m >> 12) : 16) * MODW_;
            const v4u r0 = ra[e][0], r1 = ra[e][1];
            f32x4 v[4];
            v[0] = (f32x4){__builtin_bit_cast(float, r0.x << 16), __builtin_bit_cast(float, r0.x & 0xffff0000u), __builtin_bit_cast(float, r0.y << 16), __builtin_bit_cast(float, r0.y & 0xffff0000u)};
            v[1] = (f32x4){__builtin_bit_cast(float, r0.z << 16), __builtin_bit_cast(float, r0.z & 0xffff0000u), __builtin_bit_cast(float, r0.w << 16), __builtin_bit_cast(float, r0.w & 0xffff0000u)};
            v[2] = (f32x4){__builtin_bit_cast(float, r1.x << 16), __builtin_bit_cast(float, r1.x & 0xffff0000u), __builtin_bit_cast(float, r1.y << 16), __builtin_bit_cast(float, r1.y & 0xffff0000u)};
            v[3] = (f32x4){__builtin_bit_cast(float, r1.z << 16), __builtin_bit_cast(float, r1.z & 0xffff0000u), __builtin_bit_cast(float, r1.w << 16), __builtin_bit_cast(float, r1.w & 0xffff0000u)};
            float s = 0.f;
#pragma unroll
            for (int j = 0; j < 4; ++j) s += (v[j].x * v[j].x + v[j].y * v[j].y) + (v[j].z * v[j].z + v[j].w * v[j].w);
            const float rstd = 1.0f / sqrtf(wave_sum(s, lane) * (1.0f / 1024.0f) + 1e-6f);
            unsigned o[8];
#pragma unroll
            for (int j = 0; j < 4; ++j) { const f32x4 scv = *(const f32x4*)(md + scale_chunk * 1024 + 16 * lane + 4 * j), shv = *(const f32x4*)(md + shift_chunk * 1024 + 16 * lane + 4 * j);
                const f32x4 y = v[j] * rstd * gm[j] * (scv + 1.0f) + shv; o[2 * j] = pk2(y.x, y.y); o[2 * j + 1] = pk2(y.z, y.w); }
            bf16* hp = HX + (size_t)m * 1024 + lane * 16;
            *(v4u*)hp = (v4u){o[0], o[1], o[2], o[3]}; *(v4u*)(hp + 8) = (v4u){o[4], o[5], o[6], o[7]}; }
    }
}
__device__ __forceinline__ void prep_phase(const P& p, int layer, LAS unsigned char* lds, int tid, int wave, int lane, int cu, int ncu) {
    const bf16* Z = (const bf16*)(p.ws + WS_Z); bf16* MX = (bf16*)(p.ws + WS_MX);
    const int gw = cu * NWAVES + wave, NGW = ncu * NWAVES;
    { const int nrows = layer == 0 ? MTR : MXR;
      for (int it = gw; it < nrows / 4; it += NGW) {
        const int m = it * 4 + (lane >> 4), c = lane & 15;
        const bool isx = m < MXR;
        const int t = isx ? (m & 4095) : ((m - MXR) & 255), L = isx ? SEQ : CTX;
        const int w = 2 << (c >> 2);
        int lo = t - (w >> 1); if (lo < 0) lo = 0; int hi = t + w - (w >> 1); if (hi > L) hi = L;
        const bf16* zb = Z + (size_t)(m - t) * 1024 + 768 + c * 16;
        float a[16];
#pragma unroll
        for (int f = 0; f < 16; ++f) a[f] = 0.f;
        float sv[16];
        { const v4u q0 = *(const v4u*)(zb + (size_t)t * 1024), q1 = *(const v4u*)(zb + (size_t)t * 1024 + 8);
          const unsigned ww[8] = {q0.x, q0.y, q0.z, q0.w, q1.x, q1.y, q1.z, q1.w};
#pragma unroll
          for (int j = 0; j < 8; ++j) { sv[2 * j] = __builtin_bit_cast(float, ww[j] << 16); sv[2 * j + 1] = __builtin_bit_cast(float, ww[j] & 0xffff0000u); } }
#pragma unroll
        for (int ib = 0; ib < 16; ib += 8) { v4u q0[8], q1[8];
#pragma unroll
            for (int i = 0; i < 8; ++i) { int tt = lo + ib + i; if (tt > hi - 1) tt = hi - 1; q0[i] = *(const v4u*)(zb + (size_t)tt * 1024); q1[i] = *(const v4u*)(zb + (size_t)tt * 1024 + 8); }
#pragma unroll
            for (int i = 0; i < 8; ++i) { const float wgt = (lo + ib + i < hi) ? 1.0f : 0.0f;
                const unsigned ww[8] = {q0[i].x, q0[i].y, q0[i].z, q0[i].w, q1[i].x, q1[i].y, q1[i].z, q1[i].w};
#pragma unroll
                for (int j = 0; j < 8; ++j) { a[2 * j] += wgt * __builtin_bit_cast(float, ww[j] << 16); a[2 * j + 1] += wgt * __builtin_bit_cast(float, ww[j] & 0xffff0000u); } } }
        const float inv = 1.0f / (float)(hi - lo);
        v4u w0, w1;
        w0.x = pk2(a[0] * inv - sv[0], a[1] * inv - sv[1]); w0.y = pk2(a[2] * inv - sv[2], a[3] * inv - sv[3]); w0.z = pk2(a[4] * inv - sv[4], a[5] * inv - sv[5]); w0.w = pk2(a[6] * inv - sv[6], a[7] * inv - sv[7]);
        w1.x = pk2(a[8] * inv - sv[8], a[9] * inv - sv[9]); w1.y = pk2(a[10] * inv - sv[10], a[11] * inv - sv[11]); w1.z = pk2(a[12] * inv - sv[12], a[13] * inv - sv[13]); w1.w = pk2(a[14] * inv - sv[14], a[15] * inv - sv[15]);
        bf16* o = MX + (size_t)m * 1024 + 512 + c * 16; *(v4u*)o = w0; *(v4u*)(o + 8) = w1;
      } }
    __syncthreads();
    { LAS unsigned short* row = (LAS unsigned short*)(lds + wave * 16384);
      const bf16* PQT = (const bf16*)(p.ws + WS_PQT); const bf16* PQTC = (const bf16*)(p.ws + WS_PQTC); bf16* PQF = (bf16*)(p.ws + WS_PQF); bf16* PQFC = (bf16*)(p.ws + WS_PQFC);
      const int ntot = layer == 0 ? 8192 : 4096;
      for (int it = 4096 + gw; it < ntot; it += NGW) {
        const bool isx = it < 4096; const int n = isx ? it : it - 4096, L = isx ? SEQ : CTX, H2 = L >> 1;
        const bf16* src = isx ? PQT + (size_t)n * 8192 : PQTC + (size_t)n * 512;
        bf16* dst = isx ? PQF + (size_t)n * 4096 : PQFC + (size_t)n * 256;
        for (int c = lane; c < L / 4; c += 64) *(LAS v4u*)(row + c * 8) = *(const v4u*)(src + c * 8);
        asm volatile("s_waitcnt vmcnt(0) lgkmcnt(0)" ::: "memory");
        for (int c = lane; c < L / 8; c += 64) { const int j0 = c * 8; float o[8];
#pragma unroll
            for (int jj = 0; jj < 8; ++jj) { const int j = j0 + jj; const bool lowh = j <= H2; const int l = j - H2;
                const int ia = lowh ? j : L + l, ib = lowh ? L - j : 2 * L - l;
                const float va = bf2f(row[ia]), vb = bf2f(row[ib]);
                const float sg = lowh ? ((j == 0 || j == H2) ? 0.0f : 1.0f) : -1.0f;
                o[jj] = va + sg * vb; }
            v4u w; w.x = pk2(o[0], o[1]); w.y = pk2(o[2], o[3]); w.z = pk2(o[4], o[5]); w.w = pk2(o[6], o[7]);
            *(v4u*)(dst + j0) = w; }
        asm volatile("s_waitcnt lgkmcnt(0)" ::: "memory");
      } }
    __syncthreads();
}

__device__ __forceinline__ constexpr int bitrev6(int i) { return ((i & 1) << 5) | ((i & 2) << 3) | ((i & 4) << 1) | ((i & 8) >> 1) | ((i & 16) >> 3) | ((i & 32) >> 5); }
typedef float f32x2 __attribute__((ext_vector_type(2)));
template <int HALF> __device__ __forceinline__ void fft64_stage(f32x2 (&x)[64]) {
constexpr float FC[32] = {1.000000000e+00f, 9.951847267e-01f, 9.807852804e-01f, 9.569403357e-01f, 9.238795325e-01f, 8.819212643e-01f, 8.314696123e-01f, 7.730104534e-01f, 7.071067812e-01f, 6.343932842e-01f, 5.555702330e-01f, 4.713967368e-01f, 3.826834324e-01f, 2.902846773e-01f, 1.950903220e-01f, 9.801714033e-02f, 6.123233996e-17f, -9.801714033e-02f, -1.950903220e-01f, -2.902846773e-01f, -3.826834324e-01f, -4.713967368e-01f, -5.555702330e-01f, -6.343932842e-01f, -7.071067812e-01f, -7.730104534e-01f, -8.314696123e-01f, -8.819212643e-01f, -9.238795325e-01f, -9.569403357e-01f, -9.807852804e-01f, -9.951847267e-01f};
    constexpr float FS[32] = {0.000000000e+00f, 9.801714033e-02f, 1.950903220e-01f, 2.902846773e-01f, 3.826834324e-01f, 4.713967368e-01f, 5.555702330e-01f, 6.343932842e-01f, 7.071067812e-01f, 7.730104534e-01f, 8.314696123e-01f, 8.819212643e-01f, 9.238795325e-01f, 9.569403357e-01f, 9.807852804e-01f, 9.951847267e-01f, 1.000000000e+00f, 9.951847267e-01f, 9.807852804e-01f, 9.569403357e-01f, 9.238795325e-01f, 8.819212643e-01f, 8.314696123e-01f, 7.730104534e-01f, 7.071067812e-01f, 6.343932842e-01f, 5.555702330e-01f, 4.713967368e-01f, 3.826834324e-01f, 2.902846773e-01f, 1.950903220e-01f, 9.801714033e-02f};
#pragma unroll
    for (int b0 = 0; b0 < 64; b0 += 2 * HALF)
#pragma unroll
        for (int j = 0; j < HALF; ++j) { const int e = j * (32 / HALF), i0 = b0 + j, i1 = b0 + j + HALF;
            const f32x2 a = x[i0], b = x[i1];
            x[i0] = a + b;
            const f32x2 d = a - b, dsw = __builtin_shufflevector(d, d, 1, 0);
            if (e == 0) x[i1] = d;
            else if (e == 16) x[i1] = dsw * (f32x2){1.0f, -1.0f};
            else x[i1] = d * (f32x2){FC[e], FC[e]} + dsw * (f32x2){FS[e], -FS[e]}; }
}
__device__ __forceinline__ void fft64_dif(f32x2 (&x)[64]) {
    fft64_stage<32>(x); __builtin_amdgcn_sched_barrier(0); fft64_stage<16>(x); __builtin_amdgcn_sched_barrier(0); fft64_stage<8>(x); __builtin_amdgcn_sched_barrier(0);
    fft64_stage<4>(x); __builtin_amdgcn_sched_barrier(0); fft64_stage<2>(x); __builtin_amdgcn_sched_barrier(0); fft64_stage<1>(x); __builtin_amdgcn_sched_barrier(0);
}
__device__ __forceinline__ void fft_phase(const P& p, LAS unsigned char* lds, int tid, int wave, int lane, int cu, int ncu) {
    const bf16* PQT = (const bf16*)(p.ws + WS_PQT); bf16* MX = (bf16*)(p.ws + WS_MX);
    LAS unsigned short* row = (LAS unsigned short*)(lds + wave * 16640);
    LAS float* T = (LAS float*)(lds + wave * 16640);
    LAS unsigned short* OUT = (LAS unsigned short*)lds;
    for (int it = cu; it < 512; it += ncu) {
        const int bgi = it >> 3, db = it & 7, n = bgi * 64 + db * 8 + wave;
        int lane_t = lane; asm volatile("" : "+v"(lane_t));
        const bf16* src = PQT + (size_t)n * 8192;
        for (int c = lane; c < 1024; c += 64) *(LAS v4u*)(row + c * 8) = *(const v4u*)(src + c * 8);
        asm volatile("s_waitcnt vmcnt(0) lgkmcnt(0)" ::: "memory"); __builtin_amdgcn_sched_barrier(0);
        f32x2 x[64];
#pragma unroll
        for (int r = 0; r < 64; ++r) x[r] = (f32x2){bf2f(row[64 * r + lane]), -bf2f(row[4096 + 64 * r + lane])};
        asm volatile("s_waitcnt lgkmcnt(0)" ::: "memory"); __builtin_amdgcn_sched_barrier(0);
        fft64_dif(x);
        float ti[64];
#pragma unroll
        for (int r = 0; r < 64; ++r) { const int k1 = bitrev6(r); const float rev = (float)((k1 * lane_t) & 4095) * (1.0f / 4096.0f);
            const float c = __builtin_amdgcn_cosf(rev), s = __builtin_amdgcn_sinf(rev);
            const f32x2 t = x[r] * (f32x2){c, c} + __builtin_shufflevector(x[r], x[r], 1, 0) * (f32x2){s, -s}; T[k1 * 65 + lane] = t.x; ti[r] = t.y; }
        f32x2 bb[64];
        asm volatile("s_waitcnt lgkmcnt(0)" ::: "memory"); __builtin_amdgcn_sched_barrier(0);
#pragma unroll
        for (int r = 0; r < 64; ++r) bb[r].x = T[lane * 65 + r];
        asm volatile("s_waitcnt lgkmcnt(0)" ::: "memory"); __builtin_amdgcn_sched_barrier(0);
#pragma unroll
        for (int r = 0; r < 64; ++r) { const int k1 = bitrev6(r); T[k1 * 65 + lane] = ti[r]; }
        asm volatile("s_waitcnt lgkmcnt(0)" ::: "memory"); __builtin_amdgcn_sched_barrier(0);
#pragma unroll
        for (int r = 0; r < 64; ++r) bb[r].y = T[lane * 65 + r];
        asm volatile("s_waitcnt lgkmcnt(0)" ::: "memory"); __builtin_amdgcn_sched_barrier(0);
        fft64_dif(bb);
        __syncthreads();
#pragma unroll
        for (int r = 0; r < 64; ++r) { const int k2 = bitrev6(r); OUT[(lane + 64 * k2) * 8 + wave] = (unsigned short)f2bf(bb[r].x * (1.0f / 512.0f)); }
        __syncthreads();
        { const int b = bgi >> 2, g = bgi & 3;
#pragma unroll
          for (int i = 0; i < 8; ++i) { const int k = tid + 512 * i; const v4u v = *(const LAS v4u*)(OUT + k * 8);
              *(v4u*)(MX + ((size_t)(b * SEQ + k)) * 1024 + 768 + g * 64 + db * 8) = v; } }
        __syncthreads();
    }
}
typedef __attribute__((address_space(1))) unsigned gu32;
#define RLX_AGENT __ATOMIC_RELAXED, __HIP_MEMORY_SCOPE_AGENT
#define XB_TMO      128
#define XB_XCNT(j)  (256  + 64 * (j))
#define XB_XSUB(j)  (1280 + 64 * (j))
#define XB_XGEN(j)  (2304 + 64 * (j))
#define XB_TOP      3328
#define XB_TOPGEN   3392
#define XCD_BAR_WORDS 3456
#define XB_SPIN_CAP (1u << 18)

__device__ __forceinline__ unsigned xb_ld(unsigned* p)              { return __hip_atomic_load(p, __ATOMIC_RELAXED, __HIP_MEMORY_SCOPE_AGENT); }
__device__ __forceinline__ unsigned xb_add(unsigned* p, unsigned v) { return __hip_atomic_fetch_add(p, v, __ATOMIC_RELAXED, __HIP_MEMORY_SCOPE_AGENT); }
__device__ __forceinline__ unsigned xb_xcc_id() { return (unsigned)__builtin_amdgcn_s_getreg((3 << 11) | 20) & 0xFu; }
#define XB_SPIN(cond, bar) do { unsigned _sp = 0; while (cond) { __builtin_amdgcn_s_sleep(1); \
    if ((++_sp & 255u) == 0u) { if (xb_ld(&(bar)[XB_TMO])) break; if (_sp > XB_SPIN_CAP) { atomicAdd(&(bar)[XB_TMO], 1u); break; } } } } while (0)

struct XcdBarrier {
    unsigned* bar; unsigned x;
    volatile LAS unsigned* st;
};

__device__ __forceinline__ XcdBarrier xcd_barrier_post(unsigned* bar, volatile LAS unsigned* st) {
    XcdBarrier b; b.bar = bar; b.x = (unsigned)__builtin_amdgcn_readfirstlane((int)xb_xcc_id()); b.st = st;
    if (threadIdx.x == 0) (void)xb_add(&bar[XB_XCNT(b.x)], 1u);
    return b;
}
__device__ __forceinline__ void xcd_barrier_complete(unsigned* bar, unsigned x, unsigned& nloc, unsigned& nx) {
    const unsigned G = gridDim.x * gridDim.y * gridDim.z;
    unsigned sum, cnt, mine, sp = 0u;
    for (;;) {
        sum = 0u; cnt = 0u; mine = 0u;
#pragma unroll
        for (unsigned j = 0; j < 16; ++j) { const unsigned c = xb_ld(&bar[XB_XCNT(j)]); sum += c; cnt += (c > 0u) ? 1u : 0u; mine = (j == x) ? c : mine; }
        if (sum == G) break;
        __builtin_amdgcn_s_sleep(1);
        if ((++sp & 255u) == 0u) { if (xb_ld(&bar[XB_TMO])) break; if (sp > XB_SPIN_CAP) { atomicAdd(&bar[XB_TMO], 1u); break; } }
    }
    nloc = mine > 0u ? mine : 1u; nx = cnt > 0u ? cnt : 1u;
}

__device__ __forceinline__ void xcd_barrier(const XcdBarrier& b) {
    asm volatile("s_waitcnt vmcnt(0)" ::: "memory");
    __syncthreads();
    if (threadIdx.x == 0) {
        unsigned* bar = b.bar; unsigned bx_ = b.x; asm volatile("" : "+s"(bx_));
        __builtin_amdgcn_s_waitcnt(0);
        unsigned nloc = b.st[0], nx = b.st[1];
        if (nloc == 0u) { xcd_barrier_complete(bar, bx_, nloc, nx); b.st[0] = nloc; b.st[1] = nx; }
        const unsigned old = xb_add(&bar[XB_XSUB(bx_)], 1u);
        const unsigned gen = old / nloc;
        if (old + 1u == (gen + 1u) * nloc) {
            __builtin_amdgcn_fence(__ATOMIC_RELEASE, "agent");
            asm volatile("s_waitcnt vmcnt(0)" ::: "memory");
            const unsigned og = xb_add(&bar[XB_TOP], 1u);
            const unsigned tg = og / nx;
            if (og + 1u == (tg + 1u) * nx) xb_add(&bar[XB_TOPGEN], 1u);
            else XB_SPIN(xb_ld(&bar[XB_TOPGEN]) == tg, bar);
            __builtin_amdgcn_fence(__ATOMIC_ACQUIRE, "agent");
            xb_add(&bar[XB_XGEN(bx_)], 1u);
            asm volatile("s_waitcnt vmcnt(0)" ::: "memory");
        } else {
            XB_SPIN(xb_ld(&bar[XB_XGEN(bx_)]) == gen, bar);
            __builtin_amdgcn_fence(__ATOMIC_ACQUIRE, "agent");
            asm volatile("s_waitcnt vmcnt(0)" ::: "memory");
        }
    }
    __syncthreads();
}

__global__ void __launch_bounds__(NTHR, 2) mk_fwd(P p) {
    extern __shared__ __attribute__((aligned(16))) unsigned char lds_raw[];
    LAS unsigned char* lds = (LAS unsigned char*)lds_raw;
    cg::grid_group grid = cg::this_grid();
    if (p.ws == nullptr) grid.sync();
    volatile LAS unsigned* bst = (volatile LAS unsigned*)(lds + 138240);
    if (threadIdx.x < 2) bst[threadIdx.x] = 0u;
    __syncthreads();
    const XcdBarrier xbar = xcd_barrier_post((unsigned*)(p.ws + WS_CTL), bst);
#define GRID_SYNC() xcd_barrier(xbar)
#define FRESH_IDS() int tid = threadIdx.x; asm volatile("" : "+v"(tid)); const int lane = tid & 63, wave = __builtin_amdgcn_readfirstlane(tid >> 6); int bx = blockIdx.x; asm volatile("" : "+s"(bx)); \
    const int vcu = (G % 8 == 0) ? (bx % 8) * (G / 8) + bx / 8 : bx; (void)lane; (void)wave; (void)vcu
    const int G = gridDim.x;
    unsigned char* ws = p.ws;
    float* MOD = (float*)(ws + WS_MOD);
    bf16* HX = (bf16*)(ws + WS_HX); bf16* Zb = (bf16*)(ws + WS_Z); bf16* MXb = (bf16*)(ws + WS_MX); bf16* Hb = (bf16*)(ws + WS_H);
    bf16* PQT = (bf16*)(ws + WS_PQT); bf16* PQTC = (bf16*)(ws + WS_PQTC); bf16* XS = (bf16*)(ws + WS_XS);
    const attn_body::bf16* QPb = (const attn_body::bf16*)(ws + WS_QP); const attn_body::bf16* KPb = (const attn_body::bf16*)(ws + WS_KP); const attn_body::bf16* VPb = (const attn_body::bf16*)(ws + WS_VP);

    LAS float* ropeT = (LAS float*)(lds + 139264);
    for (int i = threadIdx.x; i < 1024; i += NTHR) { const int pos = i >> 4, f = i & 15; const float fr = expf(-(float)f * (1.0f / 16.0f) * 9.210340371976184f); const float a = (float)pos * fr; float rev = a * 0.15915494309189535f; rev -= floorf(rev);
        ropeT[i] = __builtin_amdgcn_cosf(rev); ropeT[1024 + i] = __builtin_amdgcn_sinf(rev); }
    __syncthreads();
    { FRESH_IDS();
    p0_mod(p, lds, tid, wave, lane);
    __syncthreads();
    p0_comp(p, lds, tid);
    __syncthreads();
    p0_transposes(p, lds, wave, lane);
    p0_trig(p, tid); }
    GRID_SYNC();

    for (int layer = 0; layer < 2; ++layer) {
        const bool upd = layer == 0;
        const float* modl = MOD + (size_t)layer * 17 * MODW_;
        const bf16* WIN = (const bf16*)(ws + WS_WIN) + (size_t)layer * NIN * 1024;
        const bf16* WOUT = (const bf16*)(ws + WS_WOUT) + (size_t)layer * 1024 * 1024;
        const bf16* WGU = (const bf16*)(ws + WS_WGU) + (size_t)layer * NGU * 1024;
        const bf16* WDN = (const bf16*)(ws + WS_WDN) + (size_t)layer * 1024 * DFF;
        { FRESH_IDS(); if (layer == 0) norm_phase(p.x, p.ctx, MTR, p.g_mix, modl, 0, 1, HX, wave, lane); else norm_phase_bf16(XS, MTR, p.g_mix + 1024, modl, 0, 1, HX, wave, lane); }
        GRID_SYNC();
        { FRESH_IDS();
            pg8::EpiIn E{Zb, PQT, PQTC, 0, 0, (bf16*)(ws + WS_QP), (bf16*)(ws + WS_KP), (bf16*)(ws + WS_VP), p.q_gain + layer * 64, p.k_gain + layer * 64, ropeT, QSCALE};
            if (upd) { pg8::Gemm g{HX, WIN, MTR, NIN, 1024}; pg8::StaticOrder S; S.init(MTR, NIN, G, bx); pg8::gemm_phase<pg8::EpiIn, pg8::StaticOrder, true, true>(lds, g, S, E); }
            else {
                { pg8::Gemm g{HX, WIN, MXR, NIN, 1024}; pg8::StaticOrder S; S.init(MXR, NIN, G, bx); pg8::gemm_phase<pg8::EpiIn, pg8::StaticOrder, true, true>(lds, g, S, E); }
            }
        }
        GRID_SYNC();
        { FRESH_IDS();
          const int ngemm = upd ? 0 : 16;
          if (bx >= G - ngemm) { pg8::EpiIn E2{Zb, PQT, PQTC, MXR, 512, (bf16*)(ws + WS_QP), (bf16*)(ws + WS_KP), (bf16*)(ws + WS_VP), p.q_gain + layer * 64, p.k_gain + layer * 64, ropeT, QSCALE};
              pg8::Gemm g{HX + (size_t)MXR * 1024, WIN + (size_t)512 * 1024, MCR, 256, 1024}; pg8::StaticOrder S; S.init(MCR, 256, G, G - 1 - bx);
              pg8::gemm_phase<pg8::EpiIn, pg8::StaticOrder, true, true>(lds, g, S, E2); }
          else prep_phase(p, layer, lds, tid, wave, lane, bx, G - ngemm); }
        GRID_SYNC();
        { FRESH_IDS();
            for (int i = 0; i < (2048 + G - 1) / G; ++i) { const int pu = i * G + vcu; if (pu >= 2048) break;
                const int bg = pu >> 6, u = pu & 63, b = bg >> 1, gk = bg & 1, h = gk * 4 + (u >> 4), qb = u & 15;
                const size_t qrow = (size_t)b * SEQ + qb * 256;
                attn_body::attn_unit<8>(QPb + qrow * 512 + h * 64, KPb + (size_t)b * KVL * 128 + gk * 64, VPb + (size_t)b * KVL * 128 + gk * 64,
                                        (attn_body::bf16*)MXb + qrow * 1024 + h * 64, KVL / 64, (char*)lds_raw); }
            if (upd) for (int cu = vcu; cu < 128; cu += G) { const int b = cu >> 3, h = cu & 7, gk = h >> 2; const size_t qrow = (size_t)MXR + b * CTX;
                attn_body::attn_unit<8>(QPb + qrow * 512 + h * 64, KPb + (size_t)b * KVL * 128 + gk * 64, VPb + (size_t)b * KVL * 128 + gk * 64,
                                        (attn_body::bf16*)MXb + qrow * 1024 + h * 64, CTX / 64, (char*)lds_raw); }
            fft_phase(p, lds, tid, wave, lane, bx, G);
            if (upd) { pg8::Gemm g{(const bf16*)(ws + WS_TRIGC), (const bf16*)(ws + WS_PQFC), CTX, 4096, CTX}; pg8::StaticOrder S; S.init(CTX, 4096, G, G - 1 - bx); pg8::EpiFour E{MXb, MXR, CTX, 1.0f / 128.0f};
              pg8::gemm_phase<pg8::EpiFour, pg8::StaticOrder, true, true>(lds, g, S, E); }
        }
        GRID_SYNC();
        { FRESH_IDS(); const int M = upd ? MTR : MXR; pg8::Gemm g{MXb, WOUT, M, 1024, 1024}; pg8::StaticOrder S; S.init(M, 1024, G, bx); pg8::EpiRes E{layer == 0 ? p.x : (const float*)nullptr, p.ctx, XS, XS, (float*)nullptr, modl + 2 * 1024};
          pg8::gemm_phase<pg8::EpiRes, pg8::StaticOrder, true, true>(lds, g, S, E); }
        GRID_SYNC();
        { FRESH_IDS(); norm_phase_bf16(XS, upd ? MTR : MXR, p.g_ffn + layer * 1024, modl, 3, 4, HX, wave, lane); }
        GRID_SYNC();
        { FRESH_IDS(); const int M = upd ? MTR : MXR; pg8::Gemm g{HX, WGU, M, NGU, 1024}; pg8::StaticOrder S; S.init(M, NGU, G, bx); pg8::EpiSwiglu E{Hb};
          pg8::gemm_phase<pg8::EpiSwiglu, pg8::StaticOrder, true, true>(lds, g, S, E); }
        GRID_SYNC();
        { FRESH_IDS(); const int M = upd ? MTR : MXR; pg8::Gemm g{Hb, WDN, M, 1024, DFF}; pg8::StaticOrder S; S.init(M, 1024, G, bx); pg8::EpiRes E{(const float*)nullptr, (const float*)nullptr, XS, upd ? XS : (bf16*)nullptr, p.out, modl + 5 * 1024};
          pg8::gemm_phase<pg8::EpiRes, pg8::StaticOrder, true, true>(lds, g, S, E); }
        if (layer == 0) GRID_SYNC();
    }
}

extern "C" void kernel_launch(void* const* d_in, const int* in_sizes, int n_in, void* d_out, int out_size, void* d_ws, size_t ws_size, hipStream_t stream) {
    static int grid = 0;
    if (grid == 0) {
        if (n_in != 17 || ws_size < WS_END) { fprintf(stderr, "kernel_launch: unexpected n_in %d / ws %zu\n", n_in, ws_size); grid = -1; return; }
        int dev = 0, cus = 0, per_cu = 0;
        hipGetDevice(&dev); hipDeviceGetAttribute(&cus, hipDeviceAttributeMultiprocessorCount, dev);
        hipFuncSetAttribute((const void*)mk_fwd, hipFuncAttributeMaxDynamicSharedMemorySize, LDS_BYTES);
        hipOccupancyMaxActiveBlocksPerMultiprocessor(&per_cu, (const void*)mk_fwd, NTHR, LDS_BYTES);
        (void)hipGetLastError();
        if (per_cu < 1) per_cu = 1;
        grid = cus * per_cu;
    }
    if (grid < 0) return;
    if (hipMemsetAsync((char*)d_ws + WS_CTL, 0, CTL_BYTES, stream) != hipSuccess) { fprintf(stderr, "memset failed\n"); return; }
    P p{};
    const float** pp = (const float**)&p;
    for (int i = 0; i < 17; ++i) pp[i] = (const float*)d_in[i];
    p.out = (float*)d_out; p.ws = (unsigned char*)d_ws;
    void* args[] = {&p};
    hipError_t e = hipLaunchCooperativeKernel((const void*)mk_fwd, dim3(grid), dim3(NTHR), args, LDS_BYTES, stream);
    if (e != hipSuccess) fprintf(stderr, "cooperative launch failed: %s (grid %d)\n", hipGetErrorString(e), grid);
}
```

```cpp
#include <hip/hip_runtime.h>
#include <hip/hip_bf16.h>
#include <hip/hip_cooperative_groups.h>
#include <cstdio>
#include <cstdint>
#include <cmath>
namespace pg8 {
#define PG8_LAS __attribute__((address_space(3)))
typedef unsigned short bf16_t;
typedef short bf16x8 __attribute__((ext_vector_type(8)));
typedef float f32x4 __attribute__((ext_vector_type(4)));
typedef unsigned u32x4 __attribute__((ext_vector_type(4)));
constexpr int BM = 256, BK = 64, HALF = 128, HTB = HALF * BK * 2  , STAGE_BYTES = 8 * HTB, NXCD = 8, WGM = 8;

__host__ __device__ __forceinline__ int lds_byte(int r, int c) { const int st = (r >> 4) * 2 + (c >> 5), rr = r & 15, cc = c & 31, ob = rr * 64 + cc * 2; return st * 1024 + (ob ^ (((ob >> 9) & 1) << 5)); }
__host__ __device__ __forceinline__ void stage_rc(int b, int& R, int& C) { const int st = b / 1024, sb = b % 1024, swz = sb ^ (((sb >> 9) & 1) << 5); R = (st >> 1) * 16 + swz / 64; C = (st & 1) * 32 + (swz % 64) / 2; }
__host__ __device__ __forceinline__ int perm32(int rho) { const int n = rho >> 4, i = rho & 15; return 8 * (i >> 2) + 4 * n + (i & 3); }

struct Unit { int pm, pn; };
struct Gemm { const bf16_t* A; const bf16_t* Bt; int M, N, K; };

struct StaticOrder {
    int nM, nN, nwg, G, c;
    __host__ __device__ void init(int M, int N, int G_, int c_) { nM = M / BM; nN = N / BM; nwg = nM * nN; G = G_; c = c_; }
    __host__ __device__ bool next(int i, Unit& u) const {
        const long L = (long)i * G + c; if (L >= nwg) return false;
        int wgid = (int)L; { const int q = nwg / NXCD, r = nwg % NXCD, xcd = wgid % NXCD, off = wgid / NXCD; wgid = (xcd < r ? xcd * (q + 1) : r * (q + 1) + (xcd - r) * q) + off; }
        const int nig = WGM * nN, gid = wgid / nig, fm = gid * WGM, gsz = (nM - fm) < WGM ? (nM - fm) : WGM;
        u.pm = fm + ((wgid % nig) % gsz); u.pn = (wgid % nig) / gsz; return true;
    }
    __device__ __forceinline__ void a_ready(const Unit&) const {}
    __device__ __forceinline__ void done(const Unit&) const {}
};

__device__ __forceinline__ unsigned cvt_pk_bf16(float lo, float hi) { unsigned r; asm volatile("v_cvt_pk_bf16_f32 %0, %1, %2" : "=v"(r) : "v"(lo), "v"(hi)); return r; }
typedef float f32x2 __attribute__((ext_vector_type(2)));
__device__ __forceinline__ float shx_(float v, int o, int lane) { return __builtin_bit_cast(float, __builtin_amdgcn_ds_bpermute((lane ^ o) << 2, __builtin_bit_cast(int, v))); }
constexpr int XROWS = 65536, CTXL = 256, SEQL = 4096, MODW = 6144;
struct EpiIn {
    static constexpr bool PERM = true, AFTER_DRAIN = false;
    bf16_t* Z; bf16_t* PQt; bf16_t* PQtc; int row_off, col_off;
    bf16_t* QP; bf16_t* KP; bf16_t* VP; const float* qg; const float* kg; const PG8_LAS float* rope; float qscale;
    __device__ __forceinline__ void operator()(const f32x4 (&acc)[2][2][4][2], const Unit& u, int wr, int wc, int fr, int fq) const {
        asm volatile("" : "+v"(fr), "+v"(fq));
        const int gr0 = row_off + u.pm * BM, ct = (col_off >> 8) + u.pn;
        if (ct < 3) {
            const bool isx = gr0 < XROWS, isv = (ct == 2) && (wc >= 2), isq = ct < 2;
            f32x4 gn[2][2];
            { const float* gp = (isq ? qg : kg) + 8 * fq;
#pragma unroll
              for (int bj = 0; bj < 2; ++bj)
#pragma unroll
                  for (int n = 0; n < 2; ++n) gn[bj][n] = *(const f32x4*)(gp + 32 * bj + 4 * n); }
            const float osc = isq ? qscale : 1.0f;
            const int half = fq >> 1, f0 = 8 * (fq & 1);
#pragma unroll
            for (int ai = 0; ai < 2; ++ai)
#pragma unroll
                for (int m = 0; m < 4; ++m) {
                    const int grow = gr0 + ai * HALF + wr * 64 + m * 16 + fr;
                    const int b = isx ? (grow >> 12) : ((grow - XROWS) >> 8), t = isx ? (grow & 4095) : ((grow - XROWS) & 255);
                    const size_t kvrow = (size_t)b * (SEQL + CTXL) + (isx ? CTXL + t : t);
                    if (isv) {
#pragma unroll
                        for (int bj = 0; bj < 2; ++bj) { const f32x4 v0 = acc[ai][bj][m][0], v1 = acc[ai][bj][m][1];
                            u32x4 w; w.x = cvt_pk_bf16(v0[0], v0[1]); w.y = cvt_pk_bf16(v0[2], v0[3]); w.z = cvt_pk_bf16(v1[0], v1[1]); w.w = cvt_pk_bf16(v1[2], v1[3]);
                            *(u32x4*)(VP + kvrow * 128 + (wc - 2) * 64 + 32 * bj + 8 * fq) = w; }
                    } else {
                        float ss = 0.f;
#pragma unroll
                        for (int bj = 0; bj < 2; ++bj)
#pragma unroll
                            for (int n = 0; n < 2; ++n) { const f32x4 v = acc[ai][bj][m][n]; ss += (v[0] * v[0] + v[1] * v[1]) + (v[2] * v[2] + v[3] * v[3]); }
                        ss += shx_(ss, 16, fq * 16 + fr); ss += shx_(ss, 32, fq * 16 + fr);
                        const float rstd = 1.0f / sqrtf(ss * (1.0f / 64.0f) + 1e-6f);
#pragma unroll
                        for (int bj = 0; bj < 2; ++bj) { f32x4 y[2];
#pragma unroll
                            for (int n = 0; n < 2; ++n) y[n] = acc[ai][bj][m][n] * rstd * gn[bj][n];
                            f32x4 pr[2];
#pragma unroll
                            for (int n = 0; n < 2; ++n)
#pragma unroll
                                for (int j = 0; j < 4; ++j) pr[n][j] = shx_(y[n][j], 32, fq * 16 + fr);
                            if (isx) { const int pos = bj == 0 ? (t >> 6) : (t & 63); const PG8_LAS float* cp = rope + pos * 16 + f0;
#pragma unroll
                                for (int n = 0; n < 2; ++n) { const f32x4 c = *(const PG8_LAS f32x4*)(cp + 4 * n), s = *(const PG8_LAS f32x4*)(cp + 1024 + 4 * n);
                                    y[n] = half == 0 ? y[n] * c - pr[n] * s : y[n] * c + pr[n] * s; } }
                            const f32x4 o0 = y[0] * osc, o1 = y[1] * osc;
                            u32x4 w; w.x = cvt_pk_bf16(o0[0], o0[1]); w.y = cvt_pk_bf16(o0[2], o0[3]); w.z = cvt_pk_bf16(o1[0], o1[1]); w.w = cvt_pk_bf16(o1[2], o1[3]);
                            bf16_t* dst = isq ? QP + (size_t)grow * 512 + (ct * 4 + wc) * 64 + 32 * bj + 8 * fq : KP + kvrow * 128 + wc * 64 + 32 * bj + 8 * fq;
                            *(u32x4*)dst = w; }
                    }
                }
        } else if (ct == 3) {
            bf16_t* base = Z + (size_t)(gr0 + wr * 64 + fr) * 1024 + ct * 256 + wc * 32 + 8 * fq;
#pragma unroll
            for (int ai = 0; ai < 2; ++ai)
#pragma unroll
                for (int m = 0; m < 4; ++m) { bf16_t* rowp = base + (size_t)(ai * HALF + m * 16) * 1024;
#pragma unroll
                    for (int bj = 0; bj < 2; ++bj) { const f32x4 v0 = acc[ai][bj][m][0], v1 = acc[ai][bj][m][1];
                        u32x4 w; w.x = cvt_pk_bf16(v0[0], v0[1]); w.y = cvt_pk_bf16(v0[2], v0[3]); w.z = cvt_pk_bf16(v1[0], v1[1]); w.w = cvt_pk_bf16(v1[2], v1[3]);
                        *(u32x4*)(rowp + bj * HALF) = w; } }
        } else {
            const int part = ct - 4; const bool isx = gr0 < XROWS;
            const int b = isx ? (gr0 >> 12) : ((gr0 - XROWS) >> 8);
            const int L = isx ? SEQL : CTXL;
            const int l0 = (isx ? (gr0 & 4095) : 0) + wr * 64 + fr;
            bf16_t* T = isx ? PQt : PQtc;
#pragma unroll
            for (int bj = 0; bj < 2; ++bj)
#pragma unroll
                for (int n = 0; n < 2; ++n)
#pragma unroll
                    for (int j = 0; j < 4; ++j) { const int cc = bj * HALF + wc * 32 + 8 * fq + 4 * n + j;
                        bf16_t* cp = T + ((size_t)((b * 256 + cc) * 2 + part)) * L + l0;
#pragma unroll
                        for (int ai = 0; ai < 2; ++ai)
#pragma unroll
                            for (int m = 0; m < 4; ++m) cp[ai * HALF + m * 16] = (bf16_t)(cvt_pk_bf16(acc[ai][bj][m][n][j], 0.f) & 0xffffu); }
        }
    }
};
struct EpiRes {
    static constexpr bool PERM = true, AFTER_DRAIN = false;
    const float* bx; const float* bc; const bf16_t* bs; bf16_t* os; float* of; const float* gate;
    __device__ __forceinline__ void operator()(const f32x4 (&acc)[2][2][4][2], const Unit& u, int wr, int wc, int fr, int fq) const {
        asm volatile("" : "+v"(fr), "+v"(fq));
        const bool isx = u.pm < 256;
        const float* gt = gate + (size_t)(isx ? (u.pm >> 4) : 16) * MODW;
        const int col0 = u.pn * BM + wc * 64 + 8 * fq;
        f32x4 gv[2][2];
#pragma unroll
        for (int bj = 0; bj < 2; ++bj)
#pragma unroll
            for (int n = 0; n < 2; ++n) gv[bj][n] = *(const f32x4*)(gt + col0 + bj * 32 + 4 * n);
        const bool bf32 = bx != nullptr, obf = os != nullptr;
#pragma unroll
        for (int ai = 0; ai < 2; ++ai)
#pragma unroll
            for (int m = 0; m < 4; ++m) { const size_t grow = (size_t)u.pm * BM + ai * HALF + wr * 64 + m * 16 + fr;
#pragma unroll
                for (int bj = 0; bj < 2; ++bj) { const size_t off = grow * 1024 + col0 + bj * 32; f32x4 b0, b1;
                    if (bf32) { const float* bp = isx ? bx + off : bc + (off - (size_t)XROWS * 1024); b0 = *(const f32x4*)bp; b1 = *(const f32x4*)(bp + 4); }
                    else { const u32x4 w = *(const u32x4*)(bs + off);
                        b0 = (f32x4){__builtin_bit_cast(float, w.x << 16), __builtin_bit_cast(float, w.x & 0xffff0000u), __builtin_bit_cast(float, w.y << 16), __builtin_bit_cast(float, w.y & 0xffff0000u)};
                        b1 = (f32x4){__builtin_bit_cast(float, w.z << 16), __builtin_bit_cast(float, w.z & 0xffff0000u), __builtin_bit_cast(float, w.w << 16), __builtin_bit_cast(float, w.w & 0xffff0000u)}; }
                    const f32x4 o0 = b0 + gv[bj][0] * acc[ai][bj][m][0], o1 = b1 + gv[bj][1] * acc[ai][bj][m][1];
                    if (obf) { u32x4 w; w.x = cvt_pk_bf16(o0[0], o0[1]); w.y = cvt_pk_bf16(o0[2], o0[3]); w.z = cvt_pk_bf16(o1[0], o1[1]); w.w = cvt_pk_bf16(o1[2], o1[3]); *(u32x4*)(os + off) = w; }
                    else { *(f32x4*)(of + off) = o0; *(f32x4*)(of + off + 4) = o1; } } }
    }
};
struct EpiSwiglu {
    static constexpr bool PERM = true, AFTER_DRAIN = false;
    bf16_t* H;
    __device__ __forceinline__ void operator()(const f32x4 (&acc)[2][2][4][2], const Unit& u, int wr, int wc, int fr, int fq) const {
        asm volatile("" : "+v"(fr), "+v"(fq));
        bf16_t* base = H + (size_t)(u.pm * BM + wr * 64 + fr) * 2816 + u.pn * HALF + wc * 32 + 8 * fq;
#pragma unroll
        for (int ai = 0; ai < 2; ++ai)
#pragma unroll
            for (int m = 0; m < 4; ++m) { float r[8];
#pragma unroll
                for (int n = 0; n < 2; ++n)
#pragma unroll
                    for (int j = 0; j < 4; ++j) { const float g = acc[ai][0][m][n][j], up = acc[ai][1][m][n][j];
                        r[n * 4 + j] = g * __builtin_amdgcn_rcpf(1.0f + __builtin_amdgcn_exp2f(-1.4426950408889634f * g)) * up; }
                u32x4 w; w.x = cvt_pk_bf16(r[0], r[1]); w.y = cvt_pk_bf16(r[2], r[3]); w.z = cvt_pk_bf16(r[4], r[5]); w.w = cvt_pk_bf16(r[6], r[7]);
                *(u32x4*)(base + (size_t)(ai * HALF + m * 16) * 2816) = w; }
    }
};
struct EpiFour {
    static constexpr bool PERM = true, AFTER_DRAIN = false;
    bf16_t* MX; int rowbase, L; float scale;
    __device__ __forceinline__ void operator()(const f32x4 (&acc)[2][2][4][2], const Unit& u, int wr, int wc, int fr, int fq) const {
        asm volatile("" : "+v"(fr), "+v"(fq));
        bf16_t* base = MX + (size_t)(rowbase + u.pn * L + u.pm * BM + wr * 64 + fr) * 1024 + 768 + wc * 32 + 8 * fq;
#pragma unroll
        for (int ai = 0; ai < 2; ++ai)
#pragma unroll
            for (int m = 0; m < 4; ++m) { bf16_t* rowp = base + (size_t)(ai * HALF + m * 16) * 1024;
#pragma unroll
                for (int bj = 0; bj < 2; ++bj) { const f32x4 v0 = acc[ai][bj][m][0] * scale, v1 = acc[ai][bj][m][1] * scale;
                    u32x4 w; w.x = cvt_pk_bf16(v0[0], v0[1]); w.y = cvt_pk_bf16(v0[2], v0[3]); w.z = cvt_pk_bf16(v1[0], v1[1]); w.w = cvt_pk_bf16(v1[2], v1[3]);
                    *(u32x4*)(rowp + bj * HALF) = w; } }
    }
};
template <class Epi, class Sched, bool ALIGN_EPI = false, bool SP2 = false>
__device__ __forceinline__ void gemm_phase(PG8_LAS unsigned char* lds, const Gemm g, const Sched& S, const Epi& E) {
    int tid_l = threadIdx.x; asm volatile("" : "+v"(tid_l)); const int tid = tid_l, wid = __builtin_amdgcn_readfirstlane(tid >> 6), lane = tid & 63, wr = wid >> 2, wc = wid & 3, fr = lane & 15, fq = lane >> 4;
    const int K = g.K, nt = K / BK;
    unsigned voffA[2], voffB[2];
#pragma unroll
    for (int i = 0; i < 2; ++i) { int R, C; stage_rc(tid * 16 + i * 8192, R, C); const int Rb = Epi::PERM ? ((R & ~31) + perm32(R & 31)) : R;
        voffA[i] = (unsigned)(R * K + C) * 2u; voffB[i] = (unsigned)(Rb * K + C) * 2u; }
    const size_t kstep = (size_t)(BK * 2);
    const size_t hstep = (size_t)HALF * K * 2;
    const size_t tstep = 2 * hstep;
    const unsigned ldsw = (unsigned)wid * 1024u;
    const int aoff = lds_byte(wr * 64 + fr, fq * 8), boff = lds_byte(wc * 32 + fr, fq * 8);
#define PG8_SA(b, h) (((b) * 2 + (h)) * HTB)
#define PG8_SB(b, h) ((4 + (b) * 2 + (h)) * HTB)
#define PG8_STAGE(bufoff, gbase, voff) do { _Pragma("unroll") for (int _i = 0; _i < 2; ++_i) \
        __builtin_amdgcn_global_load_lds((const unsigned*)((const char*)(gbase) + (voff)[_i]), (PG8_LAS unsigned*)(lds + (bufoff) + ldsw + _i * 8192), 16, 0, 0); } while (0)
#define PG8_LDA(dst, b, h) do { _Pragma("unroll") for (int m = 0; m < 4; ++m) _Pragma("unroll") for (int k = 0; k < 2; ++k) dst[m][k] = *(const PG8_LAS bf16x8*)(lds + PG8_SA(b, h) + aoff + m * 2048 + k * 1024); } while (0)
#define PG8_LDB(dst, b, h) do { _Pragma("unroll") for (int n = 0; n < 2; ++n) _Pragma("unroll") for (int k = 0; k < 2; ++k) dst[n][k] = *(const PG8_LAS bf16x8*)(lds + PG8_SB(b, h) + boff + n * 2048 + k * 1024); } while (0)
#define PG8_MMA(ai, bj, At, Bt) do { __builtin_amdgcn_s_setprio(1); _Pragma("unroll") for (int m = 0; m < 4; ++m) _Pragma("unroll") for (int n = 0; n < 2; ++n) _Pragma("unroll") for (int k = 0; k < 2; ++k) \
        acc[ai][bj][m][n] = __builtin_amdgcn_mfma_f32_16x16x32_bf16(Bt[n][k], At[m][k], acc[ai][bj][m][n], 0, 0, 0); __builtin_amdgcn_s_setprio(0); } while (0)
#define PG8_WAIT_V(n) asm volatile("s_waitcnt vmcnt(" #n ")" ::: "memory")
#define PG8_WAIT_L(n) asm volatile("s_waitcnt lgkmcnt(" #n ")" ::: "memory")
#define PG8_BAR __builtin_amdgcn_s_barrier()
#define PG8_SCHED __builtin_amdgcn_sched_barrier(0)
    Unit cur, nxt; int ui = 0;
    if (!S.next(0, cur)) return;
    f32x4 acc[2][2][4][2];
#pragma unroll
    for (int a = 0; a < 2; ++a)
#pragma unroll
        for (int b = 0; b < 2; ++b)
#pragma unroll
            for (int m = 0; m < 4; ++m)
#pragma unroll
                for (int n = 0; n < 2; ++n) acc[a][b][m][n] = (f32x4){0.f, 0.f, 0.f, 0.f};
    bf16x8 At[4][2], B0[2][2], B1[2][2];
    const char* cA = (const char*)g.A + (size_t)cur.pm * tstep; const char* cB = (const char*)g.Bt + (size_t)cur.pn * tstep;
    S.a_ready(cur);
    if constexpr (SP2) {
        PG8_STAGE(PG8_SB(0, 0), cB, voffB); PG8_STAGE(PG8_SB(0, 1), cB + hstep, voffB); PG8_STAGE(PG8_SA(0, 0), cA, voffA); PG8_STAGE(PG8_SA(0, 1), cA + hstep, voffA);
        if (wr == 1) PG8_BAR;
        PG8_WAIT_V(2); PG8_BAR;
        PG8_STAGE(PG8_SB(1, 0), cB + kstep, voffB); PG8_STAGE(PG8_SA(1, 0), cA + kstep, voffA); PG8_STAGE(PG8_SB(1, 1), cB + hstep + kstep, voffB);
        PG8_WAIT_V(6); PG8_BAR;
    } else {
        PG8_STAGE(PG8_SB(0, 0), cB, voffB); PG8_STAGE(PG8_SA(0, 0), cA, voffA); PG8_STAGE(PG8_SB(0, 1), cB + hstep, voffB); PG8_STAGE(PG8_SA(0, 1), cA + hstep, voffA);
        if (wr == 1) PG8_BAR;
        PG8_WAIT_V(4); PG8_BAR;
        PG8_STAGE(PG8_SB(1, 0), cB + kstep, voffB); PG8_STAGE(PG8_SA(1, 0), cA + kstep, voffA); PG8_STAGE(PG8_SB(1, 1), cB + hstep + kstep, voffB);
        PG8_WAIT_V(6); PG8_BAR;
    }
    for (;;) {
        const bool has_next = S.next(ui + 1, nxt);
        const char* nA = has_next ? (const char*)g.A + (size_t)nxt.pm * tstep : cA; const char* nB = has_next ? (const char*)g.Bt + (size_t)nxt.pn * tstep : cB;
        for (int t = 0; t < nt; t += 2) {
            const bool last = (t == nt - 2);
            const char* a1 = cA + (size_t)(t + 1) * kstep;
            const char* a2 = last ? nA : cA + (size_t)(t + 2) * kstep; const char* b2 = last ? nB : cB + (size_t)(t + 2) * kstep;
            const char* a3 = a2 + kstep; const char* b3 = b2 + kstep;
            if (last && has_next) S.a_ready(nxt);
            if constexpr (SP2) {
            PG8_LDB(B0, 0, 0); PG8_LDB(B1, 0, 1); PG8_SCHED; PG8_LDA(At, 0, 0); PG8_STAGE(PG8_SA(1, 1), a1 + hstep, voffA);
            PG8_WAIT_V(8); PG8_WAIT_L(0); PG8_BAR; PG8_MMA(0, 0, At, B0); PG8_MMA(0, 1, At, B1); PG8_BAR; PG8_SCHED;
            PG8_LDA(At, 0, 1); PG8_STAGE(PG8_SB(0, 0), b2, voffB); PG8_STAGE(PG8_SB(0, 1), b2 + hstep, voffB); PG8_STAGE(PG8_SA(0, 0), a2, voffA);
            PG8_WAIT_V(8); PG8_WAIT_L(0); PG8_BAR; PG8_MMA(1, 0, At, B0); PG8_MMA(1, 1, At, B1); PG8_BAR; PG8_SCHED;
            PG8_LDB(B0, 1, 0); PG8_LDB(B1, 1, 1); PG8_SCHED; PG8_LDA(At, 1, 0); PG8_STAGE(PG8_SA(0, 1), a2 + hstep, voffA);
            PG8_WAIT_V(8); PG8_WAIT_L(0); PG8_BAR; PG8_MMA(0, 0, At, B0); PG8_MMA(0, 1, At, B1); PG8_BAR; PG8_SCHED;
            PG8_LDA(At, 1, 1); PG8_STAGE(PG8_SB(1, 0), b3, voffB); PG8_STAGE(PG8_SB(1, 1), b3 + hstep, voffB); PG8_STAGE(PG8_SA(1, 0), a3, voffA);
            PG8_WAIT_V(8); PG8_WAIT_L(0); PG8_BAR; PG8_MMA(1, 0, At, B0); PG8_MMA(1, 1, At, B1); PG8_BAR; PG8_SCHED;
            } else {
            PG8_LDB(B0, 0, 0); PG8_SCHED; PG8_LDA(At, 0, 0); PG8_STAGE(PG8_SA(1, 1), a1 + hstep, voffA);
            PG8_WAIT_L(8); PG8_BAR; PG8_WAIT_L(0); PG8_MMA(0, 0, At, B0); PG8_BAR; PG8_SCHED;
            PG8_LDB(B1, 0, 1); PG8_STAGE(PG8_SB(0, 0), b2, voffB);
            PG8_BAR; PG8_WAIT_L(0); PG8_MMA(0, 1, At, B1); PG8_BAR;
            PG8_LDA(At, 0, 1); PG8_STAGE(PG8_SA(0, 0), a2, voffA);
            PG8_BAR; PG8_WAIT_L(0); PG8_MMA(1, 0, At, B0); PG8_BAR; PG8_SCHED;
            PG8_STAGE(PG8_SB(0, 1), b2 + hstep, voffB);
            PG8_WAIT_V(6); PG8_BAR; PG8_MMA(1, 1, At, B1); PG8_BAR;
            PG8_LDB(B0, 1, 0); PG8_SCHED; PG8_LDA(At, 1, 0); PG8_STAGE(PG8_SA(0, 1), a2 + hstep, voffA);
            PG8_WAIT_L(8); PG8_BAR; PG8_WAIT_L(0); PG8_MMA(0, 0, At, B0); PG8_BAR; PG8_SCHED;
            PG8_LDB(B1, 1, 1); PG8_STAGE(PG8_SB(1, 0), b3, voffB);
            PG8_BAR; PG8_WAIT_L(0); PG8_MMA(0, 1, At, B1); PG8_BAR;
            PG8_LDA(At, 1, 1); PG8_STAGE(PG8_SA(1, 0), a3, voffA);
            PG8_BAR; PG8_WAIT_L(0); PG8_MMA(1, 0, At, B0); PG8_BAR; PG8_SCHED;
            PG8_STAGE(PG8_SB(1, 1), b3 + hstep, voffB);
            PG8_WAIT_V(6); PG8_BAR; PG8_MMA(1, 1, At, B1); PG8_BAR;
            }
        }
        if constexpr (ALIGN_EPI) { if (wr == 0) PG8_BAR; }
        if constexpr (!Epi::AFTER_DRAIN) { E(acc, cur, wr, wc, fr, fq); S.done(cur); }
        if (!has_next) break;
#pragma unroll
        for (int a = 0; a < 2; ++a)
#pragma unroll
            for (int b = 0; b < 2; ++b)
#pragma unroll
                for (int m = 0; m < 4; ++m)
#pragma unroll
                    for (int n = 0; n < 2; ++n) acc[a][b][m][n] = (f32x4){0.f, 0.f, 0.f, 0.f};
        cur = nxt; cA = nA; cB = nB; ++ui;
        if constexpr (ALIGN_EPI) { if (wr == 1) PG8_BAR; }
    }
    PG8_WAIT_V(0);
    if constexpr (!ALIGN_EPI) { if (wr == 0) PG8_BAR; }
    PG8_BAR;
    if constexpr (Epi::AFTER_DRAIN) { E.fused(acc, cur, wr, wc, fr, fq, lds, wid, lane); S.done(cur); }
#undef PG8_SA
#undef PG8_SB
#undef PG8_STAGE
#undef PG8_LDA
#undef PG8_LDB
#undef PG8_MMA
#undef PG8_WAIT_V
#undef PG8_WAIT_L
#undef PG8_BAR
#undef PG8_SCHED
}
}
namespace attn_body {
using bf16=__hip_bfloat16;
using bf16x8=__attribute__((ext_vector_type(8)))short;
using s16x4=__attribute__((ext_vector_type(4)))short;
using f32x16=__attribute__((ext_vector_type(16)))float;
using u32x4=__attribute__((ext_vector_type(4)))unsigned;
constexpr int D=64,QPITCH=512,KVPITCH=128,OPITCH=1024;
constexpr int NW=8,QBLK=32,QB=QBLK*NW,KVBLK=64;

__device__ __forceinline__ int crow(int r,int hi){return (r&3)+8*(r>>2)+4*hi;}
#define SBAR() __builtin_amdgcn_sched_barrier(0)
__device__ __forceinline__ void cmask(f32x16&p0,f32x16&p1,int jb,int qrel,int hi){
  const float NEG=-INFINITY; int kb=64*jb+4*hi;
  #pragma unroll
  for(int r=0;r<16;++r){int kv=kb+(r&3)+8*(r>>2); if(kv>qrel)p0[r]=NEG; if(kv+32>qrel)p1[r]=NEG;}
}

constexpr int NSLOT=3, SLOTB=8192;
constexpr int LDS_K=0, LDS_V=NSLOT*SLOTB, LDS_WS=2*NSLOT*SLOTB, LDS_OST=LDS_WS+NW*64*4, LDS_BYTES=LDS_OST+NW*4096;
constexpr float C2=0.125f*1.4426950408889634f;
__device__ __forceinline__ void glds16(const void*gsrc,unsigned lds_dst){unsigned keep;
  asm volatile("s_mov_b32 %0, m0\n\ts_mov_b32 m0, %2\n\ts_nop 0\n\tglobal_load_lds_dwordx4 %1, off\n\ts_mov_b32 m0, %0":"=&s"(keep):"v"(gsrc),"s"(lds_dst):"memory");}
__device__ __forceinline__ float max3f(float a,float b,float c){float r;asm("v_max3_f32 %0, %1, %2, %3":"=v"(r):"v"(a),"v"(b),"v"(c));return r;}
__device__ __forceinline__ float max2f(float a,float b){float r;asm("v_max_f32_e32 %0, %1, %2":"=v"(r):"v"(a),"v"(b));return r;}
__device__ __forceinline__ float fadd_s(float a,float b){float r;asm("v_add_f32_e32 %0, %1, %2":"=v"(r):"v"(a),"v"(b));return r;}
__device__ __forceinline__ float fsub_s(float a,float b){float r;asm("v_sub_f32_e32 %0, %1, %2":"=v"(r):"v"(a),"v"(b));return r;}
typedef float f32x2_t __attribute__((ext_vector_type(2))); typedef __bf16 bf16x2_t __attribute__((ext_vector_type(2)));
__device__ __forceinline__ unsigned cvtpk_s(float lo,float hi){f32x2_t v={lo,hi};bf16x2_t b=__builtin_convertvector(v,bf16x2_t);return __builtin_bit_cast(unsigned,b);}
#define WAIT_BAR(N) asm volatile("s_waitcnt vmcnt(" #N ") lgkmcnt(0)\n\ts_barrier":::"memory")

__device__ __forceinline__ void qkt(f32x16&p0,f32x16&p1,const char*Kslot,const bf16x8*qr,const f32x16&negm,int r32,int hi){
  const char*kb=Kslot+hi*1024+r32*16;
  #pragma unroll
  for(int d0=0;d0<4;++d0){
    const bf16x8 b0=*reinterpret_cast<const bf16x8*>(kb+d0*2048);
    const bf16x8 b1=*reinterpret_cast<const bf16x8*>(kb+d0*2048+512);
    if(d0==0){p0=__builtin_amdgcn_mfma_f32_32x32x16_bf16(b0,qr[0],negm,0,0,0);p1=__builtin_amdgcn_mfma_f32_32x32x16_bf16(b1,qr[0],negm,0,0,0);}
    else{p0=__builtin_amdgcn_mfma_f32_32x32x16_bf16(b0,qr[d0],p0,0,0,0);p1=__builtin_amdgcn_mfma_f32_32x32x16_bf16(b1,qr[d0],p1,0,0,0);}}
}
typedef __attribute__((address_space(3))) const char* lds_cptr;
typedef short v4i16_t __attribute__((ext_vector_type(4)));
__device__ __forceinline__ void kload8(bf16x8*kf,lds_cptr kp){
  kf[0]=*(const __attribute__((address_space(3))) bf16x8*)(kp);      kf[1]=*(const __attribute__((address_space(3))) bf16x8*)(kp+512);
  kf[2]=*(const __attribute__((address_space(3))) bf16x8*)(kp+2048); kf[3]=*(const __attribute__((address_space(3))) bf16x8*)(kp+2560);
  kf[4]=*(const __attribute__((address_space(3))) bf16x8*)(kp+4096); kf[5]=*(const __attribute__((address_space(3))) bf16x8*)(kp+4608);
  kf[6]=*(const __attribute__((address_space(3))) bf16x8*)(kp+6144); kf[7]=*(const __attribute__((address_space(3))) bf16x8*)(kp+6656);
}
__device__ __forceinline__ void kload2(bf16x8*kf,lds_cptr kp,int j){ kf[2*j]=*(const __attribute__((address_space(3))) bf16x8*)(kp+j*2048); kf[2*j+1]=*(const __attribute__((address_space(3))) bf16x8*)(kp+j*2048+512); }
__device__ __forceinline__ s16x4 vtr(lds_cptr p){ return __builtin_bit_cast(s16x4,__builtin_amdgcn_ds_read_tr16_b64_v4i16((__attribute__((address_space(3))) v4i16_t*)p)); }
__device__ __forceinline__ float rowmax(const f32x16&p0,const f32x16&p1){
  float a=max3f(p0[0],p0[1],p1[0]),b=max3f(p0[2],p0[3],p1[1]);a=max3f(a,p1[2],p1[3]);
  #pragma unroll
  for(int r=4;r<16;r+=4){a=max3f(a,p0[r],p0[r+1]);b=max3f(b,p0[r+2],p0[r+3]);a=max3f(a,p1[r],p1[r+1]);b=max3f(b,p1[r+2],p1[r+3]);}
  const float m=max2f(a,b);
  auto rr=__builtin_amdgcn_permlane32_swap(__float_as_uint(m),__float_as_uint(m),false,false);
  return max2f(__uint_as_float(rr[0]),__uint_as_float(rr[1]));
}
__device__ __forceinline__ void pv(f32x16*o,int vb,bf16x8 pa0,bf16x8 pa1,bf16x8 pa2,bf16x8 pa3){
  #pragma unroll
  for(int d0=0;d0<2;++d0){s16x4 lo[4],hi[4];
    #pragma unroll
    for(int ks=0;ks<4;++ks){
      asm volatile("ds_read_b64_tr_b16 %0,%1 offset:%c2":"=&v"(lo[ks]):"v"(vb),"i"(d0*4096+ks*1024):"memory");
      asm volatile("ds_read_b64_tr_b16 %0,%1 offset:%c2":"=&v"(hi[ks]):"v"(vb),"i"(d0*4096+ks*1024+512):"memory");}
    asm volatile("s_waitcnt lgkmcnt(0)":::"memory");SBAR();
    #define PK(k) (bf16x8){lo[k][0],lo[k][1],lo[k][2],lo[k][3],hi[k][0],hi[k][1],hi[k][2],hi[k][3]}
    o[d0]=__builtin_amdgcn_mfma_f32_32x32x16_bf16(pa0,PK(0),o[d0],0,0,0);
    o[d0]=__builtin_amdgcn_mfma_f32_32x32x16_bf16(pa1,PK(1),o[d0],0,0,0);
    o[d0]=__builtin_amdgcn_mfma_f32_32x32x16_bf16(pa2,PK(2),o[d0],0,0,0);
    o[d0]=__builtin_amdgcn_mfma_f32_32x32x16_bf16(pa3,PK(3),o[d0],0,0,0);
    #undef PK
  }
}

#ifndef ATTN_STORE16
#define ATTN_STORE16(p,v) (*(u32x4*)(p)=(v))
#endif
template<int THRL> __device__ __forceinline__ void attn_unit(const bf16*Qu,const bf16*__restrict__ Kh,const bf16*__restrict__ Vh,bf16*Ou,const int NT,char*shm){
  int tid_l=threadIdx.x; asm volatile("":"+v"(tid_l)); const int tid=tid_l,lane=tid&63,r32=lane&31,hi=lane>>5; const int wid=__builtin_amdgcn_readfirstlane(tid>>6);
  const bf16*Qw=Qu+(long)(wid*QBLK)*QPITCH;
  const unsigned lds0=(unsigned)(uintptr_t)shm;
  float*wsf=(float*)(shm+LDS_WS)+wid*64;
  const bf16*ksrc=Kh+(long)lane*KVPITCH+wid*8;
  const bf16*vsrc=Vh+(long)(16*(wid&3)+(lane>>2))*KVPITCH+(wid>>2)*32+(lane&3)*8;
  const unsigned kdst=lds0+LDS_K+wid*1024, vdst=lds0+LDS_V+wid*1024;
  #define DMA_K(t,slot) glds16(ksrc+(long)(t)*KVBLK*KVPITCH,(unsigned)__builtin_amdgcn_readfirstlane(kdst+(slot)))
  #define DMA_V(t,slot) glds16(vsrc+(long)(t)*KVBLK*KVPITCH,(unsigned)__builtin_amdgcn_readfirstlane(vdst+(slot)))
  const int vb0=(int)(lds0+LDS_V)+((lane>>4)&1)*32+(lane&3)*8+(4*hi+((lane&15)>>2))*64;
  const char*Kbase=shm+LDS_K; bf16x8 kf[8];
  const lds_cptr shm3=(lds_cptr)shm; const lds_cptr kp0=shm3+LDS_K+hi*1024+r32*16; const lds_cptr vp0=shm3+LDS_V+((lane>>4)&1)*32+(lane&3)*8+(4*hi+((lane&15)>>2))*64;
  DMA_K(0,0);DMA_V(0,0);DMA_K(1,SLOTB);
  bf16x8 qr[4];
  #pragma unroll
  for(int d0=0;d0<4;++d0)qr[d0]=*reinterpret_cast<const bf16x8*>(&Qw[(long)r32*QPITCH+d0*16+hi*8]);
  float mhat=0.f,l_reg=0.f;f32x16 o[2];o[0]=f32x16{};o[1]=f32x16{};f32x16 negm=f32x16{};asm volatile("":"+v"(negm));
  #define CMASK(P0,P1,t) do{}while(0)
  bool resc=false;
  #define START(P0,P1) do{ const float rm=rowmax(P0,P1); resc=false; \
    { const float dl=rm; mhat=fadd_s(mhat,dl); \
      _Pragma("unroll") for(int r=0;r<16;++r){P0[r]=fsub_s(P0[r],dl);P1[r]=fsub_s(P1[r],dl);} \
      _Pragma("unroll") for(int r=0;r<16;++r)negm[r]=-mhat; asm volatile("":"+v"(negm)); } \
    _Pragma("unroll") for(int r=0;r<16;++r)P0[r]=__builtin_amdgcn_exp2f(P0[r]); }while(0)
  #define RESC() do{ if(resc){ asm volatile("s_waitcnt lgkmcnt(0)":::"memory"); \
      _Pragma("unroll") for(int d_=0;d_<2;++d_) _Pragma("unroll") for(int r=0;r<16;++r)o[d_][r]*=wsf[crow(r,hi)]; } }while(0)
  f32x16 pA0,pA1,pB0,pB1;
  int sl_prev=0,sl_cur=0,sl_next=SLOTB;
  #define ROT() do{sl_prev=sl_cur;sl_cur=sl_next;sl_next=(sl_next==(NSLOT-1)*SLOTB)?0:sl_next+SLOTB;}while(0)
  DMA_K(2,2*SLOTB);
  WAIT_BAR(3);
  qkt(pA0,pA1,Kbase,qr,negm,r32,hi);asm volatile("s_nop 15\n\ts_nop 7":"+v"(pA0),"+v"(pA1));CMASK(pA0,pA1,0);
  START(pA0,pA1);
  _Pragma("unroll") for(int r=0;r<16;++r)pA1[r]=__builtin_amdgcn_exp2f(pA1[r]);
  WAIT_BAR(0);
  DMA_K(3,0);DMA_V(1,SLOTB);
  ROT();
  kload8(kf,kp0+sl_cur);
  WAIT_BAR(2);
  s16x4 vlo[8],vhi[8]; u32x4 pw0,pw1,pw2,pw3;
  #define PKW(P,B) cvtpk_s(P[B],P[B+1])
  #define PAF(k) __builtin_bit_cast(bf16x8,pw##k)
  #define VFR(i) (bf16x8){vlo[i][0],vlo[i][1],vlo[i][2],vlo[i][3],vhi[i][0],vhi[i][1],vhi[i][2],vhi[i][3]}
  #define PIN(x) asm volatile("":"+v"(x))
  #define MX3(a,b,c) __builtin_fmaxf(__builtin_fmaxf((a),(b)),(c))
  #define GAPA(MF,A0,A1,A2,A3,W0,W1,PW) do{ MF; sacc+=A0; sacc+=A1; sacc+=A2; sacc+=A3; PIN(sacc); W0; W1; PIN(PW); SBAR(); }while(0)
  #define EX(v) __builtin_amdgcn_exp2f(v)
  #define GAPB(MF,X,B) do{ MF; X[B]=EX(X[B]); X[B+1]=EX(X[B+1]); X[B+2]=EX(X[B+2]); X[B+3]=EX(X[B+3]); PIN(X); SBAR(); }while(0)
  #define VRD(i) do{ vlo[i]=vtr(vp_+(((i)>>2)*4096+((i)&3)*1024)); vhi[i]=vtr(vp_+(((i)>>2)*4096+((i)&3)*1024+512)); }while(0)
  #define KRD(G,j) do{ if(G){ kload2(kf,kp0+sl_next,j); SBAR(); } }while(0)
  #define STEP(C0,C1,P0,P1,t,GK,GV,GL) do{ SBAR(); \
    const lds_cptr vp_=vp0+sl_prev; \
    VRD(0); SBAR(); float sacc=(P0[0]+P0[1]); \
    GAPA(C0=__builtin_amdgcn_mfma_f32_32x32x16_bf16(kf[0],qr[0],negm,0,0,0), P0[2],P0[3],P0[4],P0[5],     pw0[0]=PKW(P0,0), pw0[1]=PKW(P0,2), pw0); \
    VRD(4); SBAR(); GAPA(C1=__builtin_amdgcn_mfma_f32_32x32x16_bf16(kf[1],qr[0],negm,0,0,0), P0[6],P0[7],P0[8],P0[9],     pw0[2]=PKW(P0,4), pw0[3]=PKW(P0,6), pw0); \
    VRD(1); SBAR(); GAPA(C0=__builtin_amdgcn_mfma_f32_32x32x16_bf16(kf[2],qr[1],C0,0,0,0),   P0[10],P0[11],P0[12],P0[13], pw1[0]=PKW(P0,8), pw1[1]=PKW(P0,10), pw1); \
    VRD(5); SBAR(); GAPA(C1=__builtin_amdgcn_mfma_f32_32x32x16_bf16(kf[3],qr[1],C1,0,0,0),   P0[14],P0[15],P1[0],P1[1],   pw1[2]=PKW(P0,12),pw1[3]=PKW(P0,14), pw1); \
    VRD(2); SBAR(); GAPA(C0=__builtin_amdgcn_mfma_f32_32x32x16_bf16(kf[4],qr[2],C0,0,0,0),   P1[2],P1[3],P1[4],P1[5],     pw2[0]=PKW(P1,0), pw2[1]=PKW(P1,2), pw2); \
    VRD(6); SBAR(); GAPA(C1=__builtin_amdgcn_mfma_f32_32x32x16_bf16(kf[5],qr[2],C1,0,0,0),   P1[6],P1[7],P1[8],P1[9],     pw2[2]=PKW(P1,4), pw2[3]=PKW(P1,6), pw2); \
    VRD(3); SBAR(); GAPA(C0=__builtin_amdgcn_mfma_f32_32x32x16_bf16(kf[6],qr[3],C0,0,0,0),   P1[10],P1[11],P1[12],P1[13], pw3[0]=PKW(P1,8), pw3[1]=PKW(P1,10), pw3); \
    VRD(7); SBAR(); GAPA(C1=__builtin_amdgcn_mfma_f32_32x32x16_bf16(kf[7],qr[3],C1,0,0,0),   P1[14],P1[15],0.f,0.f,       pw3[2]=PKW(P1,12),pw3[3]=PKW(P1,14), pw3); \
    l_reg+=sacc; \
    if(GK){DMA_K((t)+3,sl_cur);} if(GV){DMA_V((t)+1,sl_next);} \
    CMASK(C0,C1,t); \
    { float a=MX3(C0[0],C0[1],C1[0]),b=MX3(C0[2],C0[3],C1[1]); a=MX3(a,C1[2],C1[3]); \
      _Pragma("unroll") for(int r=4;r<16;r+=4){a=MX3(a,C0[r],C0[r+1]);b=MX3(b,C0[r+2],C0[r+3]);a=MX3(a,C1[r],C1[r+1]);b=MX3(b,C1[r+2],C1[r+3]);} \
      float rm=__builtin_fmaxf(a,b); { auto rr=__builtin_amdgcn_permlane32_swap(__float_as_uint(rm),__float_as_uint(rm),false,false); rm=__builtin_fmaxf(__uint_as_float(rr[0]),__uint_as_float(rr[1])); } \
      resc=false; \
      if(__builtin_expect(__any(rm>(float)THRL),0)){ const float dl=__builtin_fmaxf(rm,0.f); mhat+=dl; \
        _Pragma("unroll") for(int r=0;r<16;++r){C0[r]-=dl;C1[r]-=dl;} \
        _Pragma("unroll") for(int r=0;r<16;++r)negm[r]=-mhat; asm volatile("":"+v"(negm)); \
        const float f=__builtin_amdgcn_exp2f(-dl); l_reg*=f; if(hi==0)wsf[r32]=f; resc=true; } } \
    SBAR(); \
    GAPB(o[0]=__builtin_amdgcn_mfma_f32_32x32x16_bf16(PAF(0),VFR(0),o[0],0,0,0), C0,0); \
    GAPB(o[1]=__builtin_amdgcn_mfma_f32_32x32x16_bf16(PAF(0),VFR(4),o[1],0,0,0), C0,4); \
    KRD(GL,0); GAPB(o[0]=__builtin_amdgcn_mfma_f32_32x32x16_bf16(PAF(1),VFR(1),o[0],0,0,0), C0,8); \
    KRD(GL,1); GAPB(o[1]=__builtin_amdgcn_mfma_f32_32x32x16_bf16(PAF(1),VFR(5),o[1],0,0,0), C0,12); \
    KRD(GL,2); GAPB(o[0]=__builtin_amdgcn_mfma_f32_32x32x16_bf16(PAF(2),VFR(2),o[0],0,0,0), C1,0); \
    KRD(GL,3); GAPB(o[1]=__builtin_amdgcn_mfma_f32_32x32x16_bf16(PAF(2),VFR(6),o[1],0,0,0), C1,4); \
    GAPB(o[0]=__builtin_amdgcn_mfma_f32_32x32x16_bf16(PAF(3),VFR(3),o[0],0,0,0), C1,8); \
    GAPB(o[1]=__builtin_amdgcn_mfma_f32_32x32x16_bf16(PAF(3),VFR(7),o[1],0,0,0), C1,12); \
    }while(0)
  int t=1;
  #undef CMASK
  #define CMASK(P0,P1,t) do{}while(0)
  for(;t+5<NT;t+=2){
    STEP(pB0,pB1,pA0,pA1,t,true,true,true);     WAIT_BAR(2); RESC(); ROT();
    STEP(pA0,pA1,pB0,pB1,t+1,true,true,true);   WAIT_BAR(2); RESC(); ROT();
  }
  #undef CMASK
  #define CMASK(P0,P1,t) do{}while(0)
  #define ENDW(tt) do{ if((tt)+3<NT){WAIT_BAR(2);} else if((tt)+2<NT){WAIT_BAR(1);} else {WAIT_BAR(0);} }while(0)
  for(;t+1<NT;t+=2){
    STEP(pB0,pB1,pA0,pA1,t,(t+3<NT),(t+1<NT),(t+1<NT));       ENDW(t);   RESC(); ROT();
    STEP(pA0,pA1,pB0,pB1,t+1,(t+4<NT),(t+2<NT),(t+2<NT));     ENDW(t+1); RESC(); ROT();
  }
  STEP(pB0,pB1,pA0,pA1,NT-1,false,false,false); RESC();
  { float sacc=pB0[0]+pB0[1]; _Pragma("unroll") for(int r=2;r<16;++r)sacc+=pB0[r]; _Pragma("unroll") for(int r=0;r<16;++r)sacc+=pB1[r]; l_reg+=sacc;
    pw0=(u32x4){PKW(pB0,0),PKW(pB0,2),PKW(pB0,4),PKW(pB0,6)};pw1=(u32x4){PKW(pB0,8),PKW(pB0,10),PKW(pB0,12),PKW(pB0,14)};pw2=(u32x4){PKW(pB1,0),PKW(pB1,2),PKW(pB1,4),PKW(pB1,6)};pw3=(u32x4){PKW(pB1,8),PKW(pB1,10),PKW(pB1,12),PKW(pB1,14)};
    SBAR(); pv(o,vb0+sl_cur,PAF(0),PAF(1),PAF(2),PAF(3)); }
  #undef PKW
  #undef PAF
  #undef VFR
  #undef PIN
  #undef MX3
  #undef GAPA
  #undef GAPB
  #undef EX
  #undef VRD
  #undef KRD
  #undef STEP
  #undef ENDW
  {auto rr=__builtin_amdgcn_permlane32_swap(__float_as_uint(l_reg),__float_as_uint(l_reg),false,false);l_reg=__uint_as_float(rr[0])+__uint_as_float(rr[1]);}
  if(hi==0)wsf[32+r32]=l_reg;asm volatile("s_waitcnt lgkmcnt(0)":::"memory");
  float rli[16];
  #pragma unroll
  for(int r=0;r<16;++r)rli[r]=__builtin_amdgcn_rcpf(wsf[32+crow(r,hi)]);
  bf16*Ow=Ou+(long)(wid*QBLK)*OPITCH;
  { bf16*stg=(bf16*)(shm+LDS_OST)+wid*2048;
    #pragma unroll
    for(int r=0;r<16;++r){const int orow=crow(r,hi);
      #pragma unroll
      for(int d0=0;d0<2;++d0)stg[orow*64+d0*32+r32]=__float2bfloat16(o[d0][r]*rli[r]);}
    asm volatile("s_waitcnt lgkmcnt(0)":::"memory");
    #pragma unroll
    for(int i=0;i<4;++i){const int row=i*8+(lane>>3),ch=lane&7; const u32x4 v=*(const u32x4*)(stg+row*64+ch*8); ATTN_STORE16(Ow+(long)row*OPITCH+ch*8,v);} }
  asm volatile("s_waitcnt lgkmcnt(0)\n\ts_barrier":::"memory");
  #undef DMA_K
  #undef DMA_V
  #undef CMASK
  #undef START
  #undef RESC
  #undef ROT
}
#undef SBAR
#undef WAIT_BAR
}
namespace cg = cooperative_groups;
#define LAS __attribute__((address_space(3)))
typedef unsigned short bf16;
typedef unsigned v4u __attribute__((ext_vector_type(4)));
typedef unsigned v2u __attribute__((ext_vector_type(2)));
typedef float f32x4 __attribute__((ext_vector_type(4)));
constexpr int NWAVES = 8, NTHR = 512;
constexpr int DMODEL = 1024, NBATCH = 16, SEQ = 4096, CTX = 256, MXR = NBATCH * SEQ, MCR = NBATCH * CTX, MTR = MXR + MCR;
constexpr int NIN = 1536, DFF = 2816, NGU = 5632, KVL = SEQ + CTX, INW = 1280, MODW_ = 6144;
constexpr size_t MiB = 1u << 20;
constexpr size_t WS_MOD = 0, WS_WIN = 1 * MiB, WS_WOUT = 7 * MiB, WS_WGU = 11 * MiB, WS_WDN = 33 * MiB, WS_TRIG = 44 * MiB, WS_TRIGC = 108 * MiB,
                 WS_CX = 109 * MiB, WS_KP = 125 * MiB, WS_VP = 142 * MiB, WS_HX = 159 * MiB, WS_Z = 295 * MiB, WS_PQT = 431 * MiB, WS_PQTC = 495 * MiB,
                 WS_QP = 499 * MiB, WS_MX = 567 * MiB, WS_H = 295 * MiB, WS_XS = 703 * MiB, WS_PQF = 839 * MiB, WS_PQFC = 871 * MiB, WS_END = 873 * MiB, WS_CTL = 896 * 1024, CTL_BYTES = 16384;
static_assert(WS_H + (size_t)MTR * DFF * 2 <= WS_END && WS_MX + (size_t)MTR * 1024 * 2 <= WS_END && WS_KP + (size_t)NBATCH * KVL * 128 * 2 <= WS_VP, "ws map");
constexpr int LDS_BYTES = 147456;
constexpr float QSCALE = 0.125f * 1.4426950408889634f;

struct P { const float *x, *c, *ctx, *c_ctx, *w_ada, *b_ada, *g_mix, *g_ffn, *w_in, *q_gain, *k_gain, *w_pool, *pool_scale, *w_four, *w_out, *w_gate_up, *w_down; float* out; unsigned char* ws; };

__device__ __forceinline__ unsigned f2bf(float f) { unsigned u = __builtin_bit_cast(unsigned, f); return (u + 0x7fffu + ((u >> 16) & 1u)) >> 16; }
__device__ __forceinline__ unsigned pk2(float lo, float hi) { return f2bf(lo) | (f2bf(hi) << 16); }
__device__ __forceinline__ float bf2f(unsigned short h) { return __builtin_bit_cast(float, (unsigned)h << 16); }
__device__ __forceinline__ float shx(float v, int o, int lane) { return __builtin_bit_cast(float, __builtin_amdgcn_ds_bpermute((lane ^ o) << 2, __builtin_bit_cast(int, v))); }
__device__ __forceinline__ float wave_sum(float v, int lane) {
    v += shx(v, 1, lane); v += shx(v, 2, lane); v += shx(v, 4, lane); v += shx(v, 8, lane); v += shx(v, 16, lane); v += shx(v, 32, lane);
    return v;
}

__device__ __forceinline__ void p0_mod(const P& p, LAS unsigned char* lds, int tid, int wave, int lane) {
    LAS float* sc = (LAS float*)lds;
    LAS float* red = (LAS float*)(lds + 69632);
    float* MOD = (float*)(p.ws + WS_MOD);
    if ((int)blockIdx.x >= 192) return;
    for (int i = tid; i < 17 * 1024; i += NTHR) { const int r = i >> 10, k = i & 1023; const float v = r < 16 ? p.c[r * 1024 + k] : p.c_ctx[k]; sc[i] = v / (1.0f + __expf(-v)); }
    __syncthreads();
    for (int it = blockIdx.x; it < 192; it += gridDim.x) {
        const int layer = it / 96, n0 = (it % 96) * 64;
        float acc[17];
#pragma unroll
        for (int r = 0; r < 17; ++r) acc[r] = 0.f;
        const float* W = p.w_ada + ((size_t)layer * 1024 + wave * 128) * MODW_ + n0 + lane;
        for (int kc = 0; kc < 128; kc += 16) { float wv[16];
#pragma unroll
            for (int j = 0; j < 16; ++j) wv[j] = W[(size_t)(kc + j) * MODW_];
#pragma unroll
            for (int j = 0; j < 16; ++j)
#pragma unroll
                for (int r = 0; r < 17; ++r) acc[r] += sc[r * 1024 + wave * 128 + kc + j] * wv[j]; }
#pragma unroll
        for (int r = 0; r < 17; ++r) red[(wave * 17 + r) * 64 + lane] = acc[r];
        __syncthreads();
        for (int i = tid; i < 17 * 64; i += NTHR) { const int r = i >> 6, l = i & 63; float s = p.b_ada[layer * MODW_ + n0 + l];
#pragma unroll
            for (int w = 0; w < 8; ++w) s += red[(w * 17 + r) * 64 + l];
            MOD[((size_t)layer * 17 + r) * MODW_ + n0 + l] = s; }
        __syncthreads();
    }
}
__device__ __forceinline__ void p0_comp(const P& p, LAS unsigned char* lds, int tid) {
    LAS float* M2 = (LAS float*)lds;
    LAS float* tile = (LAS float*)(lds + 16384);
    for (int it = (int)gridDim.x - 1 - (int)blockIdx.x; it < 192; it += gridDim.x) {
        const int kc = it & 7, g = (it >> 3) & 3, ty = (it >> 5) % 3, layer = it / 96;
        const int k0 = kc * 128;
        LAS float* wfs = (LAS float*)(lds + 49664);
        if (ty != 0) { for (int i = tid; i < 4096; i += NTHR) wfs[i] = p.w_four[(size_t)(layer * 4 + g) * 4096 + i]; __syncthreads(); }
        for (int i = tid; i < 4096; i += NTHR) { const int c = i >> 6, d = i & 63; float v;
            if (ty == 0) v = p.w_pool[((size_t)(layer * 4 + g) * 64 + c) * 64 + d] * p.pool_scale[layer * 256 + g * 64 + d];
            else { v = 0.f;
#pragma unroll 8
                for (int m = 0; m < 64; ++m) { const float rev = (float)((m * c) & 63) * (1.0f / 64.0f); const float t = ty == 1 ? __builtin_amdgcn_cosf(rev) : __builtin_amdgcn_sinf(rev); v += t * wfs[m * 64 + d]; } }
            M2[i] = v; }
        const int srccol = (ty == 0 ? 768 : 1024) + g * 64;
        for (int i = tid; i < 128 * 64; i += NTHR) { const int kk = i >> 6, c = i & 63; tile[kk * 65 + c] = p.w_in[((size_t)layer * 1024 + k0 + kk) * INW + srccol + c]; }
        __syncthreads();
        { const int d = tid & 63, kg = tid >> 6;
          bf16* dst = (bf16*)(p.ws + WS_WIN) + ((size_t)layer * NIN + 768 + ty * 256 + g * 64 + d) * 1024 + k0 + kg * 16;
          float o[16];
#pragma unroll
          for (int j = 0; j < 16; ++j) o[j] = 0.f;
          for (int c = 0; c < 64; ++c) { const float mv = M2[c * 64 + d];
#pragma unroll
              for (int j = 0; j < 16; ++j) o[j] += tile[(kg * 16 + j) * 65 + c] * mv; }
          v4u w0, w1; w0.x = pk2(o[0], o[1]); w0.y = pk2(o[2], o[3]); w0.z = pk2(o[4], o[5]); w0.w = pk2(o[6], o[7]);
          w1.x = pk2(o[8], o[9]); w1.y = pk2(o[10], o[11]); w1.z = pk2(o[12], o[13]); w1.w = pk2(o[14], o[15]);
          *(v4u*)dst = w0; *(v4u*)(dst + 8) = w1; }
        __syncthreads();
    }
}
__device__ __forceinline__ void tr_item(const float* W, int ldw, int c0, int k0, bf16* WT, int K, int r0, LAS float* scr, int lane) {
#pragma unroll 8
    for (int i = 0; i < 32; ++i) { const int kk = 2 * i + (lane >> 5); scr[kk * 33 + (lane & 31)] = W[(size_t)(k0 + kk) * ldw + c0 + (lane & 31)]; }
    asm volatile("s_waitcnt lgkmcnt(0)" ::: "memory");
    const int c = lane & 7;
#pragma unroll
    for (int j = 0; j < 4; ++j) { const int n = (lane >> 3) + 8 * j; const LAS float* s = scr + (8 * c) * 33 + n;
        v4u o; o.x = pk2(s[0 * 33], s[1 * 33]); o.y = pk2(s[2 * 33], s[3 * 33]); o.z = pk2(s[4 * 33], s[5 * 33]); o.w = pk2(s[6 * 33], s[7 * 33]);
        *(v4u*)(WT + (size_t)(r0 + n) * K + k0 + 8 * c) = o; }
    asm volatile("s_waitcnt lgkmcnt(0)" ::: "memory");
}
__device__ __forceinline__ void p0_transposes(const P& p, LAS unsigned char* lds, int wave, int lane) {
    LAS float* scr = (LAS float*)(lds + wave * 16384);
    const int gw = blockIdx.x * NWAVES + wave, NGW = gridDim.x * NWAVES;
    constexpr int I_IN = 24 * 16, I_OUT = 32 * 16, I_GU = 176 * 16, I_DN = 32 * 44, I_L = I_IN + I_OUT + I_GU + I_DN;
    for (int it = gw; it < 2 * I_L; it += NGW) {
        const int layer = it / I_L; int r = it % I_L;
        if (r < I_IN) { const int nb = r % 24, kb = r / 24; tr_item(p.w_in + (size_t)layer * 1024 * INW, INW, nb * 32, kb * 64, (bf16*)(p.ws + WS_WIN) + (size_t)layer * NIN * 1024, 1024, (nb >> 3) * 256 + 128 * (nb & 1) + 32 * ((nb & 7) >> 1), scr, lane); continue; } r -= I_IN;
        if (r < I_OUT) { const int nb = r % 32, kb = r / 32; tr_item(p.w_out + (size_t)layer * 1024 * 1024, 1024, nb * 32, kb * 64, (bf16*)(p.ws + WS_WOUT) + (size_t)layer * 1024 * 1024, 1024, (nb >> 3) * 256 + 128 * (nb & 1) + 32 * ((nb & 7) >> 1), scr, lane); continue; } r -= I_OUT;
        if (r < I_GU) { const int nb = r % 176, kb = r / 176; const int n0 = nb * 32; const int j = n0 < DFF ? n0 : n0 - DFF; const int drow = (j >> 7) * 256 + (n0 < DFF ? 0 : 128) + (j & 127);
            tr_item(p.w_gate_up + (size_t)layer * 1024 * NGU, NGU, n0, kb * 64, (bf16*)(p.ws + WS_WGU) + (size_t)layer * NGU * 1024, 1024, drow, scr, lane); continue; } r -= I_GU;
        { const int nb = r % 32, kb = r / 32; tr_item(p.w_down + (size_t)layer * DFF * 1024, 1024, nb * 32, kb * 64, (bf16*)(p.ws + WS_WDN) + (size_t)layer * 1024 * DFF, DFF, (nb >> 3) * 256 + 128 * (nb & 1) + 32 * ((nb & 7) >> 1), scr, lane); }
    }
}
__device__ __forceinline__ void p0_trig(const P& p, int tid) {
    const int gt = blockIdx.x * NTHR + tid, NGT = gridDim.x * NTHR;
    bf16* TC = (bf16*)(p.ws + WS_TRIGC);
    for (int it = gt; it < 256 * 32; it += NGT) { const int k = it >> 5, c8 = (it & 31) * 8;
        float v[8];
#pragma unroll
        for (int jj = 0; jj < 8; ++jj) { const int j = c8 + jj; const bool isS = j > 128; const int l = isS ? j - 128 : j; const float rev = (float)((k * l) & 255) * (1.0f / 256.0f); v[jj] = isS ? -__builtin_amdgcn_sinf(rev) : __builtin_amdgcn_cosf(rev); }
        v4u w; w.x = pk2(v[0], v[1]); w.y = pk2(v[2], v[3]); w.z = pk2(v[4], v[5]); w.w = pk2(v[6], v[7]);
        *(v4u*)(TC + (size_t)k * 256 + c8) = w; }
}
__device__ __forceinline__ void norm_phase(const float* sx, const float* scx, int nrows, const float* g, const float* modl, int shift_chunk, int scale_chunk, bf16* HX, int wave, int lane) {
    constexpr int R = 2;
    const int gw = blockIdx.x * NWAVES + wave, NGW = gridDim.x * NWAVES;
    f32x4 gm[4];
#pragma unroll
    for (int j = 0; j < 4; ++j) gm[j] = *(const f32x4*)(g + 256 * j + 4 * lane);
    for (int m0 = gw * R; m0 < nrows; m0 += NGW * R) {
        f32x4 v[R][4];
#pragma unroll
        for (int e = 0; e < R; ++e) { const int m = m0 + e; const float* xrow = m < MXR ? sx + (size_t)m * 1024 : scx + (size_t)(m - MXR) * 1024;
#pragma unroll
            for (int j = 0; j < 4; ++j) v[e][j] = *(const f32x4*)(xrow + 256 * j + 4 * lane); }
#pragma unroll
        for (int e = 0; e < R; ++e) { const int m = m0 + e; const float* md = modl + (size_t)(m < MXR ? (m >> 12) : 16) * MODW_;
            float s = 0.f;
#pragma unroll
            for (int j = 0; j < 4; ++j) s += (v[e][j].x * v[e][j].x + v[e][j].y * v[e][j].y) + (v[e][j].z * v[e][j].z + v[e][j].w * v[e][j].w);
            const float rstd = 1.0f / sqrtf(wave_sum(s, lane) * (1.0f / 1024.0f) + 1e-6f);
#pragma unroll
            for (int j = 0; j < 4; ++j) { const f32x4 scv = *(const f32x4*)(md + scale_chunk * 1024 + 256 * j + 4 * lane), shv = *(const f32x4*)(md + shift_chunk * 1024 + 256 * j + 4 * lane);
                const f32x4 y = v[e][j] * rstd * gm[j] * (scv + 1.0f) + shv;
                v2u w; w.x = pk2(y.x, y.y); w.y = pk2(y.z, y.w);
                *(v2u*)(HX + (size_t)m * 1024 + 256 * j + 4 * lane) = w; } }
    }
}
__device__ __forceinline__ void norm_phase_bf16(const bf16* XS, int nrows, const float* g, const float* modl, int shift_chunk, int scale_chunk, bf16* HX, int wave, int lane) {
    constexpr int R = 4;
    const int gw = blockIdx.x * NWAVES + wave, NGW = gridDim.x * NWAVES;
    f32x4 gm[4];
#pragma unroll
    for (int j = 0; j < 4; ++j) gm[j] = *(const f32x4*)(g + 16 * lane + 4 * j);
    for (int m0 = gw * R; m0 < nrows; m0 += NGW * R) {
        v4u ra[R][2];
#pragma unroll
        for (int e = 0; e < R; ++e) { const bf16* xr = XS + (size_t)(m0 + e) * 1024 + lane * 16; ra[e][0] = *(const v4u*)xr; ra[e][1] = *(const v4u*)(xr + 8); }
#pragma unroll
        for (int e = 0; e < R; ++e) { const int m = m0 + e; const float* md = modl + (size_t)(m < MXR ? (m >> 12) : 16) * MODW_;
            const v4u r0 = ra[e][0], r1 = ra[e][1];
            f32x4 v[4];
            v[0] = (f32x4){__builtin_bit_cast(float, r0.x << 16), __builtin_bit_cast(float, r0.x & 0xffff0000u), __builtin_bit_cast(float, r0.y << 16), __builtin_bit_cast(float, r0.y & 0xffff0000u)};
            v[1] = (f32x4){__builtin_bit_cast(float, r0.z << 16), __builtin_bit_cast(float, r0.z & 0xffff0000u), __builtin_bit_cast(float, r0.w << 16), __builtin_bit_cast(float, r0.w & 0xffff0000u)};
            v[2] = (f32x4){__builtin_bit_cast(float, r1.x << 16), __builtin_bit_cast(float, r1.x & 0xffff0000u), __builtin_bit_cast(float, r1.y << 16), __builtin_bit_cast(float, r1.y & 0xffff0000u)};
            v[3] = (f32x4){__builtin_bit_cast(float, r1.z << 16), __builtin_bit_cast(float, r1.z & 0xffff0000u), __builtin_bit_cast(float, r1.w << 16), __builtin_bit_cast(float, r1.w & 0xffff0000u)};
            float s = 0.f;
#pragma unroll
            for (int j = 0; j < 4; ++j) s += (v[j].x * v[j].x + v[j].y * v[j].y) + (v[j].z * v[j].z + v[j].w * v[j].w);
            const float rstd = 1.0f / sqrtf(wave_sum(s, lane) * (1.0f / 1024.0f) + 1e-6f);
            unsigned o[8];
#pragma unroll
            for (int j = 0; j < 4; ++j) { const f32x4 scv = *(const f32x4*)(md + scale_chunk * 1024 + 16 * lane + 4 * j), shv = *(const f32x4*)(md + shift_chunk * 1024 + 16 * lane + 4 * j);
                const f32x4 y = v[j] * rstd * gm[j] * (scv + 1.0f) + shv; o[2 * j] = pk2(y.x, y.y); o[2 * j + 1] = pk2(y.z, y.w); }
            bf16* hp = HX + (size_t)m * 1024 + lane * 16;
            *(v4u*)hp = (v4u){o[0], o[1], o[2], o[3]}; *(v4u*)(hp + 8) = (v4u){o[4], o[5], o[6], o[7]}; }
    }
}
__device__ __forceinline__ void prep_phase(const P& p, int layer, LAS unsigned char* lds, int tid, int wave, int lane, int cu, int ncu) {
    const bf16* Z = (const bf16*)(p.ws + WS_Z); bf16* MX = (bf16*)(p.ws + WS_MX);
    const int gw = cu * NWAVES + wave, NGW = ncu * NWAVES;
    { const int nrows = layer == 0 ? MTR : MXR;
      for (int it = gw; it < nrows / 4; it += NGW) {
        const int m = it * 4 + (lane >> 4), c = lane & 15;
        const bool isx = m < MXR;
        const int t = isx ? (m & 4095) : ((m - MXR) & 255), L = isx ? SEQ : CTX;
        const int w = 2 << (c >> 2);
        int lo = t - (w >> 1); if (lo < 0) lo = 0; int hi = t + w - (w >> 1); if (hi > L) hi = L;
        const bf16* zb = Z + (size_t)(m - t) * 1024 + 768 + c * 16;
        float a[16];
#pragma unroll
        for (int f = 0; f < 16; ++f) a[f] = 0.f;
        float sv[16];
        { const v4u q0 = *(const v4u*)(zb + (size_t)t * 1024), q1 = *(const v4u*)(zb + (size_t)t * 1024 + 8);
          const unsigned ww[8] = {q0.x, q0.y, q0.z, q0.w, q1.x, q1.y, q1.z, q1.w};
#pragma unroll
          for (int j = 0; j < 8; ++j) { sv[2 * j] = __builtin_bit_cast(float, ww[j] << 16); sv[2 * j + 1] = __builtin_bit_cast(float, ww[j] & 0xffff0000u); } }
#pragma unroll
        for (int ib = 0; ib < 16; ib += 8) { v4u q0[8], q1[8];
#pragma unroll
            for (int i = 0; i < 8; ++i) { int tt = lo + ib + i; if (tt > hi - 1) tt = hi - 1; q0[i] = *(const v4u*)(zb + (size_t)tt * 1024); q1[i] = *(const v4u*)(zb + (size_t)tt * 1024 + 8); }
#pragma unroll
            for (int i = 0; i < 8; ++i) { const float wgt = (lo + ib + i < hi) ? 1.0f : 0.0f;
                const unsigned ww[8] = {q0[i].x, q0[i].y, q0[i].z, q0[i].w, q1[i].x, q1[i].y, q1[i].z, q1[i].w};
#pragma unroll
                for (int j = 0; j < 8; ++j) { a[2 * j] += wgt * __builtin_bit_cast(float, ww[j] << 16); a[2 * j + 1] += wgt * __builtin_bit_cast(float, ww[j] & 0xffff0000u); } } }
        const float inv = 1.0f / (float)(hi - lo);
        v4u w0, w1;
        w0.x = pk2(a[0] * inv - sv[0], a[1] * inv - sv[1]); w0.y = pk2(a[2] * inv - sv[2], a[3] * inv - sv[3]); w0.z = pk2(a[4] * inv - sv[4], a[5] * inv - sv[5]); w0.w = pk2(a[6] * inv - sv[6], a[7] * inv - sv[7]);
        w1.x = pk2(a[8] * inv - sv[8], a[9] * inv - sv[9]); w1.y = pk2(a[10] * inv - sv[10], a[11] * inv - sv[11]); w1.z = pk2(a[12] * inv - sv[12], a[13] * inv - sv[13]); w1.w = pk2(a[14] * inv - sv[14], a[15] * inv - sv[15]);
        bf16* o = MX + (size_t)m * 1024 + 512 + c * 16; *(v4u*)o = w0; *(v4u*)(o + 8) = w1;
      } }
    __syncthreads();
    { LAS unsigned short* row = (LAS unsigned short*)(lds + wave * 16384);
      const bf16* PQT = (const bf16*)(p.ws + WS_PQT); const bf16* PQTC = (const bf16*)(p.ws + WS_PQTC); bf16* PQF = (bf16*)(p.ws + WS_PQF); bf16* PQFC = (bf16*)(p.ws + WS_PQFC);
      const int ntot = layer == 0 ? 8192 : 4096;
      for (int it = 4096 + gw; it < ntot; it += NGW) {
        const bool isx = it < 4096; const int n = isx ? it : it - 4096, L = isx ? SEQ : CTX, H2 = L >> 1;
        const bf16* src = isx ? PQT + (size_t)n * 8192 : PQTC + (size_t)n * 512;
        bf16* dst = isx ? PQF + (size_t)n * 4096 : PQFC + (size_t)n * 256;
        for (int c = lane; c < L / 4; c += 64) *(LAS v4u*)(row + c * 8) = *(const v4u*)(src + c * 8);
        asm volatile("s_waitcnt vmcnt(0) lgkmcnt(0)" ::: "memory");
        for (int c = lane; c < L / 8; c += 64) { const int j0 = c * 8; float o[8];
#pragma unroll
            for (int jj = 0; jj < 8; ++jj) { const int j = j0 + jj; const bool lowh = j <= H2; const int l = j - H2;
                const int ia = lowh ? j : L + l, ib = lowh ? L - j : 2 * L - l;
                const float va = bf2f(row[ia]), vb = bf2f(row[ib]);
                const float sg = lowh ? ((j == 0 || j == H2) ? 0.0f : 1.0f) : -1.0f;
                o[jj] = va + sg * vb; }
            v4u w; w.x = pk2(o[0], o[1]); w.y = pk2(o[2], o[3]); w.z = pk2(o[4], o[5]); w.w = pk2(o[6], o[7]);
            *(v4u*)(dst + j0) = w; }
        asm volatile("s_waitcnt lgkmcnt(0)" ::: "memory");
      } }
    __syncthreads();
}

__device__ __forceinline__ constexpr int bitrev6(int i) { return ((i & 1) << 5) | ((i & 2) << 3) | ((i & 4) << 1) | ((i & 8) >> 1) | ((i & 16) >> 3) | ((i & 32) >> 5); }
typedef float f32x2 __attribute__((ext_vector_type(2)));
template <int HALF> __device__ __forceinline__ void fft64_stage(f32x2 (&x)[64]) {
constexpr float FC[32] = {1.000000000e+00f, 9.951847267e-01f, 9.807852804e-01f, 9.569403357e-01f, 9.238795325e-01f, 8.819212643e-01f, 8.314696123e-01f, 7.730104534e-01f, 7.071067812e-01f, 6.343932842e-01f, 5.555702330e-01f, 4.713967368e-01f, 3.826834324e-01f, 2.902846773e-01f, 1.950903220e-01f, 9.801714033e-02f, 6.123233996e-17f, -9.801714033e-02f, -1.950903220e-01f, -2.902846773e-01f, -3.826834324e-01f, -4.713967368e-01f, -5.555702330e-01f, -6.343932842e-01f, -7.071067812e-01f, -7.730104534e-01f, -8.314696123e-01f, -8.819212643e-01f, -9.238795325e-01f, -9.569403357e-01f, -9.807852804e-01f, -9.951847267e-01f};
    constexpr float FS[32] = {0.000000000e+00f, 9.801714033e-02f, 1.950903220e-01f, 2.902846773e-01f, 3.826834324e-01f, 4.713967368e-01f, 5.555702330e-01f, 6.343932842e-01f, 7.071067812e-01f, 7.730104534e-01f, 8.314696123e-01f, 8.819212643e-01f, 9.238795325e-01f, 9.569403357e-01f, 9.807852804e-01f, 9.951847267e-01f, 1.000000000e+00f, 9.951847267e-01f, 9.807852804e-01f, 9.569403357e-01f, 9.238795325e-01f, 8.819212643e-01f, 8.314696123e-01f, 7.730104534e-01f, 7.071067812e-01f, 6.343932842e-01f, 5.555702330e-01f, 4.713967368e-01f, 3.826834324e-01f, 2.902846773e-01f, 1.950903220e-01f, 9.801714033e-02f};
#pragma unroll
    for (int b0 = 0; b0 < 64; b0 += 2 * HALF)
#pragma unroll
        for (int j = 0; j < HALF; ++j) { const int e = j * (32 / HALF), i0 = b0 + j, i1 = b0 + j + HALF;
            const f32x2 a = x[i0], b = x[i1];
            x[i0] = a + b;
            const f32x2 d = a - b, dsw = __builtin_shufflevector(d, d, 1, 0);
            if (e == 0) x[i1] = d;
            else if (e == 16) x[i1] = dsw * (f32x2){1.0f, -1.0f};
            else x[i1] = d * (f32x2){FC[e], FC[e]} + dsw * (f32x2){FS[e], -FS[e]}; }
}
__device__ __forceinline__ void fft64_dif(f32x2 (&x)[64]) {
    fft64_stage<32>(x); __builtin_amdgcn_sched_barrier(0); fft64_stage<16>(x); __builtin_amdgcn_sched_barrier(0); fft64_stage<8>(x); __builtin_amdgcn_sched_barrier(0);
    fft64_stage<4>(x); __builtin_amdgcn_sched_barrier(0); fft64_stage<2>(x); __builtin_amdgcn_sched_barrier(0); fft64_stage<1>(x); __builtin_amdgcn_sched_barrier(0);
}
__device__ __forceinline__ void fft_phase(const P& p, LAS unsigned char* lds, int tid, int wave, int lane, int cu, int ncu) {
    const bf16* PQT = (const bf16*)(p.ws + WS_PQT); bf16* MX = (bf16*)(p.ws + WS_MX);
    LAS unsigned short* row = (LAS unsigned short*)(lds + wave * 16640);
    LAS float* T = (LAS float*)(lds + wave * 16640);
    LAS unsigned short* OUT = (LAS unsigned short*)lds;
    for (int it = cu; it < 512; it += ncu) {
        const int bgi = it >> 3, db = it & 7, n = bgi * 64 + db * 8 + wave;
        int lane_t = lane; asm volatile("" : "+v"(lane_t));
        const bf16* src = PQT + (size_t)n * 8192;
        for (int c = lane; c < 1024; c += 64) *(LAS v4u*)(row + c * 8) = *(const v4u*)(src + c * 8);
        asm volatile("s_waitcnt vmcnt(0) lgkmcnt(0)" ::: "memory"); __builtin_amdgcn_sched_barrier(0);
        f32x2 x[64];
#pragma unroll
        for (int r = 0; r < 64; ++r) x[r] = (f32x2){bf2f(row[64 * r + lane]), -bf2f(row[4096 + 64 * r + lane])};
        asm volatile("s_waitcnt lgkmcnt(0)" ::: "memory"); __builtin_amdgcn_sched_barrier(0);
        fft64_dif(x);
        float ti[64];
#pragma unroll
        for (int r = 0; r < 64; ++r) { const int k1 = bitrev6(r); const float rev = (float)((k1 * lane_t) & 4095) * (1.0f / 4096.0f);
            const float c = __builtin_amdgcn_cosf(rev), s = __builtin_amdgcn_sinf(rev);
            const f32x2 t = x[r] * (f32x2){c, c} + __builtin_shufflevector(x[r], x[r], 1, 0) * (f32x2){s, -s}; T[k1 * 65 + lane] = t.x; ti[r] = t.y; }
        f32x2 bb[64];
        asm volatile("s_waitcnt lgkmcnt(0)" ::: "memory"); __builtin_amdgcn_sched_barrier(0);
#pragma unroll
        for (int r = 0; r < 64; ++r) bb[r].x = T[lane * 65 + r];
        asm volatile("s_waitcnt lgkmcnt(0)" ::: "memory"); __builtin_amdgcn_sched_barrier(0);
#pragma unroll
        for (int r = 0; r < 64; ++r) { const int k1 = bitrev6(r); T[k1 * 65 + lane] = ti[r]; }
        asm volatile("s_waitcnt lgkmcnt(0)" ::: "memory"); __builtin_amdgcn_sched_barrier(0);
#pragma unroll
        for (int r = 0; r < 64; ++r) bb[r].y = T[lane * 65 + r];
        asm volatile("s_waitcnt lgkmcnt(0)" ::: "memory"); __builtin_amdgcn_sched_barrier(0);
        fft64_dif(bb);
        __syncthreads();
#pragma unroll
        for (int r = 0; r < 64; ++r) { const int k2 = bitrev6(r); OUT[(lane + 64 * k2) * 8 + wave] = (unsigned short)f2bf(bb[r].x * (1.0f / 512.0f)); }
        __syncthreads();
        { const int b = bgi >> 2, g = bgi & 3;
#pragma unroll
          for (int i = 0; i < 8; ++i) { const int k = tid + 512 * i; const v4u v = *(const LAS v4u*)(OUT + k * 8);
              *(v4u*)(MX + ((size_t)(b * SEQ + k)) * 1024 + 768 + g * 64 + db * 8) = v; } }
        __syncthreads();
    }
}
typedef __attribute__((address_space(1))) unsigned gu32;
#define RLX_AGENT __ATOMIC_RELAXED, __HIP_MEMORY_SCOPE_AGENT
#define XB_TMO      128
#define XB_XCNT(j)  (256  + 64 * (j))
#define XB_XSUB(j)  (1280 + 64 * (j))
#define XB_XGEN(j)  (2304 + 64 * (j))
#define XB_TOP      3328
#define XB_TOPGEN   3392
#define XCD_BAR_WORDS 3456
#define XB_SPIN_CAP (1u << 18)

__device__ __forceinline__ unsigned xb_ld(unsigned* p)              { return __hip_atomic_load(p, __ATOMIC_RELAXED, __HIP_MEMORY_SCOPE_AGENT); }
__device__ __forceinline__ unsigned xb_add(unsigned* p, unsigned v) { return __hip_atomic_fetch_add(p, v, __ATOMIC_RELAXED, __HIP_MEMORY_SCOPE_AGENT); }
__device__ __forceinline__ unsigned xb_xcc_id() { return (unsigned)__builtin_amdgcn_s_getreg((3 << 11) | 20) & 0xFu; }
#define XB_SPIN(cond, bar) do { unsigned _sp = 0; while (cond) { __builtin_amdgcn_s_sleep(1); \
    if ((++_sp & 255u) == 0u) { if (xb_ld(&(bar)[XB_TMO])) break; if (_sp > XB_SPIN_CAP) { atomicAdd(&(bar)[XB_TMO], 1u); break; } } } } while (0)

struct XcdBarrier {
    unsigned* bar; unsigned x;
    volatile LAS unsigned* st;
};

__device__ __forceinline__ XcdBarrier xcd_barrier_post(unsigned* bar, volatile LAS unsigned* st) {
    XcdBarrier b; b.bar = bar; b.x = (unsigned)__builtin_amdgcn_readfirstlane((int)xb_xcc_id()); b.st = st;
    if (threadIdx.x == 0) (void)xb_add(&bar[XB_XCNT(b.x)], 1u);
    return b;
}
__device__ __forceinline__ void xcd_barrier_complete(unsigned* bar, unsigned x, unsigned& nloc, unsigned& nx) {
    const unsigned G = gridDim.x * gridDim.y * gridDim.z;
    unsigned sum, cnt, mine, sp = 0u;
    for (;;) {
        sum = 0u; cnt = 0u; mine = 0u;
#pragma unroll
        for (unsigned j = 0; j < 16; ++j) { const unsigned c = xb_ld(&bar[XB_XCNT(j)]); sum += c; cnt += (c > 0u) ? 1u : 0u; mine = (j == x) ? c : mine; }
        if (sum == G) break;
        __builtin_amdgcn_s_sleep(1);
        if ((++sp & 255u) == 0u) { if (xb_ld(&bar[XB_TMO])) break; if (sp > XB_SPIN_CAP) { atomicAdd(&bar[XB_TMO], 1u); break; } }
    }
    nloc = mine > 0u ? mine : 1u; nx = cnt > 0u ? cnt : 1u;
}

__device__ __forceinline__ void xcd_barrier(const XcdBarrier& b) {
    asm volatile("s_waitcnt vmcnt(0)" ::: "memory");
    __syncthreads();
    if (threadIdx.x == 0) {
        unsigned* bar = b.bar; unsigned bx_ = b.x; asm volatile("" : "+s"(bx_));
        __builtin_amdgcn_s_waitcnt(0);
        unsigned nloc = b.st[0], nx = b.st[1];
        if (nloc == 0u) { xcd_barrier_complete(bar, bx_, nloc, nx); b.st[0] = nloc; b.st[1] = nx; }
        const unsigned old = xb_add(&bar[XB_XSUB(bx_)], 1u);
        const unsigned gen = old / nloc;
        if (old + 1u == (gen + 1u) * nloc) {
            __builtin_amdgcn_fence(__ATOMIC_RELEASE, "agent");
            asm volatile("s_waitcnt vmcnt(0)" ::: "memory");
            const unsigned og = xb_add(&bar[XB_TOP], 1u);
            const unsigned tg = og / nx;
            if (og + 1u == (tg + 1u) * nx) xb_add(&bar[XB_TOPGEN], 1u);
            else XB_SPIN(xb_ld(&bar[XB_TOPGEN]) == tg, bar);
            __builtin_amdgcn_fence(__ATOMIC_ACQUIRE, "agent");
            xb_add(&bar[XB_XGEN(bx_)], 1u);
            asm volatile("s_waitcnt vmcnt(0)" ::: "memory");
        } else {
            XB_SPIN(xb_ld(&bar[XB_XGEN(bx_)]) == gen, bar);
            __builtin_amdgcn_fence(__ATOMIC_ACQUIRE, "agent");
            asm volatile("s_waitcnt vmcnt(0)" ::: "memory");
        }
    }
    __syncthreads();
}

__global__ void __launch_bounds__(NTHR, 2) mk_fwd(P p) {
    extern __shared__ __attribute__((aligned(16))) unsigned char lds_raw[];
    LAS unsigned char* lds = (LAS unsigned char*)lds_raw;
    cg::grid_group grid = cg::this_grid();
    if (p.ws == nullptr) grid.sync();
    volatile LAS unsigned* bst = (volatile LAS unsigned*)(lds + 138240);
    if (threadIdx.x < 2) bst[threadIdx.x] = 0u;
    __syncthreads();
    const XcdBarrier xbar = xcd_barrier_post((unsigned*)(p.ws + WS_CTL), bst);
#define GRID_SYNC() xcd_barrier(xbar)
#define FRESH_IDS() int tid = threadIdx.x; asm volatile("" : "+v"(tid)); const int lane = tid & 63, wave = __builtin_amdgcn_readfirstlane(tid >> 6); int bx = blockIdx.x; asm volatile("" : "+s"(bx)); \
    const int vcu = (G % 8 == 0) ? (bx % 8) * (G / 8) + bx / 8 : bx; (void)lane; (void)wave; (void)vcu
    const int G = gridDim.x;
    unsigned char* ws = p.ws;
    float* MOD = (float*)(ws + WS_MOD);
    bf16* HX = (bf16*)(ws + WS_HX); bf16* Zb = (bf16*)(ws + WS_Z); bf16* MXb = (bf16*)(ws + WS_MX); bf16* Hb = (bf16*)(ws + WS_H);
    bf16* PQT = (bf16*)(ws + WS_PQT); bf16* PQTC = (bf16*)(ws + WS_PQTC); bf16* XS = (bf16*)(ws + WS_XS);
    const attn_body::bf16* QPb = (const attn_body::bf16*)(ws + WS_QP); const attn_body::bf16* KPb = (const attn_body::bf16*)(ws + WS_KP); const attn_body::bf16* VPb = (const attn_body::bf16*)(ws + WS_VP);

    LAS float* ropeT = (LAS float*)(lds + 139264);
    for (int i = threadIdx.x; i < 1024; i += NTHR) { const int pos = i >> 4, f = i & 15; const float fr = expf(-(float)f * (1.0f / 16.0f) * 9.210340371976184f); const float a = (float)pos * fr; float rev = a * 0.15915494309189535f; rev -= floorf(rev);
        ropeT[i] = __builtin_amdgcn_cosf(rev); ropeT[1024 + i] = __builtin_amdgcn_sinf(rev); }
    __syncthreads();
    { FRESH_IDS();
    p0_mod(p, lds, tid, wave, lane);
    __syncthreads();
    p0_comp(p, lds, tid);
    __syncthreads();
    p0_transposes(p, lds, wave, lane);
    p0_trig(p, tid); }
    GRID_SYNC();

    for (int layer = 0; layer < 2; ++layer) {
        const bool upd = layer == 0;
        const float* modl = MOD + (size_t)layer * 17 * MODW_;
        const bf16* WIN = (const bf16*)(ws + WS_WIN) + (size_t)layer * NIN * 1024;
        const bf16* WOUT = (const bf16*)(ws + WS_WOUT) + (size_t)layer * 1024 * 1024;
        const bf16* WGU = (const bf16*)(ws + WS_WGU) + (size_t)layer * NGU * 1024;
        const bf16* WDN = (const bf16*)(ws + WS_WDN) + (size_t)layer * 1024 * DFF;
        { FRESH_IDS(); if (layer == 0) norm_phase(p.x, p.ctx, MTR, p.g_mix, modl, 0, 1, HX, wave, lane); else norm_phase_bf16(XS, MTR, p.g_mix + 1024, modl, 0, 1, HX, wave, lane); }
        GRID_SYNC();
        { FRESH_IDS();
            pg8::EpiIn E{Zb, PQT, PQTC, 0, 0, (bf16*)(ws + WS_QP), (bf16*)(ws + WS_KP), (bf16*)(ws + WS_VP), p.q_gain + layer * 64, p.k_gain + layer * 64, ropeT, QSCALE};
            if (upd) { pg8::Gemm g{HX, WIN, MTR, NIN, 1024}; pg8::StaticOrder S; S.init(MTR, NIN, G, bx); pg8::gemm_phase<pg8::EpiIn, pg8::StaticOrder, true, true>(lds, g, S, E); }
            else {
                { pg8::Gemm g{HX, WIN, MXR, NIN, 1024}; pg8::StaticOrder S; S.init(MXR, NIN, G, bx); pg8::gemm_phase<pg8::EpiIn, pg8::StaticOrder, true, true>(lds, g, S, E); }
            }
        }
        GRID_SYNC();
        { FRESH_IDS();
          const int ngemm = upd ? 0 : 16;
          if (bx >= G - ngemm) { pg8::EpiIn E2{Zb, PQT, PQTC, MXR, 512, (bf16*)(ws + WS_QP), (bf16*)(ws + WS_KP), (bf16*)(ws + WS_VP), p.q_gain + layer * 64, p.k_gain + layer * 64, ropeT, QSCALE};
              pg8::Gemm g{HX + (size_t)MXR * 1024, WIN + (size_t)512 * 1024, MCR, 256, 1024}; pg8::StaticOrder S; S.init(MCR, 256, G, G - 1 - bx);
              pg8::gemm_phase<pg8::EpiIn, pg8::StaticOrder, true, true>(lds, g, S, E2); }
          else prep_phase(p, layer, lds, tid, wave, lane, bx, G - ngemm); }
        GRID_SYNC();
        { FRESH_IDS();
            for (int i = 0; i < (2048 + G - 1) / G; ++i) { const int pu = i * G + vcu; if (pu >= 2048) break;
                const int bg = pu >> 6, u = pu & 63, b = bg >> 1, gk = bg & 1, h = gk * 4 + (u >> 4), qb = u & 15;
                const size_t qrow = (size_t)b * SEQ + qb * 256;
                attn_body::attn_unit<8>(QPb + qrow * 512 + h * 64, KPb + (size_t)b * KVL * 128 + gk * 64, VPb + (size_t)b * KVL * 128 + gk * 64,
                                        (attn_body::bf16*)MXb + qrow * 1024 + h * 64, KVL / 64, (char*)lds_raw); }
            if (upd) for (int cu = vcu; cu < 128; cu += G) { const int b = cu >> 3, h = cu & 7, gk = h >> 2; const size_t qrow = (size_t)MXR + b * CTX;
                attn_body::attn_unit<8>(QPb + qrow * 512 + h * 64, KPb + (size_t)b * KVL * 128 + gk * 64, VPb + (size_t)b * KVL * 128 + gk * 64,
                                        (attn_body::bf16*)MXb + qrow * 1024 + h * 64, CTX / 64, (char*)lds_raw); }
            fft_phase(p, lds, tid, wave, lane, bx, G);
            if (upd) { pg8::Gemm g{(const bf16*)(ws + WS_TRIGC), (const bf16*)(ws + WS_PQFC), CTX, 4096, CTX}; pg8::StaticOrder S; S.init(CTX, 4096, G, G - 1 - bx); pg8::EpiFour E{MXb, MXR, CTX, 1.0f / 128.0f};
              pg8::gemm_phase<pg8::EpiFour, pg8::StaticOrder, true, true>(lds, g, S, E); }
        }
        GRID_SYNC();
        { FRESH_IDS(); const int M = upd ? MTR : MXR; pg8::Gemm g{MXb, WOUT, M, 1024, 1024}; pg8::StaticOrder S; S.init(M, 1024, G, bx); pg8::EpiRes E{layer == 0 ? p.x : (const float*)nullptr, p.ctx, XS, XS, (float*)nullptr, modl + 2 * 1024};
          pg8::gemm_phase<pg8::EpiRes, pg8::StaticOrder, true, true>(lds, g, S, E); }
        GRID_SYNC();
        { FRESH_IDS(); norm_phase_bf16(XS, upd ? MTR : MXR, p.g_ffn + layer * 1024, modl, 3, 4, HX, wave, lane); }
        GRID_SYNC();
        { FRESH_IDS(); const int M = upd ? MTR : MXR; pg8::Gemm g{HX, WGU, M, NGU, 1024}; pg8::StaticOrder S; S.init(M, NGU, G, bx); pg8::EpiSwiglu E{Hb};
          pg8::gemm_phase<pg8::EpiSwiglu, pg8::StaticOrder, true, true>(lds, g, S, E); }
        GRID_SYNC();
        { FRESH_IDS(); const int M = upd ? MTR : MXR; pg8::Gemm g{Hb, WDN, M, 1024, DFF}; pg8::StaticOrder S; S.init(M, 1024, G, bx); pg8::EpiRes E{(const float*)nullptr, (const float*)nullptr, XS, upd ? XS : (bf16*)nullptr, p.out, modl + 5 * 1024};
          pg8::gemm_phase<pg8::EpiRes, pg8::StaticOrder, true, true>(lds, g, S, E); }
        if (layer == 0) GRID_SYNC();
    }
}

extern "C" void kernel_launch(void* const* d_in, const int* in_sizes, int n_in, void* d_out, int out_size, void* d_ws, size_t ws_size, hipStream_t stream) {
    static int grid = 0;
    if (grid == 0) {
        if (n_in != 17 || ws_size < WS_END) { fprintf(stderr, "kernel_launch: unexpected n_in %d / ws %zu\n", n_in, ws_size); grid = -1; return; }
        int dev = 0, cus = 0, per_cu = 0;
        hipGetDevice(&dev); hipDeviceGetAttribute(&cus, hipDeviceAttributeMultiprocessorCount, dev);
        hipFuncSetAttribute((const void*)mk_fwd, hipFuncAttributeMaxDynamicSharedMemorySize, LDS_BYTES);
        hipOccupancyMaxActiveBlocksPerMultiprocessor(&per_cu, (const void*)mk_fwd, NTHR, LDS_BYTES);
        (void)hipGetLastError();
        if (per_cu < 1) per_cu = 1;
        grid = cus * per_cu;
    }
    if (grid < 0) return;
    if (hipMemsetAsync((char*)d_ws + WS_CTL, 0, CTL_BYTES, stream) != hipSuccess) { fprintf(stderr, "memset failed\n"); return; }
    P p{};
    const float** pp = (const float**)&p;
    for (int i = 0; i < 17; ++i) pp[i] = (const float*)d_in[i];
    p.out = (float*)d_out; p.ws = (unsigned char*)d_ws;
    void* args[] = {&p};
    hipError_t e = hipLaunchCooperativeKernel((const void*)mk_fwd, dim3(grid), dim3(NTHR), args, LDS_BYTES, stream);
    if (e != hipSuccess) fprintf(stderr, "cooperative launch failed: %s (grid %d)\n", hipGetErrorString(e), grid);
}
```

```cpp
#include <hip/hip_runtime.h>
#include <hip/hip_bf16.h>
#include <hip/hip_cooperative_groups.h>
#include <cstdio>
#include <cstdint>
#include <cmath>
namespace pg8 {
#define PG8_LAS __attribute__((address_space(3)))
typedef unsigned short bf16_t;
typedef short bf16x8 __attribute__((ext_vector_type(8)));
typedef float f32x4 __attribute__((ext_vector_type(4)));
typedef unsigned u32x4 __attribute__((ext_vector_type(4)));
constexpr int BM = 256, BK = 64, HALF = 128, HTB = HALF * BK * 2  , STAGE_BYTES = 8 * HTB, NXCD = 8, WGM = 8;

__host__ __device__ __forceinline__ int lds_byte(int r, int c) { const int st = (r >> 4) * 2 + (c >> 5), rr = r & 15, cc = c & 31, ob = rr * 64 + cc * 2; return st * 1024 + (ob ^ (((ob >> 9) & 1) << 5)); }
__host__ __device__ __forceinline__ void stage_rc(int b, int& R, int& C) { const int st = b / 1024, sb = b % 1024, swz = sb ^ (((sb >> 9) & 1) << 5); R = (st >> 1) * 16 + swz / 64; C = (st & 1) * 32 + (swz % 64) / 2; }
__host__ __device__ __forceinline__ int perm32(int rho) { const int n = rho >> 4, i = rho & 15; return 8 * (i >> 2) + 4 * n + (i & 3); }

struct Unit { int pm, pn; };
struct Gemm { const bf16_t* A; const bf16_t* Bt; int M, N, K; };

struct StaticOrder {
    int nM, nN, nwg, G, c;
    __host__ __device__ void init(int M, int N, int G_, int c_) { nM = M / BM; nN = N / BM; nwg = nM * nN; G = G_; c = c_; }
    __host__ __device__ bool next(int i, Unit& u) const {
        const long L = (long)i * G + c; if (L >= nwg) return false;
        int wgid = (int)L; { const int q = nwg / NXCD, r = nwg % NXCD, xcd = wgid % NXCD, off = wgid / NXCD; wgid = (xcd < r ? xcd * (q + 1) : r * (q + 1) + (xcd - r) * q) + off; }
        const int nig = WGM * nN, gid = wgid / nig, fm = gid * WGM, gsz = (nM - fm) < WGM ? (nM - fm) : WGM;
        u.pm = fm + ((wgid % nig) % gsz); u.pn = (wgid % nig) / gsz; return true;
    }
    __device__ __forceinline__ void a_ready(const Unit&) const {}
    __device__ __forceinline__ void done(const Unit&) const {}
};

__device__ __forceinline__ unsigned cvt_pk_bf16(float lo, float hi) { unsigned r; asm volatile("v_cvt_pk_bf16_f32 %0, %1, %2" : "=v"(r) : "v"(lo), "v"(hi)); return r; }
typedef float f32x2 __attribute__((ext_vector_type(2)));
__device__ __forceinline__ float shx_(float v, int o, int lane) { return __builtin_bit_cast(float, __builtin_amdgcn_ds_bpermute((lane ^ o) << 2, __builtin_bit_cast(int, v))); }
constexpr int XROWS = 65536, CTXL = 256, SEQL = 4096, MODW = 6144;
struct EpiIn {
    static constexpr bool PERM = true, AFTER_DRAIN = false;
    bf16_t* Z; bf16_t* PQt; bf16_t* PQtc; int row_off, col_off;
    bf16_t* QP; bf16_t* KP; bf16_t* VP; const float* qg; const float* kg; const PG8_LAS float* rope; float qscale;
    __device__ __forceinline__ void operator()(const f32x4 (&acc)[2][2][4][2], const Unit& u, int wr, int wc, int fr, int fq) const {
        asm volatile("" : "+v"(fr), "+v"(fq));
        const int gr0 = row_off + u.pm * BM, ct = (col_off >> 8) + u.pn;
        if (ct < 3) {
            const bool isx = gr0 < XROWS, isv = (ct == 2) && (wc >= 2), isq = ct < 2;
            f32x4 gn[2][2];
            { const float* gp = (isq ? qg : kg) + 8 * fq;
#pragma unroll
              for (int bj = 0; bj < 2; ++bj)
#pragma unroll
                  for (int n = 0; n < 2; ++n) gn[bj][n] = *(const f32x4*)(gp + 32 * bj + 4 * n); }
            const float osc = isq ? qscale : 1.0f;
            const int half = fq >> 1, f0 = 8 * (fq & 1);
#pragma unroll
            for (int ai = 0; ai < 2; ++ai)
#pragma unroll
                for (int m = 0; m < 4; ++m) {
                    const int grow = gr0 + ai * HALF + wr * 64 + m * 16 + fr;
                    const int b = isx ? (grow >> 12) : ((grow - XROWS) >> 8), t = isx ? (grow & 4095) : ((grow - XROWS) & 255);
                    const size_t kvrow = (size_t)b * (SEQL + CTXL) + (isx ? CTXL + t : t);
                    if (isv) {
#pragma unroll
                        for (int bj = 0; bj < 2; ++bj) { const f32x4 v0 = acc[ai][bj][m][0], v1 = acc[ai][bj][m][1];
                            u32x4 w; w.x = cvt_pk_bf16(v0[0], v0[1]); w.y = cvt_pk_bf16(v0[2], v0[3]); w.z = cvt_pk_bf16(v1[0], v1[1]); w.w = cvt_pk_bf16(v1[2], v1[3]);
                            *(u32x4*)(VP + kvrow * 128 + (wc - 2) * 64 + 32 * bj + 8 * fq) = w; }
                    } else {
                        float ss = 0.f;
#pragma unroll
                        for (int bj = 0; bj < 2; ++bj)
#pragma unroll
                            for (int n = 0; n < 2; ++n) { const f32x4 v = acc[ai][bj][m][n]; ss += (v[0] * v[0] + v[1] * v[1]) + (v[2] * v[2] + v[3] * v[3]); }
                        ss += shx_(ss, 16, fq * 16 + fr); ss += shx_(ss, 32, fq * 16 + fr);
                        const float rstd = 1.0f / sqrtf(ss * (1.0f / 64.0f) + 1e-6f);
#pragma unroll
                        for (int bj = 0; bj < 2; ++bj) { f32x4 y[2];
#pragma unroll
                            for (int n = 0; n < 2; ++n) y[n] = acc[ai][bj][m][n] * rstd * gn[bj][n];
                            f32x4 pr[2];
#pragma unroll
                            for (int n = 0; n < 2; ++n)
#pragma unroll
                                for (int j = 0; j < 4; ++j) pr[n][j] = shx_(y[n][j], 32, fq * 16 + fr);
                            if (isx) { const int pos = bj == 0 ? (t >> 6) : (t & 63); const PG8_LAS float* cp = rope + pos * 16 + f0;
#pragma unroll
                                for (int n = 0; n < 2; ++n) { const f32x4 c = *(const PG8_LAS f32x4*)(cp + 4 * n), s = *(const PG8_LAS f32x4*)(cp + 1024 + 4 * n);
                                    y[n] = half == 0 ? y[n] * c - pr[n] * s : y[n] * c + pr[n] * s; } }
                            const f32x4 o0 = y[0] * osc, o1 = y[1] * osc;
                            u32x4 w; w.x = cvt_pk_bf16(o0[0], o0[1]); w.y = cvt_pk_bf16(o0[2], o0[3]); w.z = cvt_pk_bf16(o1[0], o1[1]); w.w = cvt_pk_bf16(o1[2], o1[3]);
                            bf16_t* dst = isq ? QP + (size_t)grow * 512 + (ct * 4 + wc) * 64 + 32 * bj + 8 * fq : KP + kvrow * 128 + wc * 64 + 32 * bj + 8 * fq;
                            *(u32x4*)dst = w; }
                    }
                }
        } else if (ct == 3) {
            bf16_t* base = Z + (size_t)(gr0 + wr * 64 + fr) * 1024 + ct * 256 + wc * 32 + 8 * fq;
#pragma unroll
            for (int ai = 0; ai < 2; ++ai)
#pragma unroll
                for (int m = 0; m < 4; ++m) { bf16_t* rowp = base + (size_t)(ai * HALF + m * 16) * 1024;
#pragma unroll
                    for (int bj = 0; bj < 2; ++bj) { const f32x4 v0 = acc[ai][bj][m][0], v1 = acc[ai][bj][m][1];
                        u32x4 w; w.x = cvt_pk_bf16(v0[0], v0[1]); w.y = cvt_pk_bf16(v0[2], v0[3]); w.z = cvt_pk_bf16(v1[0], v1[1]); w.w = cvt_pk_bf16(v1[2], v1[3]);
                        *(u32x4*)(rowp + bj * HALF) = w; } }
        } else {
            const int part = ct - 4; const bool isx = gr0 < XROWS;
            const int b = isx ? (gr0 >> 12) : ((gr0 - XROWS) >> 8);
            const int L = isx ? SEQL : CTXL;
            const int l0 = (isx ? (gr0 & 4095) : 0) + wr * 64 + fr;
            bf16_t* T = isx ? PQt : PQtc;
#pragma unroll
            for (int bj = 0; bj < 2; ++bj)
#pragma unroll
                for (int n = 0; n < 2; ++n)
#pragma unroll
                    for (int j = 0; j < 4; ++j) { const int cc = bj * HALF + wc * 32 + 8 * fq + 4 * n + j;
                        bf16_t* cp = T + ((size_t)((b * 256 + cc) * 2 + part)) * L + l0;
#pragma unroll
                        for (int ai = 0; ai < 2; ++ai)
#pragma unroll
                            for (int m = 0; m < 4; ++m) cp[ai * HALF + m * 16] = (bf16_t)(cvt_pk_bf16(acc[ai][bj][m][n][j], 0.f) & 0xffffu); }
        }
    }
};
struct EpiRes {
    static constexpr bool PERM = true, AFTER_DRAIN = false;
    const float* bx; const float* bc; const bf16_t* bs; bf16_t* os; float* of; const float* gate;
    __device__ __forceinline__ void operator()(const f32x4 (&acc)[2][2][4][2], const Unit& u, int wr, int wc, int fr, int fq) const {
        asm volatile("" : "+v"(fr), "+v"(fq));
        const bool isx = u.pm < 256;
        const float* gt = gate + (size_t)(isx ? (u.pm >> 4) : 16) * MODW;
        const int col0 = u.pn * BM + wc * 64 + 8 * fq;
        f32x4 gv[2][2];
#pragma unroll
        for (int bj = 0; bj < 2; ++bj)
#pragma unroll
            for (int n = 0; n < 2; ++n) gv[bj][n] = *(const f32x4*)(gt + col0 + bj * 32 + 4 * n);
        const bool bf32 = bx != nullptr, obf = os != nullptr;
#pragma unroll
        for (int ai = 0; ai < 2; ++ai)
#pragma unroll
            for (int m = 0; m < 4; ++m) { const size_t grow = (size_t)u.pm * BM + ai * HALF + wr * 64 + m * 16 + fr;
#pragma unroll
                for (int bj = 0; bj < 2; ++bj) { const size_t off = grow * 1024 + col0 + bj * 32; f32x4 b0, b1;
                    if (bf32) { const float* bp = isx ? bx + off : bc + (off - (size_t)XROWS * 1024); b0 = *(const f32x4*)bp; b1 = *(const f32x4*)(bp + 4); }
                    else { const u32x4 w = *(const u32x4*)(bs + off);
                        b0 = (f32x4){__builtin_bit_cast(float, w.x << 16), __builtin_bit_cast(float, w.x & 0xffff0000u), __builtin_bit_cast(float, w.y << 16), __builtin_bit_cast(float, w.y & 0xffff0000u)};
                        b1 = (f32x4){__builtin_bit_cast(float, w.z << 16), __builtin_bit_cast(float, w.z & 0xffff0000u), __builtin_bit_cast(float, w.w << 16), __builtin_bit_cast(float, w.w & 0xffff0000u)}; }
                    const f32x4 o0 = b0 + gv[bj][0] * acc[ai][bj][m][0], o1 = b1 + gv[bj][1] * acc[ai][bj][m][1];
                    if (obf) { u32x4 w; w.x = cvt_pk_bf16(o0[0], o0[1]); w.y = cvt_pk_bf16(o0[2], o0[3]); w.z = cvt_pk_bf16(o1[0], o1[1]); w.w = cvt_pk_bf16(o1[2], o1[3]); *(u32x4*)(os + off) = w; }
                    else { *(f32x4*)(of + off) = o0; *(f32x4*)(of + off + 4) = o1; } } }
    }
};
struct EpiSwiglu {
    static constexpr bool PERM = true, AFTER_DRAIN = false;
    bf16_t* H;
    __device__ __forceinline__ void operator()(const f32x4 (&acc)[2][2][4][2], const Unit& u, int wr, int wc, int fr, int fq) const {
        asm volatile("" : "+v"(fr), "+v"(fq));
        bf16_t* base = H + (size_t)(u.pm * BM + wr * 64 + fr) * 2816 + u.pn * HALF + wc * 32 + 8 * fq;
#pragma unroll
        for (int ai = 0; ai < 2; ++ai)
#pragma unroll
            for (int m = 0; m < 4; ++m) { float r[8];
#pragma unroll
                for (int n = 0; n < 2; ++n)
#pragma unroll
                    for (int j = 0; j < 4; ++j) { const float g = acc[ai][0][m][n][j], up = acc[ai][1][m][n][j];
                        r[n * 4 + j] = g * __builtin_amdgcn_rcpf(1.0f + __builtin_amdgcn_exp2f(-1.4426950408889634f * g)) * up; }
                u32x4 w; w.x = cvt_pk_bf16(r[0], r[1]); w.y = cvt_pk_bf16(r[2], r[3]); w.z = cvt_pk_bf16(r[4], r[5]); w.w = cvt_pk_bf16(r[6], r[7]);
                *(u32x4*)(base + (size_t)(ai * HALF + m * 16) * 2816) = w; }
    }
};
struct EpiFour {
    static constexpr bool PERM = true, AFTER_DRAIN = false;
    bf16_t* MX; int rowbase, L; float scale;
    __device__ __forceinline__ void operator()(const f32x4 (&acc)[2][2][4][2], const Unit& u, int wr, int wc, int fr, int fq) const {
        asm volatile("" : "+v"(fr), "+v"(fq));
        bf16_t* base = MX + (size_t)(rowbase + u.pn * L + u.pm * BM + wr * 64 + fr) * 1024 + 768 + wc * 32 + 8 * fq;
#pragma unroll
        for (int ai = 0; ai < 2; ++ai)
#pragma unroll
            for (int m = 0; m < 4; ++m) { bf16_t* rowp = base + (size_t)(ai * HALF + m * 16) * 1024;
#pragma unroll
                for (int bj = 0; bj < 2; ++bj) { const f32x4 v0 = acc[ai][bj][m][0] * scale, v1 = acc[ai][bj][m][1] * scale;
                    u32x4 w; w.x = cvt_pk_bf16(v0[0], v0[1]); w.y = cvt_pk_bf16(v0[2], v0[3]); w.z = cvt_pk_bf16(v1[0], v1[1]); w.w = cvt_pk_bf16(v1[2], v1[3]);
                    *(u32x4*)(rowp + bj * HALF) = w; } }
    }
};
template <class Epi, class Sched, bool ALIGN_EPI = false, bool SP2 = false>
__device__ __forceinline__ void gemm_phase(PG8_LAS unsigned char* lds, const Gemm g, const Sched& S, const Epi& E) {
    int tid_l = threadIdx.x; asm volatile("" : "+v"(tid_l)); const int tid = tid_l, wid = __builtin_amdgcn_readfirstlane(tid >> 6), lane = tid & 63, wr = wid >> 2, wc = wid & 3, fr = lane & 15, fq = lane >> 4;
    const int K = g.K, nt = K / BK;
    unsigned voffA[2], voffB[2];
#pragma unroll
    for (int i = 0; i < 2; ++i) { int R, C; stage_rc(tid * 16 + i * 8192, R, C); const int Rb = Epi::PERM ? ((R & ~31) + perm32(R & 31)) : R;
        voffA[i] = (unsigned)(R * K + C) * 2u; voffB[i] = (unsigned)(Rb * K + C) * 2u; }
    const size_t kstep = (size_t)(BK * 2);
    const size_t hstep = (size_t)HALF * K * 2;
    const size_t tstep = 2 * hstep;
    const unsigned ldsw = (unsigned)wid * 1024u;
    const int aoff = lds_byte(wr * 64 + fr, fq * 8), boff = lds_byte(wc * 32 + fr, fq * 8);
#define PG8_SA(b, h) (((b) * 2 + (h)) * HTB)
#define PG8_SB(b, h) ((4 + (b) * 2 + (h)) * HTB)
#define PG8_STAGE(bufoff, gbase, voff) do { _Pragma("unroll") for (int _i = 0; _i < 2; ++_i) \
        __builtin_amdgcn_global_load_lds((const unsigned*)((const char*)(gbase) + (voff)[_i]), (PG8_LAS unsigned*)(lds + (bufoff) + ldsw + _i * 8192), 16, 0, 0); } while (0)
#define PG8_LDA(dst, b, h) do { _Pragma("unroll") for (int m = 0; m < 4; ++m) _Pragma("unroll") for (int k = 0; k < 2; ++k) dst[m][k] = *(const PG8_LAS bf16x8*)(lds + PG8_SA(b, h) + aoff + m * 2048 + k * 1024); } while (0)
#define PG8_LDB(dst, b, h) do { _Pragma("unroll") for (int n = 0; n < 2; ++n) _Pragma("unroll") for (int k = 0; k < 2; ++k) dst[n][k] = *(const PG8_LAS bf16x8*)(lds + PG8_SB(b, h) + boff + n * 2048 + k * 1024); } while (0)
#define PG8_MMA(ai, bj, At, Bt) do { __builtin_amdgcn_s_setprio(1); _Pragma("unroll") for (int m = 0; m < 4; ++m) _Pragma("unroll") for (int n = 0; n < 2; ++n) _Pragma("unroll") for (int k = 0; k < 2; ++k) \
        acc[ai][bj][m][n] = __builtin_amdgcn_mfma_f32_16x16x32_bf16(Bt[n][k], At[m][k], acc[ai][bj][m][n], 0, 0, 0); __builtin_amdgcn_s_setprio(0); } while (0)
#define PG8_WAIT_V(n) asm volatile("s_waitcnt vmcnt(" #n ")" ::: "memory")
#define PG8_WAIT_L(n) asm volatile("s_waitcnt lgkmcnt(" #n ")" ::: "memory")
#define PG8_BAR __builtin_amdgcn_s_barrier()
#define PG8_SCHED __builtin_amdgcn_sched_barrier(0)
    Unit cur, nxt; int ui = 0;
    if (!S.next(0, cur)) return;
    f32x4 acc[2][2][4][2];
#pragma unroll
    for (int a = 0; a < 2; ++a)
#pragma unroll
        for (int b = 0; b < 2; ++b)
#pragma unroll
            for (int m = 0; m < 4; ++m)
#pragma unroll
                for (int n = 0; n < 2; ++n) acc[a][b][m][n] = (f32x4){0.f, 0.f, 0.f, 0.f};
    bf16x8 At[4][2], B0[2][2], B1[2][2];
    const char* cA = (const char*)g.A + (size_t)cur.pm * tstep; const char* cB = (const char*)g.Bt + (size_t)cur.pn * tstep;
    S.a_ready(cur);
    if constexpr (SP2) {
        PG8_STAGE(PG8_SB(0, 0), cB, voffB); PG8_STAGE(PG8_SB(0, 1), cB + hstep, voffB); PG8_STAGE(PG8_SA(0, 0), cA, voffA); PG8_STAGE(PG8_SA(0, 1), cA + hstep, voffA);
        if (wr == 1) PG8_BAR;
        PG8_WAIT_V(2); PG8_BAR;
        PG8_STAGE(PG8_SB(1, 0), cB + kstep, voffB); PG8_STAGE(PG8_SA(1, 0), cA + kstep, voffA); PG8_STAGE(PG8_SB(1, 1), cB + hstep + kstep, voffB);
        PG8_WAIT_V(6); PG8_BAR;
    } else {
        PG8_STAGE(PG8_SB(0, 0), cB, voffB); PG8_STAGE(PG8_SA(0, 0), cA, voffA); PG8_STAGE(PG8_SB(0, 1), cB + hstep, voffB); PG8_STAGE(PG8_SA(0, 1), cA + hstep, voffA);
        if (wr == 1) PG8_BAR;
        PG8_WAIT_V(4); PG8_BAR;
        PG8_STAGE(PG8_SB(1, 0), cB + kstep, voffB); PG8_STAGE(PG8_SA(1, 0), cA + kstep, voffA); PG8_STAGE(PG8_SB(1, 1), cB + hstep + kstep, voffB);
        PG8_WAIT_V(6); PG8_BAR;
    }
    for (;;) {
        const bool has_next = S.next(ui + 1, nxt);
        const char* nA = has_next ? (const char*)g.A + (size_t)nxt.pm * tstep : cA; const char* nB = has_next ? (const char*)g.Bt + (size_t)nxt.pn * tstep : cB;
        for (int t = 0; t < nt; t += 2) {
            const bool last = (t == nt - 2);
            const char* a1 = cA + (size_t)(t + 1) * kstep;
            const char* a2 = last ? nA : cA + (size_t)(t + 2) * kstep; const char* b2 = last ? nB : cB + (size_t)(t + 2) * kstep;
            const char* a3 = a2 + kstep; const char* b3 = b2 + kstep;
            if (last && has_next) S.a_ready(nxt);
            if constexpr (SP2) {
            PG8_LDB(B0, 0, 0); PG8_LDB(B1, 0, 1); PG8_SCHED; PG8_LDA(At, 0, 0); PG8_STAGE(PG8_SA(1, 1), a1 + hstep, voffA);
            PG8_WAIT_V(8); PG8_WAIT_L(0); PG8_BAR; PG8_MMA(0, 0, At, B0); PG8_MMA(0, 1, At, B1); PG8_BAR; PG8_SCHED;
            PG8_LDA(At, 0, 1); PG8_STAGE(PG8_SB(0, 0), b2, voffB); PG8_STAGE(PG8_SB(0, 1), b2 + hstep, voffB); PG8_STAGE(PG8_SA(0, 0), a2, voffA);
            PG8_WAIT_V(8); PG8_WAIT_L(0); PG8_BAR; PG8_MMA(1, 0, At, B0); PG8_MMA(1, 1, At, B1); PG8_BAR; PG8_SCHED;
            PG8_LDB(B0, 1, 0); PG8_LDB(B1, 1, 1); PG8_SCHED; PG8_LDA(At, 1, 0); PG8_STAGE(PG8_SA(0, 1), a2 + hstep, voffA);
            PG8_WAIT_V(8); PG8_WAIT_L(0); PG8_BAR; PG8_MMA(0, 0, At, B0); PG8_MMA(0, 1, At, B1); PG8_BAR; PG8_SCHED;
            PG8_LDA(At, 1, 1); PG8_STAGE(PG8_SB(1, 0), b3, voffB); PG8_STAGE(PG8_SB(1, 1), b3 + hstep, voffB); PG8_STAGE(PG8_SA(1, 0), a3, voffA);
            PG8_WAIT_V(8); PG8_WAIT_L(0); PG8_BAR; PG8_MMA(1, 0, At, B0); PG8_MMA(1, 1, At, B1); PG8_BAR; PG8_SCHED;
            } else {
            PG8_LDB(B0, 0, 0); PG8_SCHED; PG8_LDA(At, 0, 0); PG8_STAGE(PG8_SA(1, 1), a1 + hstep, voffA);
            PG8_WAIT_L(8); PG8_BAR; PG8_WAIT_L(0); PG8_MMA(0, 0, At, B0); PG8_BAR; PG8_SCHED;
            PG8_LDB(B1, 0, 1); PG8_STAGE(PG8_SB(0, 0), b2, voffB);
            PG8_BAR; PG8_WAIT_L(0); PG8_MMA(0, 1, At, B1); PG8_BAR;
            PG8_LDA(At, 0, 1); PG8_STAGE(PG8_SA(0, 0), a2, voffA);
            PG8_BAR; PG8_WAIT_L(0); PG8_MMA(1, 0, At, B0); PG8_BAR; PG8_SCHED;
            PG8_STAGE(PG8_SB(0, 1), b2 + hstep, voffB);
            PG8_WAIT_V(6); PG8_BAR; PG8_MMA(1, 1, At, B1); PG8_BAR;
            PG8_LDB(B0, 1, 0); PG8_SCHED; PG8_LDA(At, 1, 0); PG8_STAGE(PG8_SA(0, 1), a2 + hstep, voffA);
            PG8_WAIT_L(8); PG8_BAR; PG8_WAIT_L(0); PG8_MMA(0, 0, At, B0); PG8_BAR; PG8_SCHED;
            PG8_LDB(B1, 1, 1); PG8_STAGE(PG8_SB(1, 0), b3, voffB);
            PG8_BAR; PG8_WAIT_L(0); PG8_MMA(0, 1, At, B1); PG8_BAR;
            PG8_LDA(At, 1, 1); PG8_STAGE(PG8_SA(1, 0), a3, voffA);
            PG8_BAR; PG8_WAIT_L(0); PG8_MMA(1, 0, At, B0); PG8_BAR; PG8_SCHED;
            PG8_STAGE(PG8_SB(1, 1), b3 + hstep, voffB);
            PG8_WAIT_V(6); PG8_BAR; PG8_MMA(1, 1, At, B1); PG8_BAR;
            }
        }
        if constexpr (ALIGN_EPI) { if (wr == 0) PG8_BAR; }
        if constexpr (!Epi::AFTER_DRAIN) { E(acc, cur, wr, wc, fr, fq); S.done(cur); }
        if (!has_next) break;
#pragma unroll
        for (int a = 0; a < 2; ++a)
#pragma unroll
            for (int b = 0; b < 2; ++b)
#pragma unroll
                for (int m = 0; m < 4; ++m)
#pragma unroll
                    for (int n = 0; n < 2; ++n) acc[a][b][m][n] = (f32x4){0.f, 0.f, 0.f, 0.f};
        cur = nxt; cA = nA; cB = nB; ++ui;
        if constexpr (ALIGN_EPI) { if (wr == 1) PG8_BAR; }
    }
    PG8_WAIT_V(0);
    if constexpr (!ALIGN_EPI) { if (wr == 0) PG8_BAR; }
    PG8_BAR;
    if constexpr (Epi::AFTER_DRAIN) { E.fused(acc, cur, wr, wc, fr, fq, lds, wid, lane); S.done(cur); }
#undef PG8_SA
#undef PG8_SB
#undef PG8_STAGE
#undef PG8_LDA
#undef PG8_LDB
#undef PG8_MMA
#undef PG8_WAIT_V
#undef PG8_WAIT_L
#undef PG8_BAR
#undef PG8_SCHED
}
}
namespace attn_body {
using bf16=__hip_bfloat16;
using bf16x8=__attribute__((ext_vector_type(8)))short;
using s16x4=__attribute__((ext_vector_type(4)))short;
using f32x16=__attribute__((ext_vector_type(16)))float;
using u32x4=__attribute__((ext_vector_type(4)))unsigned;
constexpr int D=64,QPITCH=512,KVPITCH=128,OPITCH=1024;
constexpr int NW=8,QBLK=32,QB=QBLK*NW,KVBLK=64;

__device__ __forceinline__ int crow(int r,int hi){return (r&3)+8*(r>>2)+4*hi;}
#define SBAR() __builtin_amdgcn_sched_barrier(0)
__device__ __forceinline__ void cmask(f32x16&p0,f32x16&p1,int jb,int qrel,int hi){
  const float NEG=-INFINITY; int kb=64*jb+4*hi;
  #pragma unroll
  for(int r=0;r<16;++r){int kv=kb+(r&3)+8*(r>>2); if(kv>qrel)p0[r]=NEG; if(kv+32>qrel)p1[r]=NEG;}
}

constexpr int NSLOT=3, SLOTB=8192;
constexpr int LDS_K=0, LDS_V=NSLOT*SLOTB, LDS_WS=2*NSLOT*SLOTB, LDS_OST=LDS_WS+NW*64*4, LDS_BYTES=LDS_OST+NW*4096;
constexpr float C2=0.125f*1.4426950408889634f;
__device__ __forceinline__ void glds16(const void*gsrc,unsigned lds_dst){unsigned keep;
  asm volatile("s_mov_b32 %0, m0\n\ts_mov_b32 m0, %2\n\ts_nop 0\n\tglobal_load_lds_dwordx4 %1, off\n\ts_mov_b32 m0, %0":"=&s"(keep):"v"(gsrc),"s"(lds_dst):"memory");}
__device__ __forceinline__ float max3f(float a,float b,float c){float r;asm("v_max3_f32 %0, %1, %2, %3":"=v"(r):"v"(a),"v"(b),"v"(c));return r;}
__device__ __forceinline__ float max2f(float a,float b){float r;asm("v_max_f32_e32 %0, %1, %2":"=v"(r):"v"(a),"v"(b));return r;}
__device__ __forceinline__ float fadd_s(float a,float b){float r;asm("v_add_f32_e32 %0, %1, %2":"=v"(r):"v"(a),"v"(b));return r;}
__device__ __forceinline__ float fsub_s(float a,float b){float r;asm("v_sub_f32_e32 %0, %1, %2":"=v"(r):"v"(a),"v"(b));return r;}
typedef float f32x2_t __attribute__((ext_vector_type(2))); typedef __bf16 bf16x2_t __attribute__((ext_vector_type(2)));
__device__ __forceinline__ unsigned cvtpk_s(float lo,float hi){f32x2_t v={lo,hi};bf16x2_t b=__builtin_convertvector(v,bf16x2_t);return __builtin_bit_cast(unsigned,b);}
#define WAIT_BAR(N) asm volatile("s_waitcnt vmcnt(" #N ") lgkmcnt(0)\n\ts_barrier":::"memory")

__device__ __forceinline__ void qkt(f32x16&p0,f32x16&p1,const char*Kslot,const bf16x8*qr,const f32x16&negm,int r32,int hi){
  const char*kb=Kslot+hi*1024+r32*16;
  #pragma unroll
  for(int d0=0;d0<4;++d0){
    const bf16x8 b0=*reinterpret_cast<const bf16x8*>(kb+d0*2048);
    const bf16x8 b1=*reinterpret_cast<const bf16x8*>(kb+d0*2048+512);
    if(d0==0){p0=__builtin_amdgcn_mfma_f32_32x32x16_bf16(b0,qr[0],negm,0,0,0);p1=__builtin_amdgcn_mfma_f32_32x32x16_bf16(b1,qr[0],negm,0,0,0);}
    else{p0=__builtin_amdgcn_mfma_f32_32x32x16_bf16(b0,qr[d0],p0,0,0,0);p1=__builtin_amdgcn_mfma_f32_32x32x16_bf16(b1,qr[d0],p1,0,0,0);}}
}
typedef __attribute__((address_space(3))) const char* lds_cptr;
typedef short v4i16_t __attribute__((ext_vector_type(4)));
__device__ __forceinline__ void kload8(bf16x8*kf,lds_cptr kp){
  kf[0]=*(const __attribute__((address_space(3))) bf16x8*)(kp);      kf[1]=*(const __attribute__((address_space(3))) bf16x8*)(kp+512);
  kf[2]=*(const __attribute__((address_space(3))) bf16x8*)(kp+2048); kf[3]=*(const __attribute__((address_space(3))) bf16x8*)(kp+2560);
  kf[4]=*(const __attribute__((address_space(3))) bf16x8*)(kp+4096); kf[5]=*(const __attribute__((address_space(3))) bf16x8*)(kp+4608);
  kf[6]=*(const __attribute__((address_space(3))) bf16x8*)(kp+6144); kf[7]=*(const __attribute__((address_space(3))) bf16x8*)(kp+6656);
}
__device__ __forceinline__ void kload2(bf16x8*kf,lds_cptr kp,int j){ kf[2*j]=*(const __attribute__((address_space(3))) bf16x8*)(kp+j*2048); kf[2*j+1]=*(const __attribute__((address_space(3))) bf16x8*)(kp+j*2048+512); }
__device__ __forceinline__ s16x4 vtr(lds_cptr p){ return __builtin_bit_cast(s16x4,__builtin_amdgcn_ds_read_tr16_b64_v4i16((__attribute__((address_space(3))) v4i16_t*)p)); }
__device__ __forceinline__ float rowmax(const f32x16&p0,const f32x16&p1){
  float a=max3f(p0[0],p0[1],p1[0]),b=max3f(p0[2],p0[3],p1[1]);a=max3f(a,p1[2],p1[3]);
  #pragma unroll
  for(int r=4;r<16;r+=4){a=max3f(a,p0[r],p0[r+1]);b=max3f(b,p0[r+2],p0[r+3]);a=max3f(a,p1[r],p1[r+1]);b=max3f(b,p1[r+2],p1[r+3]);}
  const float m=max2f(a,b);
  auto rr=__builtin_amdgcn_permlane32_swap(__float_as_uint(m),__float_as_uint(m),false,false);
  return max2f(__uint_as_float(rr[0]),__uint_as_float(rr[1]));
}
__device__ __forceinline__ void pv(f32x16*o,int vb,bf16x8 pa0,bf16x8 pa1,bf16x8 pa2,bf16x8 pa3){
  #pragma unroll
  for(int d0=0;d0<2;++d0){s16x4 lo[4],hi[4];
    #pragma unroll
    for(int ks=0;ks<4;++ks){
      asm volatile("ds_read_b64_tr_b16 %0,%1 offset:%c2":"=&v"(lo[ks]):"v"(vb),"i"(d0*4096+ks*1024):"memory");
      asm volatile("ds_read_b64_tr_b16 %0,%1 offset:%c2":"=&v"(hi[ks]):"v"(vb),"i"(d0*4096+ks*1024+512):"memory");}
    asm volatile("s_waitcnt lgkmcnt(0)":::"memory");SBAR();
    #define PK(k) (bf16x8){lo[k][0],lo[k][1],lo[k][2],lo[k][3],hi[k][0],hi[k][1],hi[k][2],hi[k][3]}
    o[d0]=__builtin_amdgcn_mfma_f32_32x32x16_bf16(pa0,PK(0),o[d0],0,0,0);
    o[d0]=__builtin_amdgcn_mfma_f32_32x32x16_bf16(pa1,PK(1),o[d0],0,0,0);
    o[d0]=__builtin_amdgcn_mfma_f32_32x32x16_bf16(pa2,PK(2),o[d0],0,0,0);
    o[d0]=__builtin_amdgcn_mfma_f32_32x32x16_bf16(pa3,PK(3),o[d0],0,0,0);
    #undef PK
  }
}

#ifndef ATTN_STORE16
#define ATTN_STORE16(p,v) (*(u32x4*)(p)=(v))
#endif
template<int THRL> __device__ __forceinline__ void attn_unit(const bf16*Qu,const bf16*__restrict__ Kh,const bf16*__restrict__ Vh,bf16*Ou,const int NT,char*shm){
  int tid_l=threadIdx.x; asm volatile("":"+v"(tid_l)); const int tid=tid_l,lane=tid&63,r32=lane&31,hi=lane>>5; const int wid=__builtin_amdgcn_readfirstlane(tid>>6);
  const bf16*Qw=Qu+(long)(wid*QBLK)*QPITCH;
  const unsigned lds0=(unsigned)(uintptr_t)shm;
  float*wsf=(float*)(shm+LDS_WS)+wid*64;
  const bf16*ksrc=Kh+(long)lane*KVPITCH+wid*8;
  const bf16*vsrc=Vh+(long)(16*(wid&3)+(lane>>2))*KVPITCH+(wid>>2)*32+(lane&3)*8;
  const unsigned kdst=lds0+LDS_K+wid*1024, vdst=lds0+LDS_V+wid*1024;
  #define DMA_K(t,slot) glds16(ksrc+(long)(t)*KVBLK*KVPITCH,(unsigned)__builtin_amdgcn_readfirstlane(kdst+(slot)))
  #define DMA_V(t,slot) glds16(vsrc+(long)(t)*KVBLK*KVPITCH,(unsigned)__builtin_amdgcn_readfirstlane(vdst+(slot)))
  const int vb0=(int)(lds0+LDS_V)+((lane>>4)&1)*32+(lane&3)*8+(4*hi+((lane&15)>>2))*64;
  const char*Kbase=shm+LDS_K; bf16x8 kf[8];
  const lds_cptr shm3=(lds_cptr)shm; const lds_cptr kp0=shm3+LDS_K+hi*1024+r32*16; const lds_cptr vp0=shm3+LDS_V+((lane>>4)&1)*32+(lane&3)*8+(4*hi+((lane&15)>>2))*64;
  DMA_K(0,0);DMA_V(0,0);DMA_K(1,SLOTB);
  bf16x8 qr[4];
  #pragma unroll
  for(int d0=0;d0<4;++d0)qr[d0]=*reinterpret_cast<const bf16x8*>(&Qw[(long)r32*QPITCH+d0*16+hi*8]);
  float mhat=0.f,l_reg=0.f;f32x16 o[2];o[0]=f32x16{};o[1]=f32x16{};f32x16 negm=f32x16{};asm volatile("":"+v"(negm));
  #define CMASK(P0,P1,t) do{}while(0)
  bool resc=false;
  #define START(P0,P1) do{ const float rm=rowmax(P0,P1); resc=false; \
    { const float dl=rm; mhat=fadd_s(mhat,dl); \
      _Pragma("unroll") for(int r=0;r<16;++r){P0[r]=fsub_s(P0[r],dl);P1[r]=fsub_s(P1[r],dl);} \
      _Pragma("unroll") for(int r=0;r<16;++r)negm[r]=-mhat; asm volatile("":"+v"(negm)); } \
    _Pragma("unroll") for(int r=0;r<16;++r)P0[r]=__builtin_amdgcn_exp2f(P0[r]); }while(0)
  #define RESC() do{ if(resc){ asm volatile("s_waitcnt lgkmcnt(0)":::"memory"); \
      _Pragma("unroll") for(int d_=0;d_<2;++d_) _Pragma("unroll") for(int r=0;r<16;++r)o[d_][r]*=wsf[crow(r,hi)]; } }while(0)
  f32x16 pA0,pA1,pB0,pB1;
  int sl_prev=0,sl_cur=0,sl_next=SLOTB;
  #define ROT() do{sl_prev=sl_cur;sl_cur=sl_next;sl_next=(sl_next==(NSLOT-1)*SLOTB)?0:sl_next+SLOTB;}while(0)
  DMA_K(2,2*SLOTB);
  WAIT_BAR(3);
  qkt(pA0,pA1,Kbase,qr,negm,r32,hi);asm volatile("s_nop 15\n\ts_nop 7":"+v"(pA0),"+v"(pA1));CMASK(pA0,pA1,0);
  START(pA0,pA1);
  _Pragma("unroll") for(int r=0;r<16;++r)pA1[r]=__builtin_amdgcn_exp2f(pA1[r]);
  WAIT_BAR(0);
  DMA_K(3,0);DMA_V(1,SLOTB);
  ROT();
  kload8(kf,kp0+sl_cur);
  WAIT_BAR(2);
  s16x4 vlo[8],vhi[8]; u32x4 pw0,pw1,pw2,pw3;
  #define PKW(P,B) cvtpk_s(P[B],P[B+1])
  #define PAF(k) __builtin_bit_cast(bf16x8,pw##k)
  #define VFR(i) (bf16x8){vlo[i][0],vlo[i][1],vlo[i][2],vlo[i][3],vhi[i][0],vhi[i][1],vhi[i][2],vhi[i][3]}
  #define PIN(x) asm volatile("":"+v"(x))
  #define MX3(a,b,c) __builtin_fmaxf(__builtin_fmaxf((a),(b)),(c))
  #define GAPA(MF,A0,A1,A2,A3,W0,W1,PW) do{ MF; sacc+=A0; sacc+=A1; sacc+=A2; sacc+=A3; PIN(sacc); W0; W1; PIN(PW); SBAR(); }while(0)
  #define EX(v) __builtin_amdgcn_exp2f(v)
  #define GAPB(MF,X,B) do{ MF; X[B]=EX(X[B]); X[B+1]=EX(X[B+1]); X[B+2]=EX(X[B+2]); X[B+3]=EX(X[B+3]); PIN(X); SBAR(); }while(0)
  #define VRD(i) do{ vlo[i]=vtr(vp_+(((i)>>2)*4096+((i)&3)*1024)); vhi[i]=vtr(vp_+(((i)>>2)*4096+((i)&3)*1024+512)); }while(0)
  #define KRD(G,j) do{ if(G){ kload2(kf,kp0+sl_next,j); SBAR(); } }while(0)
  #define STEP(C0,C1,P0,P1,t,GK,GV,GL) do{ SBAR(); \
    const lds_cptr vp_=vp0+sl_prev; \
    VRD(0); SBAR(); float sacc=(P0[0]+P0[1]); \
    GAPA(C0=__builtin_amdgcn_mfma_f32_32x32x16_bf16(kf[0],qr[0],negm,0,0,0), P0[2],P0[3],P0[4],P0[5],     pw0[0]=PKW(P0,0), pw0[1]=PKW(P0,2), pw0); \
    VRD(4); SBAR(); GAPA(C1=__builtin_amdgcn_mfma_f32_32x32x16_bf16(kf[1],qr[0],negm,0,0,0), P0[6],P0[7],P0[8],P0[9],     pw0[2]=PKW(P0,4), pw0[3]=PKW(P0,6), pw0); \
    VRD(1); SBAR(); GAPA(C0=__builtin_amdgcn_mfma_f32_32x32x16_bf16(kf[2],qr[1],C0,0,0,0),   P0[10],P0[11],P0[12],P0[13], pw1[0]=PKW(P0,8), pw1[1]=PKW(P0,10), pw1); \
    VRD(5); SBAR(); GAPA(C1=__builtin_amdgcn_mfma_f32_32x32x16_bf16(kf[3],qr[1],C1,0,0,0),   P0[14],P0[15],P1[0],P1[1],   pw1[2]=PKW(P0,12),pw1[3]=PKW(P0,14), pw1); \
    VRD(2); SBAR(); GAPA(C0=__builtin_amdgcn_mfma_f32_32x32x16_bf16(kf[4],qr[2],C0,0,0,0),   P1[2],P1[3],P1[4],P1[5],     pw2[0]=PKW(P1,0), pw2[1]=PKW(P1,2), pw2); \
    VRD(6); SBAR(); GAPA(C1=__builtin_amdgcn_mfma_f32_32x32x16_bf16(kf[5],qr[2],C1,0,0,0),   P1[6],P1[7],P1[8],P1[9],     pw2[2]=PKW(P1,4), pw2[3]=PKW(P1,6), pw2); \
    VRD(3); SBAR(); GAPA(C0=__builtin_amdgcn_mfma_f32_32x32x16_bf16(kf[6],qr[3],C0,0,0,0),   P1[10],P1[11],P1[12],P1[13], pw3[0]=PKW(P1,8), pw3[1]=PKW(P1,10), pw3); \
    VRD(7); SBAR(); GAPA(C1=__builtin_amdgcn_mfma_f32_32x32x16_bf16(kf[7],qr[3],C1,0,0,0),   P1[14],P1[15],0.f,0.f,       pw3[2]=PKW(P1,12),pw3[3]=PKW(P1,14), pw3); \
    l_reg+=sacc; \
    if(GK){DMA_K((t)+3,sl_cur);} if(GV){DMA_V((t)+1,sl_next);} \
    CMASK(C0,C1,t); \
    { float a=MX3(C0[0],C0[1],C1[0]),b=MX3(C0[2],C0[3],C1[1]); a=MX3(a,C1[2],C1[3]); \
      _Pragma("unroll") for(int r=4;r<16;r+=4){a=MX3(a,C0[r],C0[r+1]);b=MX3(b,C0[r+2],C0[r+3]);a=MX3(a,C1[r],C1[r+1]);b=MX3(b,C1[r+2],C1[r+3]);} \
      float rm=__builtin_fmaxf(a,b); { auto rr=__builtin_amdgcn_permlane32_swap(__float_as_uint(rm),__float_as_uint(rm),false,false); rm=__builtin_fmaxf(__uint_as_float(rr[0]),__uint_as_float(rr[1])); } \
      resc=false; \
      if(__builtin_expect(__any(rm>(float)THRL),0)){ const float dl=__builtin_fmaxf(rm,0.f); mhat+=dl; \
        _Pragma("unroll") for(int r=0;r<16;++r){C0[r]-=dl;C1[r]-=dl;} \
        _Pragma("unroll") for(int r=0;r<16;++r)negm[r]=-mhat; asm volatile("":"+v"(negm)); \
        const float f=__builtin_amdgcn_exp2f(-dl); l_reg*=f; if(hi==0)wsf[r32]=f; resc=true; } } \
    SBAR(); \
    GAPB(o[0]=__builtin_amdgcn_mfma_f32_32x32x16_bf16(PAF(0),VFR(0),o[0],0,0,0), C0,0); \
    GAPB(o[1]=__builtin_amdgcn_mfma_f32_32x32x16_bf16(PAF(0),VFR(4),o[1],0,0,0), C0,4); \
    KRD(GL,0); GAPB(o[0]=__builtin_amdgcn_mfma_f32_32x32x16_bf16(PAF(1),VFR(1),o[0],0,0,0), C0,8); \
    KRD(GL,1); GAPB(o[1]=__builtin_amdgcn_mfma_f32_32x32x16_bf16(PAF(1),VFR(5),o[1],0,0,0), C0,12); \
    KRD(GL,2); GAPB(o[0]=__builtin_amdgcn_mfma_f32_32x32x16_bf16(PAF(2),VFR(2),o[0],0,0,0), C1,0); \
    KRD(GL,3); GAPB(o[1]=__builtin_amdgcn_mfma_f32_32x32x16_bf16(PAF(2),VFR(6),o[1],0,0,0), C1,4); \
    GAPB(o[0]=__builtin_amdgcn_mfma_f32_32x32x16_bf16(PAF(3),VFR(3),o[0],0,0,0), C1,8); \
    GAPB(o[1]=__builtin_amdgcn_mfma_f32_32x32x16_bf16(PAF(3),VFR(7),o[1],0,0,0), C1,12); \
    }while(0)
  int t=1;
  #undef CMASK
  #define CMASK(P0,P1,t) do{}while(0)
  for(;t+5<NT;t+=2){
    STEP(pB0,pB1,pA0,pA1,t,true,true,true);     WAIT_BAR(2); RESC(); ROT();
    STEP(pA0,pA1,pB0,pB1,t+1,true,true,true);   WAIT_BAR(2); RESC(); ROT();
  }
  #undef CMASK
  #define CMASK(P0,P1,t) do{}while(0)
  #define ENDW(tt) do{ if((tt)+3<NT){WAIT_BAR(2);} else if((tt)+2<NT){WAIT_BAR(1);} else {WAIT_BAR(0);} }while(0)
  for(;t+1<NT;t+=2){
    STEP(pB0,pB1,pA0,pA1,t,(t+3<NT),(t+1<NT),(t+1<NT));       ENDW(t);   RESC(); ROT();
    STEP(pA0,pA1,pB0,pB1,t+1,(t+4<NT),(t+2<NT),(t+2<NT));     ENDW(t+1); RESC(); ROT();
  }
  STEP(pB0,pB1,pA0,pA1,NT-1,false,false,false); RESC();
  { float sacc=pB0[0]+pB0[1]; _Pragma("unroll") for(int r=2;r<16;++r)sacc+=pB0[r]; _Pragma("unroll") for(int r=0;r<16;++r)sacc+=pB1[r]; l_reg+=sacc;
    pw0=(u32x4){PKW(pB0,0),PKW(pB0,2),PKW(pB0,4),PKW(pB0,6)};pw1=(u32x4){PKW(pB0,8),PKW(pB0,10),PKW(pB0,12),PKW(pB0,14)};pw2=(u32x4){PKW(pB1,0),PKW(pB1,2),PKW(pB1,4),PKW(pB1,6)};pw3=(u32x4){PKW(pB1,8),PKW(pB1,10),PKW(pB1,12),PKW(pB1,14)};
    SBAR(); pv(o,vb0+sl_cur,PAF(0),PAF(1),PAF(2),PAF(3)); }
  #undef PKW
  #undef PAF
  #undef VFR
  #undef PIN
  #undef MX3
  #undef GAPA
  #undef GAPB
  #undef EX
  #undef VRD
  #undef KRD
  #undef STEP
  #undef ENDW
  {auto rr=__builtin_amdgcn_permlane32_swap(__float_as_uint(l_reg),__float_as_uint(l_reg),false,false);l_reg=__uint_as_float(rr[0])+__uint_as_float(rr[1]);}
  if(hi==0)wsf[32+r32]=l_reg;asm volatile("s_waitcnt lgkmcnt(0)":::"memory");
  float rli[16];
  #pragma unroll
  for(int r=0;r<16;++r)rli[r]=__builtin_amdgcn_rcpf(wsf[32+crow(r,hi)]);
  bf16*Ow=Ou+(long)(wid*QBLK)*OPITCH;
  { bf16*stg=(bf16*)(shm+LDS_OST)+wid*2048;
    #pragma unroll
    for(int r=0;r<16;++r){const int orow=crow(r,hi);
      #pragma unroll
      for(int d0=0;d0<2;++d0)stg[orow*64+d0*32+r32]=__float2bfloat16(o[d0][r]*rli[r]);}
    asm volatile("s_waitcnt lgkmcnt(0)":::"memory");
    #pragma unroll
    for(int i=0;i<4;++i){const int row=i*8+(lane>>3),ch=lane&7; const u32x4 v=*(const u32x4*)(stg+row*64+ch*8); ATTN_STORE16(Ow+(long)row*OPITCH+ch*8,v);} }
  asm volatile("s_waitcnt lgkmcnt(0)\n\ts_barrier":::"memory");
  #undef DMA_K
  #undef DMA_V
  #undef CMASK
  #undef START
  #undef RESC
  #undef ROT
}
#undef SBAR
#undef WAIT_BAR
}
namespace cg = cooperative_groups;
#define LAS __attribute__((address_space(3)))
typedef unsigned short bf16;
typedef unsigned v4u __attribute__((ext_vector_type(4)));
typedef unsigned v2u __attribute__((ext_vector_type(2)));
typedef float f32x4 __attribute__((ext_vector_type(4)));
constexpr int NWAVES = 8, NTHR = 512;
constexpr int DMODEL = 1024, NBATCH = 16, SEQ = 4096, CTX = 256, MXR = NBATCH * SEQ, MCR = NBATCH * CTX, MTR = MXR + MCR;
constexpr int NIN = 1536, DFF = 2816, NGU = 5632, KVL = SEQ + CTX, INW = 1280, MODW_ = 6144;
constexpr size_t MiB = 1u << 20;
constexpr size_t WS_MOD = 0, WS_WIN = 1 * MiB, WS_WOUT = 7 * MiB, WS_WGU = 11 * MiB, WS_WDN = 33 * MiB, WS_TRIG = 44 * MiB, WS_TRIGC = 108 * MiB,
                 WS_CX = 109 * MiB, WS_KP = 125 * MiB, WS_VP = 142 * MiB, WS_HX = 159 * MiB, WS_Z = 295 * MiB, WS_PQT = 431 * MiB, WS_PQTC = 495 * MiB,
                 WS_QP = 499 * MiB, WS_MX = 567 * MiB, WS_H = 295 * MiB, WS_XS = 703 * MiB, WS_PQF = 839 * MiB, WS_PQFC = 871 * MiB, WS_END = 873 * MiB, WS_CTL = 896 * 1024, CTL_BYTES = 16384;
static_assert(WS_H + (size_t)MTR * DFF * 2 <= WS_END && WS_MX + (size_t)MTR * 1024 * 2 <= WS_END && WS_KP + (size_t)NBATCH * KVL * 128 * 2 <= WS_VP, "ws map");
constexpr int LDS_BYTES = 147456;
constexpr float QSCALE = 0.125f * 1.4426950408889634f;

struct P { const float *x, *c, *ctx, *c_ctx, *w_ada, *b_ada, *g_mix, *g_ffn, *w_in, *q_gain, *k_gain, *w_pool, *pool_scale, *w_four, *w_out, *w_gate_up, *w_down; float* out; unsigned char* ws; };

__device__ __forceinline__ unsigned f2bf(float f) { unsigned u = __builtin_bit_cast(unsigned, f); return (u + 0x7fffu + ((u >> 16) & 1u)) >> 16; }
__device__ __forceinline__ unsigned pk2(float lo, float hi) { return f2bf(lo) | (f2bf(hi) << 16); }
__device__ __forceinline__ float bf2f(unsigned short h) { return __builtin_bit_cast(float, (unsigned)h << 16); }
__device__ __forceinline__ float shx(float v, int o, int lane) { return __builtin_bit_cast(float, __builtin_amdgcn_ds_bpermute((lane ^ o) << 2, __builtin_bit_cast(int, v))); }
__device__ __forceinline__ float wave_sum(float v, int lane) {
    v += shx(v, 1, lane); v += shx(v, 2, lane); v += shx(v, 4, lane); v += shx(v, 8, lane); v += shx(v, 16, lane); v += shx(v, 32, lane);
    return v;
}

__device__ __forceinline__ void p0_mod(const P& p, LAS unsigned char* lds, int tid, int wave, int lane) {
    LAS float* sc = (LAS float*)lds;
    LAS float* red = (LAS float*)(lds + 69632);
    float* MOD = (float*)(p.ws + WS_MOD);
    if ((int)blockIdx.x >= 192) return;
    for (int i = tid; i < 17 * 1024; i += NTHR) { const int r = i >> 10, k = i & 1023; const float v = r < 16 ? p.c[r * 1024 + k] : p.c_ctx[k]; sc[i] = v / (1.0f + __expf(-v)); }
    __syncthreads();
    for (int it = blockIdx.x; it < 192; it += gridDim.x) {
        const int layer = it / 96, n0 = (it % 96) * 64;
        float acc[17];
#pragma unroll
        for (int r = 0; r < 17; ++r) acc[r] = 0.f;
        const float* W = p.w_ada + ((size_t)layer * 1024 + wave * 128) * MODW_ + n0 + lane;
        for (int kc = 0; kc < 128; kc += 16) { float wv[16];
#pragma unroll
            for (int j = 0; j < 16; ++j) wv[j] = W[(size_t)(kc + j) * MODW_];
#pragma unroll
            for (int j = 0; j < 16; ++j)
#pragma unroll
                for (int r = 0; r < 17; ++r) acc[r] += sc[r * 1024 + wave * 128 + kc + j] * wv[j]; }
#pragma unroll
        for (int r = 0; r < 17; ++r) red[(wave * 17 + r) * 64 + lane] = acc[r];
        __syncthreads();
        for (int i = tid; i < 17 * 64; i += NTHR) { const int r = i >> 6, l = i & 63; float s = p.b_ada[layer * MODW_ + n0 + l];
#pragma unroll
            for (int w = 0; w < 8; ++w) s += red[(w * 17 + r) * 64 + l];
            MOD[((size_t)layer * 17 + r) * MODW_ + n0 + l] = s; }
        __syncthreads();
    }
}
__device__ __forceinline__ void p0_comp(const P& p, LAS unsigned char* lds, int tid) {
    LAS float* M2 = (LAS float*)lds;
    LAS float* tile = (LAS float*)(lds + 16384);
    for (int it = (int)gridDim.x - 1 - (int)blockIdx.x; it < 192; it += gridDim.x) {
        const int kc = it & 7, g = (it >> 3) & 3, ty = (it >> 5) % 3, layer = it / 96;
        const int k0 = kc * 128;
        LAS float* wfs = (LAS float*)(lds + 49664);
        if (ty != 0) { for (int i = tid; i < 4096; i += NTHR) wfs[i] = p.w_four[(size_t)(layer * 4 + g) * 4096 + i]; __syncthreads(); }
        for (int i = tid; i < 4096; i += NTHR) { const int c = i >> 6, d = i & 63; float v;
            if (ty == 0) v = p.w_pool[((size_t)(layer * 4 + g) * 64 + c) * 64 + d] * p.pool_scale[layer * 256 + g * 64 + d];
            else { v = 0.f;
#pragma unroll 8
                for (int m = 0; m < 64; ++m) { const float rev = (float)((m * c) & 63) * (1.0f / 64.0f); const float t = ty == 1 ? __builtin_amdgcn_cosf(rev) : __builtin_amdgcn_sinf(rev); v += t * wfs[m * 64 + d]; } }
            M2[i] = v; }
        const int srccol = (ty == 0 ? 768 : 1024) + g * 64;
        for (int i = tid; i < 128 * 64; i += NTHR) { const int kk = i >> 6, c = i & 63; tile[kk * 65 + c] = p.w_in[((size_t)layer * 1024 + k0 + kk) * INW + srccol + c]; }
        __syncthreads();
        { const int d = tid & 63, kg = tid >> 6;
          bf16* dst = (bf16*)(p.ws + WS_WIN) + ((size_t)layer * NIN + 768 + ty * 256 + g * 64 + d) * 1024 + k0 + kg * 16;
          float o[16];
#pragma unroll
          for (int j = 0; j < 16; ++j) o[j] = 0.f;
          for (int c = 0; c < 64; ++c) { const float mv = M2[c * 64 + d];
#pragma unroll
              for (int j = 0; j < 16; ++j) o[j] += tile[(kg * 16 + j) * 65 + c] * mv; }
          v4u w0, w1; w0.x = pk2(o[0], o[1]); w0.y = pk2(o[2], o[3]); w0.z = pk2(o[4], o[5]); w0.w = pk2(o[6], o[7]);
          w1.x = pk2(o[8], o[9]); w1.y = pk2(o[10], o[11]); w1.z = pk2(o[12], o[13]); w1.w = pk2(o[14], o[15]);
          *(v4u*)dst = w0; *(v4u*)(dst + 8) = w1; }
        __syncthreads();
    }
}
__device__ __forceinline__ void tr_item(const float* W, int ldw, int c0, int k0, bf16* WT, int K, int r0, LAS float* scr, int lane) {
#pragma unroll 8
    for (int i = 0; i < 32; ++i) { const int kk = 2 * i + (lane >> 5); scr[kk * 33 + (lane & 31)] = W[(size_t)(k0 + kk) * ldw + c0 + (lane & 31)]; }
    asm volatile("s_waitcnt lgkmcnt(0)" ::: "memory");
    const int c = lane & 7;
#pragma unroll
    for (int j = 0; j < 4; ++j) { const int n = (lane >> 3) + 8 * j; const LAS float* s = scr + (8 * c) * 33 + n;
        v4u o; o.x = pk2(s[0 * 33], s[1 * 33]); o.y = pk2(s[2 * 33], s[3 * 33]); o.z = pk2(s[4 * 33], s[5 * 33]); o.w = pk2(s[6 * 33], s[7 * 33]);
        *(v4u*)(WT + (size_t)(r0 + n) * K + k0 + 8 * c) = o; }
    asm volatile("s_waitcnt lgkmcnt(0)" ::: "memory");
}
__device__ __forceinline__ void p0_transposes(const P& p, LAS unsigned char* lds, int wave, int lane) {
    LAS float* scr = (LAS float*)(lds + wave * 16384);
    const int gw = blockIdx.x * NWAVES + wave, NGW = gridDim.x * NWAVES;
    constexpr int I_IN = 24 * 16, I_OUT = 32 * 16, I_GU = 176 * 16, I_DN = 32 * 44, I_L = I_IN + I_OUT + I_GU + I_DN;
    for (int it = gw; it < 2 * I_L; it += NGW) {
        const int layer = it / I_L; int r = it % I_L;
        if (r < I_IN) { const int nb = r % 24, kb = r / 24; tr_item(p.w_in + (size_t)layer * 1024 * INW, INW, nb * 32, kb * 64, (bf16*)(p.ws + WS_WIN) + (size_t)layer * NIN * 1024, 1024, (nb >> 3) * 256 + 128 * (nb & 1) + 32 * ((nb & 7) >> 1), scr, lane); continue; } r -= I_IN;
        if (r < I_OUT) { const int nb = r % 32, kb = r / 32; tr_item(p.w_out + (size_t)layer * 1024 * 1024, 1024, nb * 32, kb * 64, (bf16*)(p.ws + WS_WOUT) + (size_t)layer * 1024 * 1024, 1024, (nb >> 3) * 256 + 128 * (nb & 1) + 32 * ((nb & 7) >> 1), scr, lane); continue; } r -= I_OUT;
        if (r < I_GU) { const int nb = r % 176, kb = r / 176; const int n0 = nb * 32; const int j = n0 < DFF ? n0 : n0 - DFF; const int drow = (j >> 7) * 256 + (n0 < DFF ? 0 : 128) + (j & 127);
            tr_item(p.w_gate_up + (size_t)layer * 1024 * NGU, NGU, n0, kb * 64, (bf16*)(p.ws + WS_WGU) + (size_t)layer * NGU * 1024, 1024, drow, scr, lane); continue; } r -= I_GU;
        { const int nb = r % 32, kb = r / 32; tr_item(p.w_down + (size_t)layer * DFF * 1024, 1024, nb * 32, kb * 64, (bf16*)(p.ws + WS_WDN) + (size_t)layer * 1024 * DFF, DFF, (nb >> 3) * 256 + 128 * (nb & 1) + 32 * ((nb & 7) >> 1), scr, lane); }
    }
}
__device__ __forceinline__ void p0_trig(const P& p, int tid) {
    const int gt = blockIdx.x * NTHR + tid, NGT = gridDim.x * NTHR;
    bf16* TC = (bf16*)(p.ws + WS_TRIGC);
    for (int it = gt; it < 256 * 32; it += NGT) { const int k = it >> 5, c8 = (it & 31) * 8;
        float v[8];
#pragma unroll
        for (int jj = 0; jj < 8; ++jj) { const int j = c8 + jj; const bool isS = j > 128; const int l = isS ? j - 128 : j; const float rev = (float)((k * l) & 255) * (1.0f / 256.0f); v[jj] = isS ? -__builtin_amdgcn_sinf(rev) : __builtin_amdgcn_cosf(rev); }
        v4u w; w.x = pk2(v[0], v[1]); w.y = pk2(v[2], v[3]); w.z = pk2(v[4], v[5]); w.w = pk2(v[6], v[7]);
        *(v4u*)(TC + (size_t)k * 256 + c8) = w; }
}
__device__ __forceinline__ void norm_phase(const float* sx, const float* scx, int nrows, const float* g, const float* modl, int shift_chunk, int scale_chunk, bf16* HX, int wave, int lane) {
    constexpr int R = 2;
    const int gw = blockIdx.x * NWAVES + wave, NGW = gridDim.x * NWAVES;
    f32x4 gm[4];
#pragma unroll
    for (int j = 0; j < 4; ++j) gm[j] = *(const f32x4*)(g + 256 * j + 4 * lane);
    for (int m0 = gw * R; m0 < nrows; m0 += NGW * R) {
        f32x4 v[R][4];
#pragma unroll
        for (int e = 0; e < R; ++e) { const int m = m0 + e; const float* xrow = m < MXR ? sx + (size_t)m * 1024 : scx + (size_t)(m - MXR) * 1024;
#pragma unroll
            for (int j = 0; j < 4; ++j) v[e][j] = *(const f32x4*)(xrow + 256 * j + 4 * lane); }
#pragma unroll
        for (int e = 0; e < R; ++e) { const int m = m0 + e; const float* md = modl + (size_t)(m < MXR ? (m >> 12) : 16) * MODW_;
            float s = 0.f;
#pragma unroll
            for (int j = 0; j < 4; ++j) s += (v[e][j].x * v[e][j].x + v[e][j].y * v[e][j].y) + (v[e][j].z * v[e][j].z + v[e][j].w * v[e][j].w);
            const float rstd = 1.0f / sqrtf(wave_sum(s, lane) * (1.0f / 1024.0f) + 1e-6f);
#pragma unroll
            for (int j = 0; j < 4; ++j) { const f32x4 scv = *(const f32x4*)(md + scale_chunk * 1024 + 256 * j + 4 * lane), shv = *(const f32x4*)(md + shift_chunk * 1024 + 256 * j + 4 * lane);
                const f32x4 y = v[e][j] * rstd * gm[j] * (scv + 1.0f) + shv;
                v2u w; w.x = pk2(y.x, y.y); w.y = pk2(y.z, y.w);
                *(v2u*)(HX + (size_t)m * 1024 + 256 * j + 4 * lane) = w; } }
    }
}
__device__ __forceinline__ void norm_phase_bf16(const bf16* XS, int nrows, const float* g, const float* modl, int shift_chunk, int scale_chunk, bf16* HX, int wave, int lane) {
    constexpr int R = 4;
    const int gw = blockIdx.x * NWAVES + wave, NGW = gridDim.x * NWAVES;
    f32x4 gm[4];
#pragma unroll
    for (int j = 0; j < 4; ++j) gm[j] = *(const f32x4*)(g + 16 * lane + 4 * j);
    for (int m0 = gw * R; m0 < nrows; m0 += NGW * R) {
        v4u ra[R][2];
#pragma unroll
        for (int e = 0; e < R; ++e) { const bf16* xr = XS + (size_t)(m0 + e) * 1024 + lane * 16; ra[e][0] = *(const v4u*)xr; ra[e][1] = *(const v4u*)(xr + 8); }
#pragma unroll
        for (int e = 0; e < R; ++e) { const int m = m0 + e; const float* md = modl + (size_t)(m < MXR ? (m >> 12) : 16) * MODW_;
            const v4u r0 = ra[e][0], r1 = ra[e][1];
            f32x4 v[4];
            v[0] = (f32x4){__builtin_bit_cast(float, r0.x << 16), __builtin_bit_cast(float, r0.x & 0xffff0000u), __builtin_bit_cast(float, r0.y << 16), __builtin_bit_cast(float, r0.y & 0xffff0000u)};
            v[1] = (f32x4){__builtin_bit_cast(float, r0.z << 16), __builtin_bit_cast(float, r0.z & 0xffff0000u), __builtin_bit_cast(float, r0.w << 16), __builtin_bit_cast(float, r0.w & 0xffff0000u)};
            v[2] = (f32x4){__builtin_bit_cast(float, r1.x << 16), __builtin_bit_cast(float, r1.x & 0xffff0000u), __builtin_bit_cast(float, r1.y << 16), __builtin_bit_cast(float, r1.y & 0xffff0000u)};
            v[3] = (f32x4){__builtin_bit_cast(float, r1.z << 16), __builtin_bit_cast(float, r1.z & 0xffff0000u), __builtin_bit_cast(float, r1.w << 16), __builtin_bit_cast(float, r1.w & 0xffff0000u)};
            float s = 0.f;
#pragma unroll
            for (int j = 0; j < 4; ++j) s += (v[j].x * v[j].x + v[j].y * v[j].y) + (v[j].z * v[j].z + v[j].w * v[j].w);
            const float rstd = 1.0f / sqrtf(wave_sum(s, lane) * (1.0f / 1024.0f) + 1e-6f);
            unsigned o[8];
#pragma unroll
            for (int j = 0; j < 4; ++j) { const f32x4 scv = *(const f32x4*)(md + scale_chunk * 1024 + 16 * lane + 4 * j), shv = *(const f32x4*)(md + shift_chunk * 1024 + 16 * lane + 4 * j);
                const f32x4 y = v[j] * rstd * gm[j] * (scv + 1.0f) + shv; o[2 * j] = pk2(y.x, y.y); o[2 * j + 1] = pk2(y.z, y.w); }
            bf16* hp = HX + (size_t)m * 1024 + lane * 16;
            *(v4u*)hp = (v4u){o[0], o[1], o[2], o[3]}; *(v4u*)(hp + 8) = (v4u){o[4], o[5], o[6], o[7]}; }
    }
}
__device__ __forceinline__ void prep_phase(const P& p, int layer, LAS unsigned char* lds, int tid, int wave, int lane, int cu, int ncu) {
    const bf16* Z = (const bf16*)(p.ws + WS_Z); bf16* MX = (bf16*)(p.ws + WS_MX);
    const int gw = cu * NWAVES + wave, NGW = ncu * NWAVES;
    { const int nrows = layer == 0 ? MTR : MXR;
      for (int it = gw; it < nrows / 4; it += NGW) {
        const int m = it * 4 + (lane >> 4), c = lane & 15;
        const bool isx = m < MXR;
        const int t = isx ? (m & 4095) : ((m - MXR) & 255), L = isx ? SEQ : CTX;
        const int w = 2 << (c >> 2);
        int lo = t - (w >> 1); if (lo < 0) lo = 0; int hi = t + w - (w >> 1); if (hi > L) hi = L;
        const bf16* zb = Z + (size_t)(m - t) * 1024 + 768 + c * 16;
        float a[16];
#pragma unroll
        for (int f = 0; f < 16; ++f) a[f] = 0.f;
        float sv[16];
        { const v4u q0 = *(const v4u*)(zb + (size_t)t * 1024), q1 = *(const v4u*)(zb + (size_t)t * 1024 + 8);
          const unsigned ww[8] = {q0.x, q0.y, q0.z, q0.w, q1.x, q1.y, q1.z, q1.w};
#pragma unroll
          for (int j = 0; j < 8; ++j) { sv[2 * j] = __builtin_bit_cast(float, ww[j] << 16); sv[2 * j + 1] = __builtin_bit_cast(float, ww[j] & 0xffff0000u); } }
#pragma unroll
        for (int ib = 0; ib < 16; ib += 8) { v4u q0[8], q1[8];
#pragma unroll
            for (int i = 0; i < 8; ++i) { int tt = lo + ib + i; if (tt > hi - 1) tt = hi - 1; q0[i] = *(const v4u*)(zb + (size_t)tt * 1024); q1[i] = *(const v4u*)(zb + (size_t)tt * 1024 + 8); }
#pragma unroll
            for (int i = 0; i < 8; ++i) { const float wgt = (lo + ib + i < hi) ? 1.0f : 0.0f;
                const unsigned ww[8] = {q0[i].x, q0[i].y, q0[i].z, q0[i].w, q1[i].x, q1[i].y, q1[i].z, q1[i].w};
#pragma unroll
                for (int j = 0; j < 8; ++j) { a[2 * j] += wgt * __builtin_bit_cast(float, ww[j] << 16); a[2 * j + 1] += wgt * __builtin_bit_cast(float, ww[j] & 0xffff0000u); } } }
        const float inv = 1.0f / (float)(hi - lo);
        v4u w0, w1;
        w0.x = pk2(a[0] * inv - sv[0], a[1] * inv - sv[1]); w0.y = pk2(a[2] * inv - sv[2], a[3] * inv - sv[3]); w0.z = pk2(a[4] * inv - sv[4], a[5] * inv - sv[5]); w0.w = pk2(a[6] * inv - sv[6], a[7] * inv - sv[7]);
        w1.x = pk2(a[8] * inv - sv[8], a[9] * inv - sv[9]); w1.y = pk2(a[10] * inv - sv[10], a[11] * inv - sv[11]); w1.z = pk2(a[12] * inv - sv[12], a[13] * inv - sv[13]); w1.w = pk2(a[14] * inv - sv[14], a[15] * inv - sv[15]);
        bf16* o = MX + (size_t)m * 1024 + 512 + c * 16; *(v4u*)o = w0; *(v4u*)(o + 8) = w1;
      } }
    __syncthreads();
    { LAS unsigned short* row = (LAS unsigned short*)(lds + wave * 16384);
      const bf16* PQT = (const bf16*)(p.ws + WS_PQT); const bf16* PQTC = (const bf16*)(p.ws + WS_PQTC); bf16* PQF = (bf16*)(p.ws + WS_PQF); bf16* PQFC = (bf16*)(p.ws + WS_PQFC);
      const int ntot = layer == 0 ? 8192 : 4096;
      for (int it = 4096 + gw; it < ntot; it += NGW) {
        const bool isx = it < 4096; const int n = isx ? it : it - 4096, L = isx ? SEQ : CTX, H2 = L >> 1;
        const bf16* src = isx ? PQT + (size_t)n * 8192 : PQTC + (size_t)n * 512;
        bf16* dst = isx ? PQF + (size_t)n * 4096 : PQFC + (size_t)n * 256;
        for (int c = lane; c < L / 4; c += 64) *(LAS v4u*)(row + c * 8) = *(const v4u*)(src + c * 8);
        asm volatile("s_waitcnt vmcnt(0) lgkmcnt(0)" ::: "memory");
        for (int c = lane; c < L / 8; c += 64) { const int j0 = c * 8; float o[8];
#pragma unroll
            for (int jj = 0; jj < 8; ++jj) { const int j = j0 + jj; const bool lowh = j <= H2; const int l = j - H2;
                const int ia = lowh ? j : L + l, ib = lowh ? L - j : 2 * L - l;
                const float va = bf2f(row[ia]), vb = bf2f(row[ib]);
                const float sg = lowh ? ((j == 0 || j == H2) ? 0.0f : 1.0f) : -1.0f;
                o[jj] = va + sg * vb; }
            v4u w; w.x = pk2(o[0], o[1]); w.y = pk2(o[2], o[3]); w.z = pk2(o[4], o[5]); w.w = pk2(o[6], o[7]);
            *(v4u*)(dst + j0) = w; }
        asm volatile("s_waitcnt lgkmcnt(0)" ::: "memory");
      } }
    __syncthreads();
}

__device__ __forceinline__ constexpr int bitrev6(int i) { return ((i & 1) << 5) | ((i & 2) << 3) | ((i & 4) << 1) | ((i & 8) >> 1) | ((i & 16) >> 3) | ((i & 32) >> 5); }
typedef float f32x2 __attribute__((ext_vector_type(2)));
template <int HALF> __device__ __forceinline__ void fft64_stage(f32x2 (&x)[64]) {
constexpr float FC[32] = {1.000000000e+00f, 9.951847267e-01f, 9.807852804e-01f, 9.569403357e-01f, 9.238795325e-01f, 8.819212643e-01f, 8.314696123e-01f, 7.730104534e-01f, 7.071067812e-01f, 6.343932842e-01f, 5.555702330e-01f, 4.713967368e-01f, 3.826834324e-01f, 2.902846773e-01f, 1.950903220e-01f, 9.801714033e-02f, 6.123233996e-17f, -9.801714033e-02f, -1.950903220e-01f, -2.902846773e-01f, -3.826834324e-01f, -4.713967368e-01f, -5.555702330e-01f, -6.343932842e-01f, -7.071067812e-01f, -7.730104534e-01f, -8.314696123e-01f, -8.819212643e-01f, -9.238795325e-01f, -9.569403357e-01f, -9.807852804e-01f, -9.951847267e-01f};
    constexpr float FS[32] = {0.000000000e+00f, 9.801714033e-02f, 1.950903220e-01f, 2.902846773e-01f, 3.826834324e-01f, 4.713967368e-01f, 5.555702330e-01f, 6.343932842e-01f, 7.071067812e-01f, 7.730104534e-01f, 8.314696123e-01f, 8.819212643e-01f, 9.238795325e-01f, 9.569403357e-01f, 9.807852804e-01f, 9.951847267e-01f, 1.000000000e+00f, 9.951847267e-01f, 9.807852804e-01f, 9.569403357e-01f, 9.238795325e-01f, 8.819212643e-01f, 8.314696123e-01f, 7.730104534e-01f, 7.071067812e-01f, 6.343932842e-01f, 5.555702330e-01f, 4.713967368e-01f, 3.826834324e-01f, 2.902846773e-01f, 1.950903220e-01f, 9.801714033e-02f};
#pragma unroll
    for (int b0 = 0; b0 < 64; b0 += 2 * HALF)
#pragma unroll
        for (int j = 0; j < HALF; ++j) { const int e = j * (32 / HALF), i0 = b0 + j, i1 = b0 + j + HALF;
            const f32x2 a = x[i0], b = x[i1];
            x[i0] = a + b;
            const f32x2 d = a - b, dsw = __builtin_shufflevector(d, d, 1, 0);
            if (e == 0) x[i1] = d;
            else if (e == 16) x[i1] = dsw * (f32x2){1.0f, -1.0f};
            else x[i1] = d * (f32x2){FC[e], FC[e]} + dsw * (f32x2){FS[e], -FS[e]}; }
}
__device__ __forceinline__ void fft64_dif(f32x2 (&x)[64]) {
    fft64_stage<32>(x); __builtin_amdgcn_sched_barrier(0); fft64_stage<16>(x); __builtin_amdgcn_sched_barrier(0); fft64_stage<8>(x); __builtin_amdgcn_sched_barrier(0);
    fft64_stage<4>(x); __builtin_amdgcn_sched_barrier(0); fft64_stage<2>(x); __builtin_amdgcn_sched_barrier(0); fft64_stage<1>(x); __builtin_amdgcn_sched_barrier(0);
}
__device__ __forceinline__ void fft_phase(const P& p, LAS unsigned char* lds, int tid, int wave, int lane, int cu, int ncu) {
    const bf16* PQT = (const bf16*)(p.ws + WS_PQT); bf16* MX = (bf16*)(p.ws + WS_MX);
    LAS unsigned short* row = (LAS unsigned short*)(lds + wave * 16640);
    LAS float* T = (LAS float*)(lds + wave * 16640);
    LAS unsigned short* OUT = (LAS unsigned short*)lds;
    for (int k = 0; k * ncu < 512; ++k) {
        const int it = (ncu == 256) ? ((((cu & 7) + 8 * ((cu >> 6) + 4 * k)) << 3) | ((cu >> 3) & 7)) : cu + k * ncu;
        if (it >= 512) break;
        const int bgi = it >> 3, db = it & 7, n = bgi * 64 + db * 8 + wave;
        int lane_t = lane; asm volatile("" : "+v"(lane_t));
        const bf16* src = PQT + (size_t)n * 8192;
        for (int c = lane; c < 1024; c += 64) *(LAS v4u*)(row + c * 8) = *(const v4u*)(src + c * 8);
        asm volatile("s_waitcnt vmcnt(0) lgkmcnt(0)" ::: "memory"); __builtin_amdgcn_sched_barrier(0);
        f32x2 x[64];
#pragma unroll
        for (int r = 0; r < 64; ++r) x[r] = (f32x2){bf2f(row[64 * r + lane]), -bf2f(row[4096 + 64 * r + lane])};
        asm volatile("s_waitcnt lgkmcnt(0)" ::: "memory"); __builtin_amdgcn_sched_barrier(0);
        fft64_dif(x);
        float ti[64];
#pragma unroll
        for (int r = 0; r < 64; ++r) { const int k1 = bitrev6(r); const float rev = (float)((k1 * lane_t) & 4095) * (1.0f / 4096.0f);
            const float c = __builtin_amdgcn_cosf(rev), s = __builtin_amdgcn_sinf(rev);
            const f32x2 t = x[r] * (f32x2){c, c} + __builtin_shufflevector(x[r], x[r], 1, 0) * (f32x2){s, -s}; T[k1 * 65 + lane] = t.x; ti[r] = t.y; }
        f32x2 bb[64];
        asm volatile("s_waitcnt lgkmcnt(0)" ::: "memory"); __builtin_amdgcn_sched_barrier(0);
#pragma unroll
        for (int r = 0; r < 64; ++r) bb[r].x = T[lane * 65 + r];
        asm volatile("s_waitcnt lgkmcnt(0)" ::: "memory"); __builtin_amdgcn_sched_barrier(0);
#pragma unroll
        for (int r = 0; r < 64; ++r) { const int k1 = bitrev6(r); T[k1 * 65 + lane] = ti[r]; }
        asm volatile("s_waitcnt lgkmcnt(0)" ::: "memory"); __builtin_amdgcn_sched_barrier(0);
#pragma unroll
        for (int r = 0; r < 64; ++r) bb[r].y = T[lane * 65 + r];
        asm volatile("s_waitcnt lgkmcnt(0)" ::: "memory"); __builtin_amdgcn_sched_barrier(0);
        fft64_dif(bb);
        __syncthreads();
#pragma unroll
        for (int r = 0; r < 64; ++r) { const int k2 = bitrev6(r); OUT[(lane + 64 * k2) * 8 + wave] = (unsigned short)f2bf(bb[r].x * (1.0f / 512.0f)); }
        __syncthreads();
        { const int b = bgi >> 2, g = bgi & 3;
#pragma unroll
          for (int i = 0; i < 8; ++i) { const int k = tid + 512 * i; const v4u v = *(const LAS v4u*)(OUT + k * 8);
              *(v4u*)(MX + ((size_t)(b * SEQ + k)) * 1024 + 768 + g * 64 + db * 8) = v; } }
        __syncthreads();
    }
}
typedef __attribute__((address_space(1))) unsigned gu32;
#define RLX_AGENT __ATOMIC_RELAXED, __HIP_MEMORY_SCOPE_AGENT
#define XB_TMO      128
#define XB_XCNT(j)  (256  + 64 * (j))
#define XB_XSUB(j)  (1280 + 64 * (j))
#define XB_XGEN(j)  (2304 + 64 * (j))
#define XB_TOP      3328
#define XB_TOPGEN   3392
#define XCD_BAR_WORDS 3456
#define XB_SPIN_CAP (1u << 18)

__device__ __forceinline__ unsigned xb_ld(unsigned* p)              { return __hip_atomic_load(p, __ATOMIC_RELAXED, __HIP_MEMORY_SCOPE_AGENT); }
__device__ __forceinline__ unsigned xb_add(unsigned* p, unsigned v) { return __hip_atomic_fetch_add(p, v, __ATOMIC_RELAXED, __HIP_MEMORY_SCOPE_AGENT); }
__device__ __forceinline__ unsigned xb_xcc_id() { return (unsigned)__builtin_amdgcn_s_getreg((3 << 11) | 20) & 0xFu; }
#define XB_SPIN(cond, bar) do { unsigned _sp = 0; while (cond) { __builtin_amdgcn_s_sleep(1); \
    if ((++_sp & 255u) == 0u) { if (xb_ld(&(bar)[XB_TMO])) break; if (_sp > XB_SPIN_CAP) { atomicAdd(&(bar)[XB_TMO], 1u); break; } } } } while (0)

struct XcdBarrier {
    unsigned* bar; unsigned x;
    volatile LAS unsigned* st;
};

__device__ __forceinline__ XcdBarrier xcd_barrier_post(unsigned* bar, volatile LAS unsigned* st) {
    XcdBarrier b; b.bar = bar; b.x = (unsigned)__builtin_amdgcn_readfirstlane((int)xb_xcc_id()); b.st = st;
    if (threadIdx.x == 0) (void)xb_add(&bar[XB_XCNT(b.x)], 1u);
    return b;
}
__device__ __forceinline__ void xcd_barrier_complete(unsigned* bar, unsigned x, unsigned& nloc, unsigned& nx) {
    const unsigned G = gridDim.x * gridDim.y * gridDim.z;
    unsigned sum, cnt, mine, sp = 0u;
    for (;;) {
        sum = 0u; cnt = 0u; mine = 0u;
#pragma unroll
        for (unsigned j = 0; j < 16; ++j) { const unsigned c = xb_ld(&bar[XB_XCNT(j)]); sum += c; cnt += (c > 0u) ? 1u : 0u; mine = (j == x) ? c : mine; }
        if (sum == G) break;
        __builtin_amdgcn_s_sleep(1);
        if ((++sp & 255u) == 0u) { if (xb_ld(&bar[XB_TMO])) break; if (sp > XB_SPIN_CAP) { atomicAdd(&bar[XB_TMO], 1u); break; } }
    }
    nloc = mine > 0u ? mine : 1u; nx = cnt > 0u ? cnt : 1u;
}

__device__ __forceinline__ void xcd_barrier(const XcdBarrier& b) {
    asm volatile("s_waitcnt vmcnt(0)" ::: "memory");
    __syncthreads();
    if (threadIdx.x == 0) {
        unsigned* bar = b.bar; unsigned bx_ = b.x; asm volatile("" : "+s"(bx_));
        __builtin_amdgcn_s_waitcnt(0);
        unsigned nloc = b.st[0], nx = b.st[1];
        if (nloc == 0u) { xcd_barrier_complete(bar, bx_, nloc, nx); b.st[0] = nloc; b.st[1] = nx; }
        const unsigned old = xb_add(&bar[XB_XSUB(bx_)], 1u);
        const unsigned gen = old / nloc;
        if (old + 1u == (gen + 1u) * nloc) {
            __builtin_amdgcn_fence(__ATOMIC_RELEASE, "agent");
            asm volatile("s_waitcnt vmcnt(0)" ::: "memory");
            const unsigned og = xb_add(&bar[XB_TOP], 1u);
            const unsigned tg = og / nx;
            if (og + 1u == (tg + 1u) * nx) xb_add(&bar[XB_TOPGEN], 1u);
            else XB_SPIN(xb_ld(&bar[XB_TOPGEN]) == tg, bar);
            __builtin_amdgcn_fence(__ATOMIC_ACQUIRE, "agent");
            xb_add(&bar[XB_XGEN(bx_)], 1u);
            asm volatile("s_waitcnt vmcnt(0)" ::: "memory");
        } else {
            XB_SPIN(xb_ld(&bar[XB_XGEN(bx_)]) == gen, bar);
            __builtin_amdgcn_fence(__ATOMIC_ACQUIRE, "agent");
            asm volatile("s_waitcnt vmcnt(0)" ::: "memory");
        }
    }
    __syncthreads();
}

__global__ void __launch_bounds__(NTHR, 2) mk_fwd(P p) {
    extern __shared__ __attribute__((aligned(16))) unsigned char lds_raw[];
    LAS unsigned char* lds = (LAS unsigned char*)lds_raw;
    cg::grid_group grid = cg::this_grid();
    if (p.ws == nullptr) grid.sync();
    volatile LAS unsigned* bst = (volatile LAS unsigned*)(lds + 138240);
    if (threadIdx.x < 2) bst[threadIdx.x] = 0u;
    __syncthreads();
    const XcdBarrier xbar = xcd_barrier_post((unsigned*)(p.ws + WS_CTL), bst);
#define GRID_SYNC() xcd_barrier(xbar)
#define FRESH_IDS() int tid = threadIdx.x; asm volatile("" : "+v"(tid)); const int lane = tid & 63, wave = __builtin_amdgcn_readfirstlane(tid >> 6); int bx = blockIdx.x; asm volatile("" : "+s"(bx)); \
    const int vcu = (G % 8 == 0) ? (bx % 8) * (G / 8) + bx / 8 : bx; (void)lane; (void)wave; (void)vcu
    const int G = gridDim.x;
    unsigned char* ws = p.ws;
    float* MOD = (float*)(ws + WS_MOD);
    bf16* HX = (bf16*)(ws + WS_HX); bf16* Zb = (bf16*)(ws + WS_Z); bf16* MXb = (bf16*)(ws + WS_MX); bf16* Hb = (bf16*)(ws + WS_H);
    bf16* PQT = (bf16*)(ws + WS_PQT); bf16* PQTC = (bf16*)(ws + WS_PQTC); bf16* XS = (bf16*)(ws + WS_XS);
    const attn_body::bf16* QPb = (const attn_body::bf16*)(ws + WS_QP); const attn_body::bf16* KPb = (const attn_body::bf16*)(ws + WS_KP); const attn_body::bf16* VPb = (const attn_body::bf16*)(ws + WS_VP);

    LAS float* ropeT = (LAS float*)(lds + 139264);
    for (int i = threadIdx.x; i < 1024; i += NTHR) { const int pos = i >> 4, f = i & 15; const float fr = expf(-(float)f * (1.0f / 16.0f) * 9.210340371976184f); const float a = (float)pos * fr; float rev = a * 0.15915494309189535f; rev -= floorf(rev);
        ropeT[i] = __builtin_amdgcn_cosf(rev); ropeT[1024 + i] = __builtin_amdgcn_sinf(rev); }
    __syncthreads();
    { FRESH_IDS();
    p0_mod(p, lds, tid, wave, lane);
    __syncthreads();
    p0_comp(p, lds, tid);
    __syncthreads();
    p0_transposes(p, lds, wave, lane);
    p0_trig(p, tid); }
    GRID_SYNC();

    for (int layer = 0; layer < 2; ++layer) {
        const bool upd = layer == 0;
        const float* modl = MOD + (size_t)layer * 17 * MODW_;
        const bf16* WIN = (const bf16*)(ws + WS_WIN) + (size_t)layer * NIN * 1024;
        const bf16* WOUT = (const bf16*)(ws + WS_WOUT) + (size_t)layer * 1024 * 1024;
        const bf16* WGU = (const bf16*)(ws + WS_WGU) + (size_t)layer * NGU * 1024;
        const bf16* WDN = (const bf16*)(ws + WS_WDN) + (size_t)layer * 1024 * DFF;
        { FRESH_IDS(); if (layer == 0) norm_phase(p.x, p.ctx, MTR, p.g_mix, modl, 0, 1, HX, wave, lane); else norm_phase_bf16(XS, MTR, p.g_mix + 1024, modl, 0, 1, HX, wave, lane); }
        GRID_SYNC();
        { FRESH_IDS();
            pg8::EpiIn E{Zb, PQT, PQTC, 0, 0, (bf16*)(ws + WS_QP), (bf16*)(ws + WS_KP), (bf16*)(ws + WS_VP), p.q_gain + layer * 64, p.k_gain + layer * 64, ropeT, QSCALE};
            if (upd) { pg8::Gemm g{HX, WIN, MTR, NIN, 1024}; pg8::StaticOrder S; S.init(MTR, NIN, G, bx); pg8::gemm_phase<pg8::EpiIn, pg8::StaticOrder, true, true>(lds, g, S, E); }
            else {
                { pg8::Gemm g{HX, WIN, MXR, NIN, 1024}; pg8::StaticOrder S; S.init(MXR, NIN, G, bx); pg8::gemm_phase<pg8::EpiIn, pg8::StaticOrder, true, true>(lds, g, S, E); }
            }
        }
        GRID_SYNC();
        { FRESH_IDS();
          const int ngemm = upd ? 0 : 16;
          if (bx >= G - ngemm) { pg8::EpiIn E2{Zb, PQT, PQTC, MXR, 512, (bf16*)(ws + WS_QP), (bf16*)(ws + WS_KP), (bf16*)(ws + WS_VP), p.q_gain + layer * 64, p.k_gain + layer * 64, ropeT, QSCALE};
              pg8::Gemm g{HX + (size_t)MXR * 1024, WIN + (size_t)512 * 1024, MCR, 256, 1024}; pg8::StaticOrder S; S.init(MCR, 256, G, G - 1 - bx);
              pg8::gemm_phase<pg8::EpiIn, pg8::StaticOrder, true, true>(lds, g, S, E2); }
          else prep_phase(p, layer, lds, tid, wave, lane, bx, G - ngemm); }
        GRID_SYNC();
        { FRESH_IDS();
            for (int i = 0; i < (2048 + G - 1) / G; ++i) { const int pu = i * G + vcu; if (pu >= 2048) break;
                const int bg = pu >> 6, u = pu & 63, b = bg >> 1, gk = bg & 1, h = gk * 4 + (u >> 4), qb = u & 15;
                const size_t qrow = (size_t)b * SEQ + qb * 256;
                attn_body::attn_unit<8>(QPb + qrow * 512 + h * 64, KPb + (size_t)b * KVL * 128 + gk * 64, VPb + (size_t)b * KVL * 128 + gk * 64,
                                        (attn_body::bf16*)MXb + qrow * 1024 + h * 64, KVL / 64, (char*)lds_raw); }
            if (upd) for (int cu = vcu; cu < 128; cu += G) { const int b = cu >> 3, h = cu & 7, gk = h >> 2; const size_t qrow = (size_t)MXR + b * CTX;
                attn_body::attn_unit<8>(QPb + qrow * 512 + h * 64, KPb + (size_t)b * KVL * 128 + gk * 64, VPb + (size_t)b * KVL * 128 + gk * 64,
                                        (attn_body::bf16*)MXb + qrow * 1024 + h * 64, CTX / 64, (char*)lds_raw); }
            fft_phase(p, lds, tid, wave, lane, bx, G);
            if (upd) { pg8::Gemm g{(const bf16*)(ws + WS_TRIGC), (const bf16*)(ws + WS_PQFC), CTX, 4096, CTX}; pg8::StaticOrder S; S.init(CTX, 4096, G, G - 1 - bx); pg8::EpiFour E{MXb, MXR, CTX, 1.0f / 128.0f};
              pg8::gemm_phase<pg8::EpiFour, pg8::StaticOrder, true, true>(lds, g, S, E); }
        }
        GRID_SYNC();
        { FRESH_IDS(); const int M = upd ? MTR : MXR; pg8::Gemm g{MXb, WOUT, M, 1024, 1024}; pg8::StaticOrder S; S.init(M, 1024, G, bx); pg8::EpiRes E{layer == 0 ? p.x : (const float*)nullptr, p.ctx, XS, XS, (float*)nullptr, modl + 2 * 1024};
          pg8::gemm_phase<pg8::EpiRes, pg8::StaticOrder, true, true>(lds, g, S, E); }
        GRID_SYNC();
        { FRESH_IDS(); norm_phase_bf16(XS, upd ? MTR : MXR, p.g_ffn + layer * 1024, modl, 3, 4, HX, wave, lane); }
        GRID_SYNC();
        { FRESH_IDS(); const int M = upd ? MTR : MXR; pg8::Gemm g{HX, WGU, M, NGU, 1024}; pg8::StaticOrder S; S.init(M, NGU, G, bx); pg8::EpiSwiglu E{Hb};
          pg8::gemm_phase<pg8::EpiSwiglu, pg8::StaticOrder, true, true>(lds, g, S, E); }
        GRID_SYNC();
        { FRESH_IDS(); const int M = upd ? MTR : MXR; pg8::Gemm g{Hb, WDN, M, 1024, DFF}; pg8::StaticOrder S; S.init(M, 1024, G, bx); pg8::EpiRes E{(const float*)nullptr, (const float*)nullptr, XS, upd ? XS : (bf16*)nullptr, p.out, modl + 5 * 1024};
          pg8::gemm_phase<pg8::EpiRes, pg8::StaticOrder, true, true>(lds, g, S, E); }
        if (layer == 0) GRID_SYNC();
    }
}

extern "C" void kernel_launch(void* const* d_in, const int* in_sizes, int n_in, void* d_out, int out_size, void* d_ws, size_t ws_size, hipStream_t stream) {
    static int grid = 0;
    if (grid == 0) {
        if (n_in != 17 || ws_size < WS_END) { fprintf(stderr, "kernel_launch: unexpected n_in %d / ws %zu\n", n_in, ws_size); grid = -1; return; }
        int dev = 0, cus = 0, per_cu = 0;
        hipGetDevice(&dev); hipDeviceGetAttribute(&cus, hipDeviceAttributeMultiprocessorCount, dev);
        hipFuncSetAttribute((const void*)mk_fwd, hipFuncAttributeMaxDynamicSharedMemorySize, LDS_BYTES);
        hipOccupancyMaxActiveBlocksPerMultiprocessor(&per_cu, (const void*)mk_fwd, NTHR, LDS_BYTES);
        (void)hipGetLastError();
        if (per_cu < 1) per_cu = 1;
        grid = cus * per_cu;
    }
    if (grid < 0) return;
    if (hipMemsetAsync((char*)d_ws + WS_CTL, 0, CTL_BYTES, stream) != hipSuccess) { fprintf(stderr, "memset failed\n"); return; }
    P p{};
    const float** pp = (const float**)&p;
    for (int i = 0; i < 17; ++i) pp[i] = (const float*)d_in[i];
    p.out = (float*)d_out; p.ws = (unsigned char*)d_ws;
    void* args[] = {&p};
    hipError_t e = hipLaunchCooperativeKernel((const void*)mk_fwd, dim3(grid), dim3(NTHR), args, LDS_BYTES, stream);
    if (e != hipSuccess) fprintf(stderr, "cooperative launch failed: %s (grid %d)\n", hipGetErrorString(e), grid);
}
```

```cpp
#include <hip/hip_runtime.h>
#include <hip/hip_bf16.h>
#include <hip/hip_cooperative_groups.h>
#include <cstdio>
#include <cstdint>
#include <cmath>
namespace pg8 {
#define PG8_LAS __attribute__((address_space(3)))
typedef unsigned short bf16_t;
typedef short bf16x8 __attribute__((ext_vector_type(8)));
typedef float f32x4 __attribute__((ext_vector_type(4)));
typedef unsigned u32x4 __attribute__((ext_vector_type(4)));
constexpr int BM = 256, BK = 64, HALF = 128, HTB = HALF * BK * 2  , STAGE_BYTES = 8 * HTB, NXCD = 8, WGM = 8;

__host__ __device__ __forceinline__ int lds_byte(int r, int c) { const int st = (r >> 4) * 2 + (c >> 5), rr = r & 15, cc = c & 31, ob = rr * 64 + cc * 2; return st * 1024 + (ob ^ (((ob >> 9) & 1) << 5)); }
__host__ __device__ __forceinline__ void stage_rc(int b, int& R, int& C) { const int st = b / 1024, sb = b % 1024, swz = sb ^ (((sb >> 9) & 1) << 5); R = (st >> 1) * 16 + swz / 64; C = (st & 1) * 32 + (swz % 64) / 2; }
__host__ __device__ __forceinline__ int perm32(int rho) { const int n = rho >> 4, i = rho & 15; return 8 * (i >> 2) + 4 * n + (i & 3); }

struct Unit { int pm, pn; };
struct Gemm { const bf16_t* A; const bf16_t* Bt; int M, N, K; };

struct StaticOrder {
    int nM, nN, nwg, G, c;
    __host__ __device__ void init(int M, int N, int G_, int c_) { nM = M / BM; nN = N / BM; nwg = nM * nN; G = G_; c = c_; }
    __host__ __device__ bool next(int i, Unit& u) const {
        const long L = (long)i * G + c; if (L >= nwg) return false;
        int wgid = (int)L; { const int q = nwg / NXCD, r = nwg % NXCD, xcd = wgid % NXCD, off = wgid / NXCD; wgid = (xcd < r ? xcd * (q + 1) : r * (q + 1) + (xcd - r) * q) + off; }
        const int nig = WGM * nN, gid = wgid / nig, fm = gid * WGM, gsz = (nM - fm) < WGM ? (nM - fm) : WGM;
        u.pm = fm + ((wgid % nig) % gsz); u.pn = (wgid % nig) / gsz; return true;
    }
    __device__ __forceinline__ void a_ready(const Unit&) const {}
    __device__ __forceinline__ void done(const Unit&) const {}
};

__device__ __forceinline__ unsigned cvt_pk_bf16(float lo, float hi) { unsigned r; asm volatile("v_cvt_pk_bf16_f32 %0, %1, %2" : "=v"(r) : "v"(lo), "v"(hi)); return r; }
typedef float f32x2 __attribute__((ext_vector_type(2)));
__device__ __forceinline__ float shx_(float v, int o, int lane) { return __builtin_bit_cast(float, __builtin_amdgcn_ds_bpermute((lane ^ o) << 2, __builtin_bit_cast(int, v))); }
constexpr int XROWS = 65536, CTXL = 256, SEQL = 4096, MODW = 6144;
struct EpiIn {
    static constexpr bool PERM = true, AFTER_DRAIN = false;
    bf16_t* Z; bf16_t* PQt; bf16_t* PQtc; int row_off, col_off;
    bf16_t* QP; bf16_t* KP; bf16_t* VP; const float* qg; const float* kg; const PG8_LAS float* rope; float qscale;
    __device__ __forceinline__ void operator()(const f32x4 (&acc)[2][2][4][2], const Unit& u, int wr, int wc, int fr, int fq) const {
        { int t_ = threadIdx.x; asm volatile("" : "+v"(t_)); fr = t_ & 15; fq = (t_ >> 4) & 3; }
        const int gr0 = row_off + u.pm * BM, ct = (col_off >> 8) + u.pn;
        if (ct < 3) {
            const bool isx = gr0 < XROWS, isv = (ct == 2) && (wc >= 2), isq = ct < 2;
            f32x4 gn[2][2];
            { const float* gp = (isq ? qg : kg) + 8 * fq;
#pragma unroll
              for (int bj = 0; bj < 2; ++bj)
#pragma unroll
                  for (int n = 0; n < 2; ++n) gn[bj][n] = *(const f32x4*)(gp + 32 * bj + 4 * n); }
            const float osc = isq ? qscale : 1.0f;
            const int half = fq >> 1, f0 = 8 * (fq & 1);
#pragma unroll
            for (int ai = 0; ai < 2; ++ai)
#pragma unroll
                for (int m = 0; m < 4; ++m) {
                    const int grow = gr0 + ai * HALF + wr * 64 + m * 16 + fr;
                    const int b = isx ? (grow >> 12) : ((grow - XROWS) >> 8), t = isx ? (grow & 4095) : ((grow - XROWS) & 255);
                    const size_t kvrow = (size_t)b * (SEQL + CTXL) + (isx ? CTXL + t : t);
                    if (isv) {
#pragma unroll
                        for (int bj = 0; bj < 2; ++bj) { const f32x4 v0 = acc[ai][bj][m][0], v1 = acc[ai][bj][m][1];
                            u32x4 w; w.x = cvt_pk_bf16(v0[0], v0[1]); w.y = cvt_pk_bf16(v0[2], v0[3]); w.z = cvt_pk_bf16(v1[0], v1[1]); w.w = cvt_pk_bf16(v1[2], v1[3]);
                            *(u32x4*)(VP + kvrow * 128 + (wc - 2) * 64 + 32 * bj + 8 * fq) = w; }
                    } else {
                        float ss = 0.f;
#pragma unroll
                        for (int bj = 0; bj < 2; ++bj)
#pragma unroll
                            for (int n = 0; n < 2; ++n) { const f32x4 v = acc[ai][bj][m][n]; ss += (v[0] * v[0] + v[1] * v[1]) + (v[2] * v[2] + v[3] * v[3]); }
                        ss += shx_(ss, 16, fq * 16 + fr); ss += shx_(ss, 32, fq * 16 + fr);
                        const float rstd = 1.0f / sqrtf(ss * (1.0f / 64.0f) + 1e-6f);
#pragma unroll
                        for (int bj = 0; bj < 2; ++bj) { f32x4 y[2];
#pragma unroll
                            for (int n = 0; n < 2; ++n) y[n] = acc[ai][bj][m][n] * rstd * gn[bj][n];
                            f32x4 pr[2];
#pragma unroll
                            for (int n = 0; n < 2; ++n)
#pragma unroll
                                for (int j = 0; j < 4; ++j) pr[n][j] = shx_(y[n][j], 32, fq * 16 + fr);
                            if (isx) { const int pos = bj == 0 ? (t >> 6) : (t & 63); const PG8_LAS float* cp = rope + pos * 16 + f0;
#pragma unroll
                                for (int n = 0; n < 2; ++n) { const f32x4 c = *(const PG8_LAS f32x4*)(cp + 4 * n), s = *(const PG8_LAS f32x4*)(cp + 1024 + 4 * n);
                                    y[n] = half == 0 ? y[n] * c - pr[n] * s : y[n] * c + pr[n] * s; } }
                            const f32x4 o0 = y[0] * osc, o1 = y[1] * osc;
                            u32x4 w; w.x = cvt_pk_bf16(o0[0], o0[1]); w.y = cvt_pk_bf16(o0[2], o0[3]); w.z = cvt_pk_bf16(o1[0], o1[1]); w.w = cvt_pk_bf16(o1[2], o1[3]);
                            bf16_t* dst = isq ? QP + (size_t)grow * 512 + (ct * 4 + wc) * 64 + 32 * bj + 8 * fq : KP + kvrow * 128 + wc * 64 + 32 * bj + 8 * fq;
                            *(u32x4*)dst = w; }
                    }
                }
        } else if (ct == 3) {
            bf16_t* base = Z + (size_t)(gr0 + wr * 64 + fr) * 1024 + ct * 256 + wc * 32 + 8 * fq;
#pragma unroll
            for (int ai = 0; ai < 2; ++ai)
#pragma unroll
                for (int m = 0; m < 4; ++m) { bf16_t* rowp = base + (size_t)(ai * HALF + m * 16) * 1024;
#pragma unroll
                    for (int bj = 0; bj < 2; ++bj) { const f32x4 v0 = acc[ai][bj][m][0], v1 = acc[ai][bj][m][1];
                        u32x4 w; w.x = cvt_pk_bf16(v0[0], v0[1]); w.y = cvt_pk_bf16(v0[2], v0[3]); w.z = cvt_pk_bf16(v1[0], v1[1]); w.w = cvt_pk_bf16(v1[2], v1[3]);
                        *(u32x4*)(rowp + bj * HALF) = w; } }
        } else {
            const int part = ct - 4; const bool isx = gr0 < XROWS;
            const int b = isx ? (gr0 >> 12) : ((gr0 - XROWS) >> 8);
            const int L = isx ? SEQL : CTXL;
            const int l0 = (isx ? (gr0 & 4095) : 0) + wr * 64 + fr;
            bf16_t* T = isx ? PQt : PQtc;
#pragma unroll
            for (int bj = 0; bj < 2; ++bj)
#pragma unroll
                for (int n = 0; n < 2; ++n)
#pragma unroll
                    for (int j = 0; j < 4; ++j) { const int cc = bj * HALF + wc * 32 + 8 * fq + 4 * n + j;
                        bf16_t* cp = T + ((size_t)((b * 256 + cc) * 2 + part)) * L + l0;
#pragma unroll
                        for (int ai = 0; ai < 2; ++ai)
#pragma unroll
                            for (int m = 0; m < 4; ++m) cp[ai * HALF + m * 16] = (bf16_t)(cvt_pk_bf16(acc[ai][bj][m][n][j], 0.f) & 0xffffu); }
        }
    }
};
struct EpiRes {
    static constexpr bool PERM = true, AFTER_DRAIN = false;
    const float* bx; const float* bc; const bf16_t* bs; bf16_t* os; float* of; const float* gate;
    __device__ __forceinline__ void operator()(const f32x4 (&acc)[2][2][4][2], const Unit& u, int wr, int wc, int fr, int fq) const {
        { int t_ = threadIdx.x; asm volatile("" : "+v"(t_)); fr = t_ & 15; fq = (t_ >> 4) & 3; }
        const bool isx = u.pm < 256;
        const float* gt = gate + (size_t)(isx ? (u.pm >> 4) : 16) * MODW;
        const int col0 = u.pn * BM + wc * 64 + 8 * fq;
        f32x4 gv[2][2];
#pragma unroll
        for (int bj = 0; bj < 2; ++bj)
#pragma unroll
            for (int n = 0; n < 2; ++n) gv[bj][n] = *(const f32x4*)(gt + col0 + bj * 32 + 4 * n);
        const bool bf32 = bx != nullptr, obf = os != nullptr;
#pragma unroll
        for (int ai = 0; ai < 2; ++ai)
#pragma unroll
            for (int m = 0; m < 4; ++m) { const size_t grow = (size_t)u.pm * BM + ai * HALF + wr * 64 + m * 16 + fr;
#pragma unroll
                for (int bj = 0; bj < 2; ++bj) { const size_t off = grow * 1024 + col0 + bj * 32; f32x4 b0, b1;
                    if (bf32) { const float* bp = isx ? bx + off : bc + (off - (size_t)XROWS * 1024); b0 = *(const f32x4*)bp; b1 = *(const f32x4*)(bp + 4); }
                    else { const u32x4 w = *(const u32x4*)(bs + off);
                        b0 = (f32x4){__builtin_bit_cast(float, w.x << 16), __builtin_bit_cast(float, w.x & 0xffff0000u), __builtin_bit_cast(float, w.y << 16), __builtin_bit_cast(float, w.y & 0xffff0000u)};
                        b1 = (f32x4){__builtin_bit_cast(float, w.z << 16), __builtin_bit_cast(float, w.z & 0xffff0000u), __builtin_bit_cast(float, w.w << 16), __builtin_bit_cast(float, w.w & 0xffff0000u)}; }
                    const f32x4 o0 = b0 + gv[bj][0] * acc[ai][bj][m][0], o1 = b1 + gv[bj][1] * acc[ai][bj][m][1];
                    if (obf) { u32x4 w; w.x = cvt_pk_bf16(o0[0], o0[1]); w.y = cvt_pk_bf16(o0[2], o0[3]); w.z = cvt_pk_bf16(o1[0], o1[1]); w.w = cvt_pk_bf16(o1[2], o1[3]); *(u32x4*)(os + off) = w; }
                    else { *(f32x4*)(of + off) = o0; *(f32x4*)(of + off + 4) = o1; } } }
    }
};
struct EpiSwiglu {
    static constexpr bool PERM = true, AFTER_DRAIN = false;
    bf16_t* H;
    __device__ __forceinline__ void operator()(const f32x4 (&acc)[2][2][4][2], const Unit& u, int wr, int wc, int fr, int fq) const {
        { int t_ = threadIdx.x; asm volatile("" : "+v"(t_)); fr = t_ & 15; fq = (t_ >> 4) & 3; }
        bf16_t* base = H + (size_t)(u.pm * BM + wr * 64 + fr) * 2816 + u.pn * HALF + wc * 32 + 8 * fq;
#pragma unroll
        for (int ai = 0; ai < 2; ++ai)
#pragma unroll
            for (int m = 0; m < 4; ++m) { float r[8];
#pragma unroll
                for (int n = 0; n < 2; ++n)
#pragma unroll
                    for (int j = 0; j < 4; ++j) { const float g = acc[ai][0][m][n][j], up = acc[ai][1][m][n][j];
                        r[n * 4 + j] = g * __builtin_amdgcn_rcpf(1.0f + __builtin_amdgcn_exp2f(-1.4426950408889634f * g)) * up; }
                u32x4 w; w.x = cvt_pk_bf16(r[0], r[1]); w.y = cvt_pk_bf16(r[2], r[3]); w.z = cvt_pk_bf16(r[4], r[5]); w.w = cvt_pk_bf16(r[6], r[7]);
                *(u32x4*)(base + (size_t)(ai * HALF + m * 16) * 2816) = w; }
    }
};
struct EpiFour {
    static constexpr bool PERM = true, AFTER_DRAIN = false;
    bf16_t* MX; int rowbase, L; float scale;
    __device__ __forceinline__ void operator()(const f32x4 (&acc)[2][2][4][2], const Unit& u, int wr, int wc, int fr, int fq) const {
        { int t_ = threadIdx.x; asm volatile("" : "+v"(t_)); fr = t_ & 15; fq = (t_ >> 4) & 3; }
        bf16_t* base = MX + (size_t)(rowbase + u.pn * L + u.pm * BM + wr * 64 + fr) * 1024 + 768 + wc * 32 + 8 * fq;
#pragma unroll
        for (int ai = 0; ai < 2; ++ai)
#pragma unroll
            for (int m = 0; m < 4; ++m) { bf16_t* rowp = base + (size_t)(ai * HALF + m * 16) * 1024;
#pragma unroll
                for (int bj = 0; bj < 2; ++bj) { const f32x4 v0 = acc[ai][bj][m][0] * scale, v1 = acc[ai][bj][m][1] * scale;
                    u32x4 w; w.x = cvt_pk_bf16(v0[0], v0[1]); w.y = cvt_pk_bf16(v0[2], v0[3]); w.z = cvt_pk_bf16(v1[0], v1[1]); w.w = cvt_pk_bf16(v1[2], v1[3]);
                    *(u32x4*)(rowp + bj * HALF) = w; } }
    }
};
template <class Epi, class Sched, bool ALIGN_EPI = false, bool SP2 = false>
__device__ __forceinline__ void gemm_phase(PG8_LAS unsigned char* lds, const Gemm g, const Sched& S, const Epi& E) {
    int tid_l = threadIdx.x; asm volatile("" : "+v"(tid_l)); const int tid = tid_l, wid = __builtin_amdgcn_readfirstlane(tid >> 6), lane = tid & 63, wr = wid >> 2, wc = wid & 3, fr = lane & 15, fq = lane >> 4;
    const int K = g.K, nt = K / BK;
    unsigned voffA[2], voffB[2];
#pragma unroll
    for (int i = 0; i < 2; ++i) { int R, C; stage_rc(tid * 16 + i * 8192, R, C); const int Rb = Epi::PERM ? ((R & ~31) + perm32(R & 31)) : R;
        voffA[i] = (unsigned)(R * K + C) * 2u; voffB[i] = (unsigned)(Rb * K + C) * 2u; }
    const size_t kstep = (size_t)(BK * 2);
    const size_t hstep = (size_t)HALF * K * 2;
    const size_t tstep = 2 * hstep;
    const unsigned ldsw = (unsigned)wid * 1024u;
    const int aoff = lds_byte(wr * 64 + fr, fq * 8), boff = lds_byte(wc * 32 + fr, fq * 8);
#define PG8_SA(b, h) (((b) * 2 + (h)) * HTB)
#define PG8_SB(b, h) ((4 + (b) * 2 + (h)) * HTB)
#define PG8_STAGE(bufoff, gbase, voff) do { _Pragma("unroll") for (int _i = 0; _i < 2; ++_i) \
        __builtin_amdgcn_global_load_lds((const unsigned*)((const char*)(gbase) + (voff)[_i]), (PG8_LAS unsigned*)(lds + (bufoff) + ldsw + _i * 8192), 16, 0, 0); } while (0)
#define PG8_LDA(dst, b, h) do { _Pragma("unroll") for (int m = 0; m < 4; ++m) _Pragma("unroll") for (int k = 0; k < 2; ++k) dst[m][k] = *(const PG8_LAS bf16x8*)(lds + PG8_SA(b, h) + aoff + m * 2048 + k * 1024); } while (0)
#define PG8_LDB(dst, b, h) do { _Pragma("unroll") for (int n = 0; n < 2; ++n) _Pragma("unroll") for (int k = 0; k < 2; ++k) dst[n][k] = *(const PG8_LAS bf16x8*)(lds + PG8_SB(b, h) + boff + n * 2048 + k * 1024); } while (0)
#define PG8_MMA(ai, bj, At, Bt) do { __builtin_amdgcn_s_setprio(1); _Pragma("unroll") for (int m = 0; m < 4; ++m) _Pragma("unroll") for (int n = 0; n < 2; ++n) _Pragma("unroll") for (int k = 0; k < 2; ++k) \
        acc[ai][bj][m][n] = __builtin_amdgcn_mfma_f32_16x16x32_bf16(Bt[n][k], At[m][k], acc[ai][bj][m][n], 0, 0, 0); __builtin_amdgcn_s_setprio(0); } while (0)
#define PG8_WAIT_V(n) asm volatile("s_waitcnt vmcnt(" #n ")" ::: "memory")
#define PG8_WAIT_L(n) asm volatile("s_waitcnt lgkmcnt(" #n ")" ::: "memory")
#define PG8_BAR __builtin_amdgcn_s_barrier()
#define PG8_SCHED __builtin_amdgcn_sched_barrier(0)
    Unit cur, nxt; int ui = 0;
    if (!S.next(0, cur)) return;
    f32x4 acc[2][2][4][2];
#pragma unroll
    for (int a = 0; a < 2; ++a)
#pragma unroll
        for (int b = 0; b < 2; ++b)
#pragma unroll
            for (int m = 0; m < 4; ++m)
#pragma unroll
                for (int n = 0; n < 2; ++n) acc[a][b][m][n] = (f32x4){0.f, 0.f, 0.f, 0.f};
    bf16x8 At[4][2], B0[2][2], B1[2][2];
    const char* cA = (const char*)g.A + (size_t)cur.pm * tstep; const char* cB = (const char*)g.Bt + (size_t)cur.pn * tstep;
    S.a_ready(cur);
    if constexpr (SP2) {
        PG8_STAGE(PG8_SB(0, 0), cB, voffB); PG8_STAGE(PG8_SB(0, 1), cB + hstep, voffB); PG8_STAGE(PG8_SA(0, 0), cA, voffA); PG8_STAGE(PG8_SA(0, 1), cA + hstep, voffA);
        if (wr == 1) PG8_BAR;
        PG8_WAIT_V(2); PG8_BAR;
        PG8_STAGE(PG8_SB(1, 0), cB + kstep, voffB); PG8_STAGE(PG8_SA(1, 0), cA + kstep, voffA); PG8_STAGE(PG8_SB(1, 1), cB + hstep + kstep, voffB);
        PG8_WAIT_V(6); PG8_BAR;
    } else {
        PG8_STAGE(PG8_SB(0, 0), cB, voffB); PG8_STAGE(PG8_SA(0, 0), cA, voffA); PG8_STAGE(PG8_SB(0, 1), cB + hstep, voffB); PG8_STAGE(PG8_SA(0, 1), cA + hstep, voffA);
        if (wr == 1) PG8_BAR;
        PG8_WAIT_V(4); PG8_BAR;
        PG8_STAGE(PG8_SB(1, 0), cB + kstep, voffB); PG8_STAGE(PG8_SA(1, 0), cA + kstep, voffA); PG8_STAGE(PG8_SB(1, 1), cB + hstep + kstep, voffB);
        PG8_WAIT_V(6); PG8_BAR;
    }
    for (;;) {
        const bool has_next = S.next(ui + 1, nxt);
        const char* nA = has_next ? (const char*)g.A + (size_t)nxt.pm * tstep : cA; const char* nB = has_next ? (const char*)g.Bt + (size_t)nxt.pn * tstep : cB;
        for (int t = 0; t < nt; t += 2) {
            const bool last = (t == nt - 2);
            const char* a1 = cA + (size_t)(t + 1) * kstep;
            const char* a2 = last ? nA : cA + (size_t)(t + 2) * kstep; const char* b2 = last ? nB : cB + (size_t)(t + 2) * kstep;
            const char* a3 = a2 + kstep; const char* b3 = b2 + kstep;
            if (last && has_next) S.a_ready(nxt);
            if constexpr (SP2) {
            PG8_LDB(B0, 0, 0); PG8_LDB(B1, 0, 1); PG8_SCHED; PG8_LDA(At, 0, 0); PG8_STAGE(PG8_SA(1, 1), a1 + hstep, voffA);
            PG8_WAIT_V(8); PG8_WAIT_L(0); PG8_BAR; PG8_MMA(0, 0, At, B0); PG8_MMA(0, 1, At, B1); PG8_BAR; PG8_SCHED;
            PG8_LDA(At, 0, 1); PG8_STAGE(PG8_SB(0, 0), b2, voffB); PG8_STAGE(PG8_SB(0, 1), b2 + hstep, voffB); PG8_STAGE(PG8_SA(0, 0), a2, voffA);
            PG8_WAIT_V(8); PG8_WAIT_L(0); PG8_BAR; PG8_MMA(1, 0, At, B0); PG8_MMA(1, 1, At, B1); PG8_BAR; PG8_SCHED;
            PG8_LDB(B0, 1, 0); PG8_LDB(B1, 1, 1); PG8_SCHED; PG8_LDA(At, 1, 0); PG8_STAGE(PG8_SA(0, 1), a2 + hstep, voffA);
            PG8_WAIT_V(8); PG8_WAIT_L(0); PG8_BAR; PG8_MMA(0, 0, At, B0); PG8_MMA(0, 1, At, B1); PG8_BAR; PG8_SCHED;
            PG8_LDA(At, 1, 1); PG8_STAGE(PG8_SB(1, 0), b3, voffB); PG8_STAGE(PG8_SB(1, 1), b3 + hstep, voffB); PG8_STAGE(PG8_SA(1, 0), a3, voffA);
            PG8_WAIT_V(8); PG8_WAIT_L(0); PG8_BAR; PG8_MMA(1, 0, At, B0); PG8_MMA(1, 1, At, B1); PG8_BAR; PG8_SCHED;
            } else {
            PG8_LDB(B0, 0, 0); PG8_SCHED; PG8_LDA(At, 0, 0); PG8_STAGE(PG8_SA(1, 1), a1 + hstep, voffA);
            PG8_WAIT_L(8); PG8_BAR; PG8_WAIT_L(0); PG8_MMA(0, 0, At, B0); PG8_BAR; PG8_SCHED;
            PG8_LDB(B1, 0, 1); PG8_STAGE(PG8_SB(0, 0), b2, voffB);
            PG8_BAR; PG8_WAIT_L(0); PG8_MMA(0, 1, At, B1); PG8_BAR;
            PG8_LDA(At, 0, 1); PG8_STAGE(PG8_SA(0, 0), a2, voffA);
            PG8_BAR; PG8_WAIT_L(0); PG8_MMA(1, 0, At, B0); PG8_BAR; PG8_SCHED;
            PG8_STAGE(PG8_SB(0, 1), b2 + hstep, voffB);
            PG8_WAIT_V(6); PG8_BAR; PG8_MMA(1, 1, At, B1); PG8_BAR;
            PG8_LDB(B0, 1, 0); PG8_SCHED; PG8_LDA(At, 1, 0); PG8_STAGE(PG8_SA(0, 1), a2 + hstep, voffA);
            PG8_WAIT_L(8); PG8_BAR; PG8_WAIT_L(0); PG8_MMA(0, 0, At, B0); PG8_BAR; PG8_SCHED;
            PG8_LDB(B1, 1, 1); PG8_STAGE(PG8_SB(1, 0), b3, voffB);
            PG8_BAR; PG8_WAIT_L(0); PG8_MMA(0, 1, At, B1); PG8_BAR;
            PG8_LDA(At, 1, 1); PG8_STAGE(PG8_SA(1, 0), a3, voffA);
            PG8_BAR; PG8_WAIT_L(0); PG8_MMA(1, 0, At, B0); PG8_BAR; PG8_SCHED;
            PG8_STAGE(PG8_SB(1, 1), b3 + hstep, voffB);
            PG8_WAIT_V(6); PG8_BAR; PG8_MMA(1, 1, At, B1); PG8_BAR;
            }
        }
        if constexpr (ALIGN_EPI) { if (wr == 0) PG8_BAR; }
        if constexpr (!Epi::AFTER_DRAIN) { E(acc, cur, wr, wc, fr, fq); S.done(cur); }
        if (!has_next) break;
#pragma unroll
        for (int a = 0; a < 2; ++a)
#pragma unroll
            for (int b = 0; b < 2; ++b)
#pragma unroll
                for (int m = 0; m < 4; ++m)
#pragma unroll
                    for (int n = 0; n < 2; ++n) acc[a][b][m][n] = (f32x4){0.f, 0.f, 0.f, 0.f};
        cur = nxt; cA = nA; cB = nB; ++ui;
        if constexpr (ALIGN_EPI) { if (wr == 1) PG8_BAR; }
    }
    PG8_WAIT_V(0);
    if constexpr (!ALIGN_EPI) { if (wr == 0) PG8_BAR; }
    PG8_BAR;
    if constexpr (Epi::AFTER_DRAIN) { E.fused(acc, cur, wr, wc, fr, fq, lds, wid, lane); S.done(cur); }
#undef PG8_SA
#undef PG8_SB
#undef PG8_STAGE
#undef PG8_LDA
#undef PG8_LDB
#undef PG8_MMA
#undef PG8_WAIT_V
#undef PG8_WAIT_L
#undef PG8_BAR
#undef PG8_SCHED
}
}
namespace attn_body {
using bf16=__hip_bfloat16;
using bf16x8=__attribute__((ext_vector_type(8)))short;
using s16x4=__attribute__((ext_vector_type(4)))short;
using f32x16=__attribute__((ext_vector_type(16)))float;
using u32x4=__attribute__((ext_vector_type(4)))unsigned;
constexpr int D=64,QPITCH=512,KVPITCH=128,OPITCH=1024;
constexpr int NW=8,QBLK=32,QB=QBLK*NW,KVBLK=64;

__device__ __forceinline__ int crow(int r,int hi){return (r&3)+8*(r>>2)+4*hi;}
#define SBAR() __builtin_amdgcn_sched_barrier(0)
__device__ __forceinline__ void cmask(f32x16&p0,f32x16&p1,int jb,int qrel,int hi){
  const float NEG=-INFINITY; int kb=64*jb+4*hi;
  #pragma unroll
  for(int r=0;r<16;++r){int kv=kb+(r&3)+8*(r>>2); if(kv>qrel)p0[r]=NEG; if(kv+32>qrel)p1[r]=NEG;}
}

constexpr int NSLOT=3, SLOTB=8192;
constexpr int LDS_K=0, LDS_V=NSLOT*SLOTB, LDS_WS=2*NSLOT*SLOTB, LDS_OST=LDS_WS+NW*64*4, LDS_BYTES=LDS_OST+NW*4096;
constexpr float C2=0.125f*1.4426950408889634f;
__device__ __forceinline__ void glds16(const void*gsrc,unsigned lds_dst){unsigned keep;
  asm volatile("s_mov_b32 %0, m0\n\ts_mov_b32 m0, %2\n\ts_nop 0\n\tglobal_load_lds_dwordx4 %1, off\n\ts_mov_b32 m0, %0":"=&s"(keep):"v"(gsrc),"s"(lds_dst):"memory");}
__device__ __forceinline__ float max3f(float a,float b,float c){float r;asm("v_max3_f32 %0, %1, %2, %3":"=v"(r):"v"(a),"v"(b),"v"(c));return r;}
__device__ __forceinline__ float max2f(float a,float b){float r;asm("v_max_f32_e32 %0, %1, %2":"=v"(r):"v"(a),"v"(b));return r;}
__device__ __forceinline__ float fadd_s(float a,float b){float r;asm("v_add_f32_e32 %0, %1, %2":"=v"(r):"v"(a),"v"(b));return r;}
__device__ __forceinline__ float fsub_s(float a,float b){float r;asm("v_sub_f32_e32 %0, %1, %2":"=v"(r):"v"(a),"v"(b));return r;}
typedef float f32x2_t __attribute__((ext_vector_type(2))); typedef __bf16 bf16x2_t __attribute__((ext_vector_type(2)));
__device__ __forceinline__ unsigned cvtpk_s(float lo,float hi){f32x2_t v={lo,hi};bf16x2_t b=__builtin_convertvector(v,bf16x2_t);return __builtin_bit_cast(unsigned,b);}
#define WAIT_BAR(N) asm volatile("s_waitcnt vmcnt(" #N ") lgkmcnt(0)\n\ts_barrier":::"memory")

__device__ __forceinline__ void qkt(f32x16&p0,f32x16&p1,const char*Kslot,const bf16x8*qr,const f32x16&negm,int r32,int hi){
  const char*kb=Kslot+hi*1024+r32*16;
  #pragma unroll
  for(int d0=0;d0<4;++d0){
    const bf16x8 b0=*reinterpret_cast<const bf16x8*>(kb+d0*2048);
    const bf16x8 b1=*reinterpret_cast<const bf16x8*>(kb+d0*2048+512);
    if(d0==0){p0=__builtin_amdgcn_mfma_f32_32x32x16_bf16(b0,qr[0],negm,0,0,0);p1=__builtin_amdgcn_mfma_f32_32x32x16_bf16(b1,qr[0],negm,0,0,0);}
    else{p0=__builtin_amdgcn_mfma_f32_32x32x16_bf16(b0,qr[d0],p0,0,0,0);p1=__builtin_amdgcn_mfma_f32_32x32x16_bf16(b1,qr[d0],p1,0,0,0);}}
}
typedef __attribute__((address_space(3))) const char* lds_cptr;
typedef short v4i16_t __attribute__((ext_vector_type(4)));
__device__ __forceinline__ void kload8(bf16x8*kf,lds_cptr kp){
  kf[0]=*(const __attribute__((address_space(3))) bf16x8*)(kp);      kf[1]=*(const __attribute__((address_space(3))) bf16x8*)(kp+512);
  kf[2]=*(const __attribute__((address_space(3))) bf16x8*)(kp+2048); kf[3]=*(const __attribute__((address_space(3))) bf16x8*)(kp+2560);
  kf[4]=*(const __attribute__((address_space(3))) bf16x8*)(kp+4096); kf[5]=*(const __attribute__((address_space(3))) bf16x8*)(kp+4608);
  kf[6]=*(const __attribute__((address_space(3))) bf16x8*)(kp+6144); kf[7]=*(const __attribute__((address_space(3))) bf16x8*)(kp+6656);
}
__device__ __forceinline__ void kload2(bf16x8*kf,lds_cptr kp,int j){ kf[2*j]=*(const __attribute__((address_space(3))) bf16x8*)(kp+j*2048); kf[2*j+1]=*(const __attribute__((address_space(3))) bf16x8*)(kp+j*2048+512); }
__device__ __forceinline__ s16x4 vtr(lds_cptr p){ return __builtin_bit_cast(s16x4,__builtin_amdgcn_ds_read_tr16_b64_v4i16((__attribute__((address_space(3))) v4i16_t*)p)); }
__device__ __forceinline__ float rowmax(const f32x16&p0,const f32x16&p1){
  float a=max3f(p0[0],p0[1],p1[0]),b=max3f(p0[2],p0[3],p1[1]);a=max3f(a,p1[2],p1[3]);
  #pragma unroll
  for(int r=4;r<16;r+=4){a=max3f(a,p0[r],p0[r+1]);b=max3f(b,p0[r+2],p0[r+3]);a=max3f(a,p1[r],p1[r+1]);b=max3f(b,p1[r+2],p1[r+3]);}
  const float m=max2f(a,b);
  auto rr=__builtin_amdgcn_permlane32_swap(__float_as_uint(m),__float_as_uint(m),false,false);
  return max2f(__uint_as_float(rr[0]),__uint_as_float(rr[1]));
}
__device__ __forceinline__ void pv(f32x16*o,int vb,bf16x8 pa0,bf16x8 pa1,bf16x8 pa2,bf16x8 pa3){
  #pragma unroll
  for(int d0=0;d0<2;++d0){s16x4 lo[4],hi[4];
    #pragma unroll
    for(int ks=0;ks<4;++ks){
      asm volatile("ds_read_b64_tr_b16 %0,%1 offset:%c2":"=&v"(lo[ks]):"v"(vb),"i"(d0*4096+ks*1024):"memory");
      asm volatile("ds_read_b64_tr_b16 %0,%1 offset:%c2":"=&v"(hi[ks]):"v"(vb),"i"(d0*4096+ks*1024+512):"memory");}
    asm volatile("s_waitcnt lgkmcnt(0)":::"memory");SBAR();
    #define PK(k) (bf16x8){lo[k][0],lo[k][1],lo[k][2],lo[k][3],hi[k][0],hi[k][1],hi[k][2],hi[k][3]}
    o[d0]=__builtin_amdgcn_mfma_f32_32x32x16_bf16(pa0,PK(0),o[d0],0,0,0);
    o[d0]=__builtin_amdgcn_mfma_f32_32x32x16_bf16(pa1,PK(1),o[d0],0,0,0);
    o[d0]=__builtin_amdgcn_mfma_f32_32x32x16_bf16(pa2,PK(2),o[d0],0,0,0);
    o[d0]=__builtin_amdgcn_mfma_f32_32x32x16_bf16(pa3,PK(3),o[d0],0,0,0);
    #undef PK
  }
}

#ifndef ATTN_STORE16
#define ATTN_STORE16(p,v) (*(u32x4*)(p)=(v))
#endif
template<int THRL> __device__ __forceinline__ void attn_unit(const bf16*Qu,const bf16*__restrict__ Kh,const bf16*__restrict__ Vh,bf16*Ou,const int NT,char*shm){
  int tid_l=threadIdx.x; asm volatile("":"+v"(tid_l)); const int tid=tid_l,lane=tid&63,r32=lane&31,hi=lane>>5; const int wid=__builtin_amdgcn_readfirstlane(tid>>6);
  const bf16*Qw=Qu+(long)(wid*QBLK)*QPITCH;
  const unsigned lds0=(unsigned)(uintptr_t)shm;
  float*wsf=(float*)(shm+LDS_WS)+wid*64;
  const bf16*ksrc=Kh+(long)lane*KVPITCH+wid*8;
  const bf16*vsrc=Vh+(long)(16*(wid&3)+(lane>>2))*KVPITCH+(wid>>2)*32+(lane&3)*8;
  const unsigned kdst=lds0+LDS_K+wid*1024, vdst=lds0+LDS_V+wid*1024;
  #define DMA_K(t,slot) glds16(ksrc+(long)(t)*KVBLK*KVPITCH,(unsigned)__builtin_amdgcn_readfirstlane(kdst+(slot)))
  #define DMA_V(t,slot) glds16(vsrc+(long)(t)*KVBLK*KVPITCH,(unsigned)__builtin_amdgcn_readfirstlane(vdst+(slot)))
  const int vb0=(int)(lds0+LDS_V)+((lane>>4)&1)*32+(lane&3)*8+(4*hi+((lane&15)>>2))*64;
  const char*Kbase=shm+LDS_K; bf16x8 kf[8];
  const lds_cptr shm3=(lds_cptr)shm; const lds_cptr kp0=shm3+LDS_K+hi*1024+r32*16; const lds_cptr vp0=shm3+LDS_V+((lane>>4)&1)*32+(lane&3)*8+(4*hi+((lane&15)>>2))*64;
  DMA_K(0,0);DMA_V(0,0);DMA_K(1,SLOTB);
  bf16x8 qr[4];
  #pragma unroll
  for(int d0=0;d0<4;++d0)qr[d0]=*reinterpret_cast<const bf16x8*>(&Qw[(long)r32*QPITCH+d0*16+hi*8]);
  float mhat=0.f,l_reg=0.f;f32x16 o[2];o[0]=f32x16{};o[1]=f32x16{};f32x16 negm=f32x16{};asm volatile("":"+v"(negm));
  #define CMASK(P0,P1,t) do{}while(0)
  bool resc=false;
  #define START(P0,P1) do{ const float rm=rowmax(P0,P1); resc=false; \
    { const float dl=rm; mhat=fadd_s(mhat,dl); \
      _Pragma("unroll") for(int r=0;r<16;++r){P0[r]=fsub_s(P0[r],dl);P1[r]=fsub_s(P1[r],dl);} \
      _Pragma("unroll") for(int r=0;r<16;++r)negm[r]=-mhat; asm volatile("":"+v"(negm)); } \
    _Pragma("unroll") for(int r=0;r<16;++r)P0[r]=__builtin_amdgcn_exp2f(P0[r]); }while(0)
  #define RESC() do{ if(resc){ asm volatile("s_waitcnt lgkmcnt(0)":::"memory"); \
      _Pragma("unroll") for(int d_=0;d_<2;++d_) _Pragma("unroll") for(int r=0;r<16;++r)o[d_][r]*=wsf[crow(r,hi)]; } }while(0)
  f32x16 pA0,pA1,pB0,pB1;
  int sl_prev=0,sl_cur=0,sl_next=SLOTB;
  #define ROT() do{sl_prev=sl_cur;sl_cur=sl_next;sl_next=(sl_next==(NSLOT-1)*SLOTB)?0:sl_next+SLOTB;}while(0)
  DMA_K(2,2*SLOTB);
  WAIT_BAR(3);
  qkt(pA0,pA1,Kbase,qr,negm,r32,hi);asm volatile("s_nop 15\n\ts_nop 7":"+v"(pA0),"+v"(pA1));CMASK(pA0,pA1,0);
  START(pA0,pA1);
  _Pragma("unroll") for(int r=0;r<16;++r)pA1[r]=__builtin_amdgcn_exp2f(pA1[r]);
  WAIT_BAR(0);
  DMA_K(3,0);DMA_V(1,SLOTB);
  ROT();
  kload8(kf,kp0+sl_cur);
  WAIT_BAR(2);
  s16x4 vlo[8],vhi[8]; u32x4 pw0,pw1,pw2,pw3;
  #define PKW(P,B) cvtpk_s(P[B],P[B+1])
  #define PAF(k) __builtin_bit_cast(bf16x8,pw##k)
  #define VFR(i) (bf16x8){vlo[i][0],vlo[i][1],vlo[i][2],vlo[i][3],vhi[i][0],vhi[i][1],vhi[i][2],vhi[i][3]}
  #define PIN(x) asm volatile("":"+v"(x))
  #define MX3(a,b,c) __builtin_fmaxf(__builtin_fmaxf((a),(b)),(c))
  #define GAPA(MF,A0,A1,A2,A3,W0,W1,PW) do{ MF; sacc+=A0; sacc+=A1; sacc+=A2; sacc+=A3; PIN(sacc); W0; W1; PIN(PW); SBAR(); }while(0)
  #define EX(v) __builtin_amdgcn_exp2f(v)
  #define GAPB(MF,X,B) do{ MF; X[B]=EX(X[B]); X[B+1]=EX(X[B+1]); X[B+2]=EX(X[B+2]); X[B+3]=EX(X[B+3]); PIN(X); SBAR(); }while(0)
  #define VRD(i) do{ vlo[i]=vtr(vp_+(((i)>>2)*4096+((i)&3)*1024)); vhi[i]=vtr(vp_+(((i)>>2)*4096+((i)&3)*1024+512)); }while(0)
  #define KRD(G,j) do{ if(G){ kload2(kf,kp0+sl_next,j); SBAR(); } }while(0)
  #define STEP(C0,C1,P0,P1,t,GK,GV,GL) do{ SBAR(); \
    const lds_cptr vp_=vp0+sl_prev; \
    VRD(0); SBAR(); float sacc=(P0[0]+P0[1]); \
    GAPA(C0=__builtin_amdgcn_mfma_f32_32x32x16_bf16(kf[0],qr[0],negm,0,0,0), P0[2],P0[3],P0[4],P0[5],     pw0[0]=PKW(P0,0), pw0[1]=PKW(P0,2), pw0); \
    VRD(4); SBAR(); GAPA(C1=__builtin_amdgcn_mfma_f32_32x32x16_bf16(kf[1],qr[0],negm,0,0,0), P0[6],P0[7],P0[8],P0[9],     pw0[2]=PKW(P0,4), pw0[3]=PKW(P0,6), pw0); \
    VRD(1); SBAR(); GAPA(C0=__builtin_amdgcn_mfma_f32_32x32x16_bf16(kf[2],qr[1],C0,0,0,0),   P0[10],P0[11],P0[12],P0[13], pw1[0]=PKW(P0,8), pw1[1]=PKW(P0,10), pw1); \
    VRD(5); SBAR(); GAPA(C1=__builtin_amdgcn_mfma_f32_32x32x16_bf16(kf[3],qr[1],C1,0,0,0),   P0[14],P0[15],P1[0],P1[1],   pw1[2]=PKW(P0,12),pw1[3]=PKW(P0,14), pw1); \
    VRD(2); SBAR(); GAPA(C0=__builtin_amdgcn_mfma_f32_32x32x16_bf16(kf[4],qr[2],C0,0,0,0),   P1[2],P1[3],P1[4],P1[5],     pw2[0]=PKW(P1,0), pw2[1]=PKW(P1,2), pw2); \
    VRD(6); SBAR(); GAPA(C1=__builtin_amdgcn_mfma_f32_32x32x16_bf16(kf[5],qr[2],C1,0,0,0),   P1[6],P1[7],P1[8],P1[9],     pw2[2]=PKW(P1,4), pw2[3]=PKW(P1,6), pw2); \
    VRD(3); SBAR(); GAPA(C0=__builtin_amdgcn_mfma_f32_32x32x16_bf16(kf[6],qr[3],C0,0,0,0),   P1[10],P1[11],P1[12],P1[13], pw3[0]=PKW(P1,8), pw3[1]=PKW(P1,10), pw3); \
    VRD(7); SBAR(); GAPA(C1=__builtin_amdgcn_mfma_f32_32x32x16_bf16(kf[7],qr[3],C1,0,0,0),   P1[14],P1[15],0.f,0.f,       pw3[2]=PKW(P1,12),pw3[3]=PKW(P1,14), pw3); \
    l_reg+=sacc; \
    if(GK){DMA_K((t)+3,sl_cur);} if(GV){DMA_V((t)+1,sl_next);} \
    CMASK(C0,C1,t); \
    { float a=MX3(C0[0],C0[1],C1[0]),b=MX3(C0[2],C0[3],C1[1]); a=MX3(a,C1[2],C1[3]); \
      _Pragma("unroll") for(int r=4;r<16;r+=4){a=MX3(a,C0[r],C0[r+1]);b=MX3(b,C0[r+2],C0[r+3]);a=MX3(a,C1[r],C1[r+1]);b=MX3(b,C1[r+2],C1[r+3]);} \
      float rm=__builtin_fmaxf(a,b); { auto rr=__builtin_amdgcn_permlane32_swap(__float_as_uint(rm),__float_as_uint(rm),false,false); rm=__builtin_fmaxf(__uint_as_float(rr[0]),__uint_as_float(rr[1])); } \
      resc=false; \
      if(__builtin_expect(__any(rm>(float)THRL),0)){ const float dl=__builtin_fmaxf(rm,0.f); mhat+=dl; \
        _Pragma("unroll") for(int r=0;r<16;++r){C0[r]-=dl;C1[r]-=dl;} \
        _Pragma("unroll") for(int r=0;r<16;++r)negm[r]=-mhat; asm volatile("":"+v"(negm)); \
        const float f=__builtin_amdgcn_exp2f(-dl); l_reg*=f; if(hi==0)wsf[r32]=f; resc=true; } } \
    SBAR(); \
    GAPB(o[0]=__builtin_amdgcn_mfma_f32_32x32x16_bf16(PAF(0),VFR(0),o[0],0,0,0), C0,0); \
    GAPB(o[1]=__builtin_amdgcn_mfma_f32_32x32x16_bf16(PAF(0),VFR(4),o[1],0,0,0), C0,4); \
    KRD(GL,0); GAPB(o[0]=__builtin_amdgcn_mfma_f32_32x32x16_bf16(PAF(1),VFR(1),o[0],0,0,0), C0,8); \
    KRD(GL,1); GAPB(o[1]=__builtin_amdgcn_mfma_f32_32x32x16_bf16(PAF(1),VFR(5),o[1],0,0,0), C0,12); \
    KRD(GL,2); GAPB(o[0]=__builtin_amdgcn_mfma_f32_32x32x16_bf16(PAF(2),VFR(2),o[0],0,0,0), C1,0); \
    KRD(GL,3); GAPB(o[1]=__builtin_amdgcn_mfma_f32_32x32x16_bf16(PAF(2),VFR(6),o[1],0,0,0), C1,4); \
    GAPB(o[0]=__builtin_amdgcn_mfma_f32_32x32x16_bf16(PAF(3),VFR(3),o[0],0,0,0), C1,8); \
    GAPB(o[1]=__builtin_amdgcn_mfma_f32_32x32x16_bf16(PAF(3),VFR(7),o[1],0,0,0), C1,12); \
    }while(0)
  int t=1;
  #undef CMASK
  #define CMASK(P0,P1,t) do{}while(0)
  for(;t+5<NT;t+=2){
    STEP(pB0,pB1,pA0,pA1,t,true,true,true);     WAIT_BAR(2); RESC(); ROT();
    STEP(pA0,pA1,pB0,pB1,t+1,true,true,true);   WAIT_BAR(2); RESC(); ROT();
  }
  #undef CMASK
  #define CMASK(P0,P1,t) do{}while(0)
  #define ENDW(tt) do{ if((tt)+3<NT){WAIT_BAR(2);} else if((tt)+2<NT){WAIT_BAR(1);} else {WAIT_BAR(0);} }while(0)
  for(;t+1<NT;t+=2){
    STEP(pB0,pB1,pA0,pA1,t,(t+3<NT),(t+1<NT),(t+1<NT));       ENDW(t);   RESC(); ROT();
    STEP(pA0,pA1,pB0,pB1,t+1,(t+4<NT),(t+2<NT),(t+2<NT));     ENDW(t+1); RESC(); ROT();
  }
  STEP(pB0,pB1,pA0,pA1,NT-1,false,false,false); RESC();
  { float sacc=pB0[0]+pB0[1]; _Pragma("unroll") for(int r=2;r<16;++r)sacc+=pB0[r]; _Pragma("unroll") for(int r=0;r<16;++r)sacc+=pB1[r]; l_reg+=sacc;
    pw0=(u32x4){PKW(pB0,0),PKW(pB0,2),PKW(pB0,4),PKW(pB0,6)};pw1=(u32x4){PKW(pB0,8),PKW(pB0,10),PKW(pB0,12),PKW(pB0,14)};pw2=(u32x4){PKW(pB1,0),PKW(pB1,2),PKW(pB1,4),PKW(pB1,6)};pw3=(u32x4){PKW(pB1,8),PKW(pB1,10),PKW(pB1,12),PKW(pB1,14)};
    SBAR(); pv(o,vb0+sl_cur,PAF(0),PAF(1),PAF(2),PAF(3)); }
  #undef PKW
  #undef PAF
  #undef VFR
  #undef PIN
  #undef MX3
  #undef GAPA
  #undef GAPB
  #undef EX
  #undef VRD
  #undef KRD
  #undef STEP
  #undef ENDW
  {auto rr=__builtin_amdgcn_permlane32_swap(__float_as_uint(l_reg),__float_as_uint(l_reg),false,false);l_reg=__uint_as_float(rr[0])+__uint_as_float(rr[1]);}
  if(hi==0)wsf[32+r32]=l_reg;asm volatile("s_waitcnt lgkmcnt(0)":::"memory");
  float rli[16];
  #pragma unroll
  for(int r=0;r<16;++r)rli[r]=__builtin_amdgcn_rcpf(wsf[32+crow(r,hi)]);
  bf16*Ow=Ou+(long)(wid*QBLK)*OPITCH;
  { bf16*stg=(bf16*)(shm+LDS_OST)+wid*2048;
    #pragma unroll
    for(int r=0;r<16;++r){const int orow=crow(r,hi);
      #pragma unroll
      for(int d0=0;d0<2;++d0)stg[orow*64+d0*32+r32]=__float2bfloat16(o[d0][r]*rli[r]);}
    asm volatile("s_waitcnt lgkmcnt(0)":::"memory");
    #pragma unroll
    for(int i=0;i<4;++i){const int row=i*8+(lane>>3),ch=lane&7; const u32x4 v=*(const u32x4*)(stg+row*64+ch*8); ATTN_STORE16(Ow+(long)row*OPITCH+ch*8,v);} }
  asm volatile("s_waitcnt lgkmcnt(0)\n\ts_barrier":::"memory");
  #undef DMA_K
  #undef DMA_V
  #undef CMASK
  #undef START
  #undef RESC
  #undef ROT
}
#undef SBAR
#undef WAIT_BAR
}
namespace cg = cooperative_groups;
#define LAS __attribute__((address_space(3)))
typedef unsigned short bf16;
typedef unsigned v4u __attribute__((ext_vector_type(4)));
typedef unsigned v2u __attribute__((ext_vector_type(2)));
typedef float f32x4 __attribute__((ext_vector_type(4)));
constexpr int NWAVES = 8, NTHR = 512;
constexpr int DMODEL = 1024, NBATCH = 16, SEQ = 4096, CTX = 256, MXR = NBATCH * SEQ, MCR = NBATCH * CTX, MTR = MXR + MCR;
constexpr int NIN = 1536, DFF = 2816, NGU = 5632, KVL = SEQ + CTX, INW = 1280, MODW_ = 6144;
constexpr size_t MiB = 1u << 20;
constexpr size_t WS_MOD = 0, WS_WIN = 1 * MiB, WS_WOUT = 7 * MiB, WS_WGU = 11 * MiB, WS_WDN = 33 * MiB, WS_TRIG = 44 * MiB, WS_TRIGC = 108 * MiB,
                 WS_CX = 109 * MiB, WS_KP = 125 * MiB, WS_VP = 142 * MiB, WS_HX = 159 * MiB, WS_Z = 295 * MiB, WS_PQT = 431 * MiB, WS_PQTC = 495 * MiB,
                 WS_QP = 499 * MiB, WS_MX = 567 * MiB, WS_H = 295 * MiB, WS_XS = 703 * MiB, WS_PQF = 839 * MiB, WS_PQFC = 871 * MiB, WS_END = 873 * MiB, WS_CTL = 896 * 1024, CTL_BYTES = 16384;
static_assert(WS_H + (size_t)MTR * DFF * 2 <= WS_END && WS_MX + (size_t)MTR * 1024 * 2 <= WS_END && WS_KP + (size_t)NBATCH * KVL * 128 * 2 <= WS_VP, "ws map");
constexpr int LDS_BYTES = 147456;
constexpr float QSCALE = 0.125f * 1.4426950408889634f;

struct P { const float *x, *c, *ctx, *c_ctx, *w_ada, *b_ada, *g_mix, *g_ffn, *w_in, *q_gain, *k_gain, *w_pool, *pool_scale, *w_four, *w_out, *w_gate_up, *w_down; float* out; unsigned char* ws; };

__device__ __forceinline__ unsigned f2bf(float f) { unsigned u = __builtin_bit_cast(unsigned, f); return (u + 0x7fffu + ((u >> 16) & 1u)) >> 16; }
__device__ __forceinline__ unsigned pk2(float lo, float hi) { return f2bf(lo) | (f2bf(hi) << 16); }
__device__ __forceinline__ float bf2f(unsigned short h) { return __builtin_bit_cast(float, (unsigned)h << 16); }
__device__ __forceinline__ float shx(float v, int o, int lane) { return __builtin_bit_cast(float, __builtin_amdgcn_ds_bpermute((lane ^ o) << 2, __builtin_bit_cast(int, v))); }
__device__ __forceinline__ float wave_sum(float v, int lane) {
    v += shx(v, 1, lane); v += shx(v, 2, lane); v += shx(v, 4, lane); v += shx(v, 8, lane); v += shx(v, 16, lane); v += shx(v, 32, lane);
    return v;
}

__device__ __forceinline__ void p0_mod(const P& p, LAS unsigned char* lds, int tid, int wave, int lane) {
    LAS float* sc = (LAS float*)lds;
    LAS float* red = (LAS float*)(lds + 69632);
    float* MOD = (float*)(p.ws + WS_MOD);
    if ((int)blockIdx.x >= 192) return;
    for (int i = tid; i < 17 * 1024; i += NTHR) { const int r = i >> 10, k = i & 1023; const float v = r < 16 ? p.c[r * 1024 + k] : p.c_ctx[k]; sc[i] = v / (1.0f + __expf(-v)); }
    __syncthreads();
    for (int it = blockIdx.x; it < 192; it += gridDim.x) {
        const int layer = it / 96, n0 = (it % 96) * 64;
        float acc[17];
#pragma unroll
        for (int r = 0; r < 17; ++r) acc[r] = 0.f;
        const float* W = p.w_ada + ((size_t)layer * 1024 + wave * 128) * MODW_ + n0 + lane;
        for (int kc = 0; kc < 128; kc += 16) { float wv[16];
#pragma unroll
            for (int j = 0; j < 16; ++j) wv[j] = W[(size_t)(kc + j) * MODW_];
#pragma unroll
            for (int j = 0; j < 16; ++j)
#pragma unroll
                for (int r = 0; r < 17; ++r) acc[r] += sc[r * 1024 + wave * 128 + kc + j] * wv[j]; }
#pragma unroll
        for (int r = 0; r < 17; ++r) red[(wave * 17 + r) * 64 + lane] = acc[r];
        __syncthreads();
        for (int i = tid; i < 17 * 64; i += NTHR) { const int r = i >> 6, l = i & 63; float s = p.b_ada[layer * MODW_ + n0 + l];
#pragma unroll
            for (int w = 0; w < 8; ++w) s += red[(w * 17 + r) * 64 + l];
            MOD[((size_t)layer * 17 + r) * MODW_ + n0 + l] = s; }
        __syncthreads();
    }
}
__device__ __forceinline__ void p0_comp(const P& p, LAS unsigned char* lds, int tid) {
    LAS float* M2 = (LAS float*)lds;
    LAS float* tile = (LAS float*)(lds + 16384);
    for (int it = (int)gridDim.x - 1 - (int)blockIdx.x; it < 192; it += gridDim.x) {
        const int kc = it & 7, g = (it >> 3) & 3, ty = (it >> 5) % 3, layer = it / 96;
        const int k0 = kc * 128;
        LAS float* wfs = (LAS float*)(lds + 49664);
        if (ty != 0) { for (int i = tid; i < 4096; i += NTHR) wfs[i] = p.w_four[(size_t)(layer * 4 + g) * 4096 + i]; __syncthreads(); }
        for (int i = tid; i < 4096; i += NTHR) { const int c = i >> 6, d = i & 63; float v;
            if (ty == 0) v = p.w_pool[((size_t)(layer * 4 + g) * 64 + c) * 64 + d] * p.pool_scale[layer * 256 + g * 64 + d];
            else { v = 0.f;
#pragma unroll 8
                for (int m = 0; m < 64; ++m) { const float rev = (float)((m * c) & 63) * (1.0f / 64.0f); const float t = ty == 1 ? __builtin_amdgcn_cosf(rev) : __builtin_amdgcn_sinf(rev); v += t * wfs[m * 64 + d]; } }
            M2[i] = v; }
        const int srccol = (ty == 0 ? 768 : 1024) + g * 64;
        for (int i = tid; i < 128 * 64; i += NTHR) { const int kk = i >> 6, c = i & 63; tile[kk * 65 + c] = p.w_in[((size_t)layer * 1024 + k0 + kk) * INW + srccol + c]; }
        __syncthreads();
        { const int d = tid & 63, kg = tid >> 6;
          bf16* dst = (bf16*)(p.ws + WS_WIN) + ((size_t)layer * NIN + 768 + ty * 256 + g * 64 + d) * 1024 + k0 + kg * 16;
          float o[16];
#pragma unroll
          for (int j = 0; j < 16; ++j) o[j] = 0.f;
          for (int c = 0; c < 64; ++c) { const float mv = M2[c * 64 + d];
#pragma unroll
              for (int j = 0; j < 16; ++j) o[j] += tile[(kg * 16 + j) * 65 + c] * mv; }
          v4u w0, w1; w0.x = pk2(o[0], o[1]); w0.y = pk2(o[2], o[3]); w0.z = pk2(o[4], o[5]); w0.w = pk2(o[6], o[7]);
          w1.x = pk2(o[8], o[9]); w1.y = pk2(o[10], o[11]); w1.z = pk2(o[12], o[13]); w1.w = pk2(o[14], o[15]);
          *(v4u*)dst = w0; *(v4u*)(dst + 8) = w1; }
        __syncthreads();
    }
}
__device__ __forceinline__ void tr_item(const float* W, int ldw, int c0, int k0, bf16* WT, int K, int r0, LAS float* scr, int lane) {
#pragma unroll 8
    for (int i = 0; i < 32; ++i) { const int kk = 2 * i + (lane >> 5); scr[kk * 33 + (lane & 31)] = W[(size_t)(k0 + kk) * ldw + c0 + (lane & 31)]; }
    asm volatile("s_waitcnt lgkmcnt(0)" ::: "memory");
    const int c = lane & 7;
#pragma unroll
    for (int j = 0; j < 4; ++j) { const int n = (lane >> 3) + 8 * j; const LAS float* s = scr + (8 * c) * 33 + n;
        v4u o; o.x = pk2(s[0 * 33], s[1 * 33]); o.y = pk2(s[2 * 33], s[3 * 33]); o.z = pk2(s[4 * 33], s[5 * 33]); o.w = pk2(s[6 * 33], s[7 * 33]);
        *(v4u*)(WT + (size_t)(r0 + n) * K + k0 + 8 * c) = o; }
    asm volatile("s_waitcnt lgkmcnt(0)" ::: "memory");
}
__device__ __forceinline__ void p0_transposes(const P& p, LAS unsigned char* lds, int wave, int lane) {
    LAS float* scr = (LAS float*)(lds + wave * 16384);
    const int gw = blockIdx.x * NWAVES + wave, NGW = gridDim.x * NWAVES;
    constexpr int I_IN = 24 * 16, I_OUT = 32 * 16, I_GU = 176 * 16, I_DN = 32 * 44, I_L = I_IN + I_OUT + I_GU + I_DN;
    for (int it = gw; it < 2 * I_L; it += NGW) {
        const int layer = it / I_L; int r = it % I_L;
        if (r < I_IN) { const int nb = r % 24, kb = r / 24; tr_item(p.w_in + (size_t)layer * 1024 * INW, INW, nb * 32, kb * 64, (bf16*)(p.ws + WS_WIN) + (size_t)layer * NIN * 1024, 1024, (nb >> 3) * 256 + 128 * (nb & 1) + 32 * ((nb & 7) >> 1), scr, lane); continue; } r -= I_IN;
        if (r < I_OUT) { const int nb = r % 32, kb = r / 32; tr_item(p.w_out + (size_t)layer * 1024 * 1024, 1024, nb * 32, kb * 64, (bf16*)(p.ws + WS_WOUT) + (size_t)layer * 1024 * 1024, 1024, (nb >> 3) * 256 + 128 * (nb & 1) + 32 * ((nb & 7) >> 1), scr, lane); continue; } r -= I_OUT;
        if (r < I_GU) { const int nb = r % 176, kb = r / 176; const int n0 = nb * 32; const int j = n0 < DFF ? n0 : n0 - DFF; const int drow = (j >> 7) * 256 + (n0 < DFF ? 0 : 128) + (j & 127);
            tr_item(p.w_gate_up + (size_t)layer * 1024 * NGU, NGU, n0, kb * 64, (bf16*)(p.ws + WS_WGU) + (size_t)layer * NGU * 1024, 1024, drow, scr, lane); continue; } r -= I_GU;
        { const int nb = r % 32, kb = r / 32; tr_item(p.w_down + (size_t)layer * DFF * 1024, 1024, nb * 32, kb * 64, (bf16*)(p.ws + WS_WDN) + (size_t)layer * 1024 * DFF, DFF, (nb >> 3) * 256 + 128 * (nb & 1) + 32 * ((nb & 7) >> 1), scr, lane); }
    }
}
__device__ __forceinline__ void p0_trig(const P& p, int tid) {
    const int gt = blockIdx.x * NTHR + tid, NGT = gridDim.x * NTHR;
    bf16* TC = (bf16*)(p.ws + WS_TRIGC);
    for (int it = gt; it < 256 * 32; it += NGT) { const int k = it >> 5, c8 = (it & 31) * 8;
        float v[8];
#pragma unroll
        for (int jj = 0; jj < 8; ++jj) { const int j = c8 + jj; const bool isS = j > 128; const int l = isS ? j - 128 : j; const float rev = (float)((k * l) & 255) * (1.0f / 256.0f); v[jj] = isS ? -__builtin_amdgcn_sinf(rev) : __builtin_amdgcn_cosf(rev); }
        v4u w; w.x = pk2(v[0], v[1]); w.y = pk2(v[2], v[3]); w.z = pk2(v[4], v[5]); w.w = pk2(v[6], v[7]);
        *(v4u*)(TC + (size_t)k * 256 + c8) = w; }
}
__device__ __forceinline__ void norm_phase(const float* sx, const float* scx, int nrows, const float* g, const float* modl, int shift_chunk, int scale_chunk, bf16* HX, int wave, int lane) {
    constexpr int R = 2;
    const int gw = blockIdx.x * NWAVES + wave, NGW = gridDim.x * NWAVES;
    f32x4 gm[4];
#pragma unroll
    for (int j = 0; j < 4; ++j) gm[j] = *(const f32x4*)(g + 256 * j + 4 * lane);
    for (int m0 = gw * R; m0 < nrows; m0 += NGW * R) {
        f32x4 v[R][4];
#pragma unroll
        for (int e = 0; e < R; ++e) { const int m = m0 + e; const float* xrow = m < MXR ? sx + (size_t)m * 1024 : scx + (size_t)(m - MXR) * 1024;
#pragma unroll
            for (int j = 0; j < 4; ++j) v[e][j] = *(const f32x4*)(xrow + 256 * j + 4 * lane); }
#pragma unroll
        for (int e = 0; e < R; ++e) { const int m = m0 + e; const float* md = modl + (size_t)(m < MXR ? (m >> 12) : 16) * MODW_;
            float s = 0.f;
#pragma unroll
            for (int j = 0; j < 4; ++j) s += (v[e][j].x * v[e][j].x + v[e][j].y * v[e][j].y) + (v[e][j].z * v[e][j].z + v[e][j].w * v[e][j].w);
            const float rstd = 1.0f / sqrtf(wave_sum(s, lane) * (1.0f / 1024.0f) + 1e-6f);
#pragma unroll
            for (int j = 0; j < 4; ++j) { const f32x4 scv = *(const f32x4*)(md + scale_chunk * 1024 + 256 * j + 4 * lane), shv = *(const f32x4*)(md + shift_chunk * 1024 + 256 * j + 4 * lane);
                const f32x4 y = v[e][j] * rstd * gm[j] * (scv + 1.0f) + shv;
                v2u w; w.x = pk2(y.x, y.y); w.y = pk2(y.z, y.w);
                *(v2u*)(HX + (size_t)m * 1024 + 256 * j + 4 * lane) = w; } }
    }
}
__device__ __forceinline__ void norm_phase_bf16(const bf16* XS, int nrows, const float* g, const float* modl, int shift_chunk, int scale_chunk, bf16* HX, int wave, int lane) {
    constexpr int R = 4;
    const int gw = blockIdx.x * NWAVES + wave, NGW = gridDim.x * NWAVES;
    f32x4 gm[4];
#pragma unroll
    for (int j = 0; j < 4; ++j) gm[j] = *(const f32x4*)(g + 16 * lane + 4 * j);
    for (int m0 = gw * R; m0 < nrows; m0 += NGW * R) {
        v4u ra[R][2];
#pragma unroll
        for (int e = 0; e < R; ++e) { const bf16* xr = XS + (size_t)(m0 + e) * 1024 + lane * 16; ra[e][0] = *(const v4u*)xr; ra[e][1] = *(const v4u*)(xr + 8); }
#pragma unroll
        for (int e = 0; e < R; ++e) { const int m = m0 + e; const float* md = modl + (size_t)(m < MXR ? (m >> 12) : 16) * MODW_;
            const v4u r0 = ra[e][0], r1 = ra[e][1];
            f32x4 v[4];
            v[0] = (f32x4){__builtin_bit_cast(float, r0.x << 16), __builtin_bit_cast(float, r0.x & 0xffff0000u), __builtin_bit_cast(float, r0.y << 16), __builtin_bit_cast(float, r0.y & 0xffff0000u)};
            v[1] = (f32x4){__builtin_bit_cast(float, r0.z << 16), __builtin_bit_cast(float, r0.z & 0xffff0000u), __builtin_bit_cast(float, r0.w << 16), __builtin_bit_cast(float, r0.w & 0xffff0000u)};
            v[2] = (f32x4){__builtin_bit_cast(float, r1.x << 16), __builtin_bit_cast(float, r1.x & 0xffff0000u), __builtin_bit_cast(float, r1.y << 16), __builtin_bit_cast(float, r1.y & 0xffff0000u)};
            v[3] = (f32x4){__builtin_bit_cast(float, r1.z << 16), __builtin_bit_cast(float, r1.z & 0xffff0000u), __builtin_bit_cast(float, r1.w << 16), __builtin_bit_cast(float, r1.w & 0xffff0000u)};
            float s = 0.f;
#pragma unroll
            for (int j = 0; j < 4; ++j) s += (v[j].x * v[j].x + v[j].y * v[j].y) + (v[j].z * v[j].z + v[j].w * v[j].w);
            const float rstd = 1.0f / sqrtf(wave_sum(s, lane) * (1.0f / 1024.0f) + 1e-6f);
            unsigned o[8];
#pragma unroll
            for (int j = 0; j < 4; ++j) { const f32x4 scv = *(const f32x4*)(md + scale_chunk * 1024 + 16 * lane + 4 * j), shv = *(const f32x4*)(md + shift_chunk * 1024 + 16 * lane + 4 * j);
                const f32x4 y = v[j] * rstd * gm[j] * (scv + 1.0f) + shv; o[2 * j] = pk2(y.x, y.y); o[2 * j + 1] = pk2(y.z, y.w); }
            bf16* hp = HX + (size_t)m * 1024 + lane * 16;
            *(v4u*)hp = (v4u){o[0], o[1], o[2], o[3]}; *(v4u*)(hp + 8) = (v4u){o[4], o[5], o[6], o[7]}; }
    }
}
__device__ __forceinline__ void prep_phase(const P& p, int layer, LAS unsigned char* lds, int tid, int wave, int lane, int cu, int ncu) {
    const bf16* Z = (const bf16*)(p.ws + WS_Z); bf16* MX = (bf16*)(p.ws + WS_MX);
    const int gw = cu * NWAVES + wave, NGW = ncu * NWAVES;
    { const int nrows = layer == 0 ? MTR : MXR;
      for (int it = gw; it < nrows / 4; it += NGW) {
        const int m = it * 4 + (lane >> 4), c = lane & 15;
        const bool isx = m < MXR;
        const int t = isx ? (m & 4095) : ((m - MXR) & 255), L = isx ? SEQ : CTX;
        const int w = 2 << (c >> 2);
        int lo = t - (w >> 1); if (lo < 0) lo = 0; int hi = t + w - (w >> 1); if (hi > L) hi = L;
        const bf16* zb = Z + (size_t)(m - t) * 1024 + 768 + c * 16;
        float a[16];
#pragma unroll
        for (int f = 0; f < 16; ++f) a[f] = 0.f;
        float sv[16];
        { const v4u q0 = *(const v4u*)(zb + (size_t)t * 1024), q1 = *(const v4u*)(zb + (size_t)t * 1024 + 8);
          const unsigned ww[8] = {q0.x, q0.y, q0.z, q0.w, q1.x, q1.y, q1.z, q1.w};
#pragma unroll
          for (int j = 0; j < 8; ++j) { sv[2 * j] = __builtin_bit_cast(float, ww[j] << 16); sv[2 * j + 1] = __builtin_bit_cast(float, ww[j] & 0xffff0000u); } }
#pragma unroll
        for (int ib = 0; ib < 16; ib += 8) { v4u q0[8], q1[8];
#pragma unroll
            for (int i = 0; i < 8; ++i) { int tt = lo + ib + i; if (tt > hi - 1) tt = hi - 1; q0[i] = *(const v4u*)(zb + (size_t)tt * 1024); q1[i] = *(const v4u*)(zb + (size_t)tt * 1024 + 8); }
#pragma unroll
            for (int i = 0; i < 8; ++i) { const float wgt = (lo + ib + i < hi) ? 1.0f : 0.0f;
                const unsigned ww[8] = {q0[i].x, q0[i].y, q0[i].z, q0[i].w, q1[i].x, q1[i].y, q1[i].z, q1[i].w};
#pragma unroll
                for (int j = 0; j < 8; ++j) { a[2 * j] += wgt * __builtin_bit_cast(float, ww[j] << 16); a[2 * j + 1] += wgt * __builtin_bit_cast(float, ww[j] & 0xffff0000u); } } }
        const float inv = 1.0f / (float)(hi - lo);
        v4u w0, w1;
        w0.x = pk2(a[0] * inv - sv[0], a[1] * inv - sv[1]); w0.y = pk2(a[2] * inv - sv[2], a[3] * inv - sv[3]); w0.z = pk2(a[4] * inv - sv[4], a[5] * inv - sv[5]); w0.w = pk2(a[6] * inv - sv[6], a[7] * inv - sv[7]);
        w1.x = pk2(a[8] * inv - sv[8], a[9] * inv - sv[9]); w1.y = pk2(a[10] * inv - sv[10], a[11] * inv - sv[11]); w1.z = pk2(a[12] * inv - sv[12], a[13] * inv - sv[13]); w1.w = pk2(a[14] * inv - sv[14], a[15] * inv - sv[15]);
        bf16* o = MX + (size_t)m * 1024 + 512 + c * 16; *(v4u*)o = w0; *(v4u*)(o + 8) = w1;
      } }
    __syncthreads();
    { LAS unsigned short* row = (LAS unsigned short*)(lds + wave * 16384);
      const bf16* PQT = (const bf16*)(p.ws + WS_PQT); const bf16* PQTC = (const bf16*)(p.ws + WS_PQTC); bf16* PQF = (bf16*)(p.ws + WS_PQF); bf16* PQFC = (bf16*)(p.ws + WS_PQFC);
      const int ntot = layer == 0 ? 8192 : 4096;
      for (int it = 4096 + gw; it < ntot; it += NGW) {
        const bool isx = it < 4096; const int n = isx ? it : it - 4096, L = isx ? SEQ : CTX, H2 = L >> 1;
        const bf16* src = isx ? PQT + (size_t)n * 8192 : PQTC + (size_t)n * 512;
        bf16* dst = isx ? PQF + (size_t)n * 4096 : PQFC + (size_t)n * 256;
        for (int c = lane; c < L / 4; c += 64) *(LAS v4u*)(row + c * 8) = *(const v4u*)(src + c * 8);
        asm volatile("s_waitcnt vmcnt(0) lgkmcnt(0)" ::: "memory");
        for (int c = lane; c < L / 8; c += 64) { const int j0 = c * 8; float o[8];
#pragma unroll
            for (int jj = 0; jj < 8; ++jj) { const int j = j0 + jj; const bool lowh = j <= H2; const int l = j - H2;
                const int ia = lowh ? j : L + l, ib = lowh ? L - j : 2 * L - l;
                const float va = bf2f(row[ia]), vb = bf2f(row[ib]);
                const float sg = lowh ? ((j == 0 || j == H2) ? 0.0f : 1.0f) : -1.0f;
                o[jj] = va + sg * vb; }
            v4u w; w.x = pk2(o[0], o[1]); w.y = pk2(o[2], o[3]); w.z = pk2(o[4], o[5]); w.w = pk2(o[6], o[7]);
            *(v4u*)(dst + j0) = w; }
        asm volatile("s_waitcnt lgkmcnt(0)" ::: "memory");
      } }
    __syncthreads();
}

__device__ __forceinline__ constexpr int bitrev6(int i) { return ((i & 1) << 5) | ((i & 2) << 3) | ((i & 4) << 1) | ((i & 8) >> 1) | ((i & 16) >> 3) | ((i & 32) >> 5); }
typedef float f32x2 __attribute__((ext_vector_type(2)));
template <int HALF> __device__ __forceinline__ void fft64_stage(f32x2 (&x)[64]) {
constexpr float FC[32] = {1.000000000e+00f, 9.951847267e-01f, 9.807852804e-01f, 9.569403357e-01f, 9.238795325e-01f, 8.819212643e-01f, 8.314696123e-01f, 7.730104534e-01f, 7.071067812e-01f, 6.343932842e-01f, 5.555702330e-01f, 4.713967368e-01f, 3.826834324e-01f, 2.902846773e-01f, 1.950903220e-01f, 9.801714033e-02f, 6.123233996e-17f, -9.801714033e-02f, -1.950903220e-01f, -2.902846773e-01f, -3.826834324e-01f, -4.713967368e-01f, -5.555702330e-01f, -6.343932842e-01f, -7.071067812e-01f, -7.730104534e-01f, -8.314696123e-01f, -8.819212643e-01f, -9.238795325e-01f, -9.569403357e-01f, -9.807852804e-01f, -9.951847267e-01f};
    constexpr float FS[32] = {0.000000000e+00f, 9.801714033e-02f, 1.950903220e-01f, 2.902846773e-01f, 3.826834324e-01f, 4.713967368e-01f, 5.555702330e-01f, 6.343932842e-01f, 7.071067812e-01f, 7.730104534e-01f, 8.314696123e-01f, 8.819212643e-01f, 9.238795325e-01f, 9.569403357e-01f, 9.807852804e-01f, 9.951847267e-01f, 1.000000000e+00f, 9.951847267e-01f, 9.807852804e-01f, 9.569403357e-01f, 9.238795325e-01f, 8.819212643e-01f, 8.314696123e-01f, 7.730104534e-01f, 7.071067812e-01f, 6.343932842e-01f, 5.555702330e-01f, 4.713967368e-01f, 3.826834324e-01f, 2.902846773e-01f, 1.950903220e-01f, 9.801714033e-02f};
#pragma unroll
    for (int b0 = 0; b0 < 64; b0 += 2 * HALF)
#pragma unroll
        for (int j = 0; j < HALF; ++j) { const int e = j * (32 / HALF), i0 = b0 + j, i1 = b0 + j + HALF;
            const f32x2 a = x[i0], b = x[i1];
            x[i0] = a + b;
            const f32x2 d = a - b, dsw = __builtin_shufflevector(d, d, 1, 0);
            if (e == 0) x[i1] = d;
            else if (e == 16) x[i1] = dsw * (f32x2){1.0f, -1.0f};
            else x[i1] = d * (f32x2){FC[e], FC[e]} + dsw * (f32x2){FS[e], -FS[e]}; }
}
__device__ __forceinline__ void fft64_dif(f32x2 (&x)[64]) {
    fft64_stage<32>(x); __builtin_amdgcn_sched_barrier(0); fft64_stage<16>(x); __builtin_amdgcn_sched_barrier(0); fft64_stage<8>(x); __builtin_amdgcn_sched_barrier(0);
    fft64_stage<4>(x); __builtin_amdgcn_sched_barrier(0); fft64_stage<2>(x); __builtin_amdgcn_sched_barrier(0); fft64_stage<1>(x); __builtin_amdgcn_sched_barrier(0);
}
__device__ __forceinline__ void fft_phase(const P& p, LAS unsigned char* lds, int tid, int wave, int lane, int cu, int ncu) {
    const bf16* PQT = (const bf16*)(p.ws + WS_PQT); bf16* MX = (bf16*)(p.ws + WS_MX);
    LAS unsigned short* row = (LAS unsigned short*)(lds + wave * 16640);
    LAS float* T = (LAS float*)(lds + wave * 16640);
    LAS unsigned short* OUT = (LAS unsigned short*)lds;
    for (int k = 0; k * ncu < 512; ++k) {
        const int it = (ncu == 256) ? ((((cu & 7) + 8 * ((cu >> 6) + 4 * k)) << 3) | ((cu >> 3) & 7)) : cu + k * ncu;
        if (it >= 512) break;
        const int bgi = it >> 3, db = it & 7, n = bgi * 64 + db * 8 + wave;
        int lane_t = lane; asm volatile("" : "+v"(lane_t));
        const bf16* src = PQT + (size_t)n * 8192;
        for (int c = lane; c < 1024; c += 64) *(LAS v4u*)(row + c * 8) = *(const v4u*)(src + c * 8);
        asm volatile("s_waitcnt vmcnt(0) lgkmcnt(0)" ::: "memory"); __builtin_amdgcn_sched_barrier(0);
        f32x2 x[64];
#pragma unroll
        for (int r = 0; r < 64; ++r) x[r] = (f32x2){bf2f(row[64 * r + lane]), -bf2f(row[4096 + 64 * r + lane])};
        asm volatile("s_waitcnt lgkmcnt(0)" ::: "memory"); __builtin_amdgcn_sched_barrier(0);
        fft64_dif(x);
        float ti[64];
#pragma unroll
        for (int r = 0; r < 64; ++r) { const int k1 = bitrev6(r); const float rev = (float)((k1 * lane_t) & 4095) * (1.0f / 4096.0f);
            const float c = __builtin_amdgcn_cosf(rev), s = __builtin_amdgcn_sinf(rev);
            const f32x2 t = x[r] * (f32x2){c, c} + __builtin_shufflevector(x[r], x[r], 1, 0) * (f32x2){s, -s}; T[k1 * 65 + lane] = t.x; ti[r] = t.y; }
        f32x2 bb[64];
        asm volatile("s_waitcnt lgkmcnt(0)" ::: "memory"); __builtin_amdgcn_sched_barrier(0);
#pragma unroll
        for (int r = 0; r < 64; ++r) bb[r].x = T[lane * 65 + r];
        asm volatile("s_waitcnt lgkmcnt(0)" ::: "memory"); __builtin_amdgcn_sched_barrier(0);
#pragma unroll
        for (int r = 0; r < 64; ++r) { const int k1 = bitrev6(r); T[k1 * 65 + lane] = ti[r]; }
        asm volatile("s_waitcnt lgkmcnt(0)" ::: "memory"); __builtin_amdgcn_sched_barrier(0);
#pragma unroll
        for (int r = 0; r < 64; ++r) bb[r].y = T[lane * 65 + r];
        asm volatile("s_waitcnt lgkmcnt(0)" ::: "memory"); __builtin_amdgcn_sched_barrier(0);
        fft64_dif(bb);
        __syncthreads();
#pragma unroll
        for (int r = 0; r < 64; ++r) { const int k2 = bitrev6(r); OUT[(lane + 64 * k2) * 8 + wave] = (unsigned short)f2bf(bb[r].x * (1.0f / 512.0f)); }
        __syncthreads();
        { const int b = bgi >> 2, g = bgi & 3;
#pragma unroll
          for (int i = 0; i < 8; ++i) { const int k = tid + 512 * i; const v4u v = *(const LAS v4u*)(OUT + k * 8);
              *(v4u*)(MX + ((size_t)(b * SEQ + k)) * 1024 + 768 + g * 64 + db * 8) = v; } }
        __syncthreads();
    }
}
typedef __attribute__((address_space(1))) unsigned gu32;
#define RLX_AGENT __ATOMIC_RELAXED, __HIP_MEMORY_SCOPE_AGENT
#define XB_TMO      128
#define XB_XCNT(j)  (256  + 64 * (j))
#define XB_XSUB(j)  (1280 + 64 * (j))
#define XB_XGEN(j)  (2304 + 64 * (j))
#define XB_TOP      3328
#define XB_TOPGEN   3392
#define XCD_BAR_WORDS 3456
#define XB_SPIN_CAP (1u << 18)

__device__ __forceinline__ unsigned xb_ld(unsigned* p)              { return __hip_atomic_load(p, __ATOMIC_RELAXED, __HIP_MEMORY_SCOPE_AGENT); }
__device__ __forceinline__ unsigned xb_add(unsigned* p, unsigned v) { return __hip_atomic_fetch_add(p, v, __ATOMIC_RELAXED, __HIP_MEMORY_SCOPE_AGENT); }
__device__ __forceinline__ unsigned xb_xcc_id() { return (unsigned)__builtin_amdgcn_s_getreg((3 << 11) | 20) & 0xFu; }
#define XB_SPIN(cond, bar) do { unsigned _sp = 0; while (cond) { __builtin_amdgcn_s_sleep(1); \
    if ((++_sp & 255u) == 0u) { if (xb_ld(&(bar)[XB_TMO])) break; if (_sp > XB_SPIN_CAP) { atomicAdd(&(bar)[XB_TMO], 1u); break; } } } } while (0)

struct XcdBarrier {
    unsigned* bar; unsigned x;
    volatile LAS unsigned* st;
};

__device__ __forceinline__ XcdBarrier xcd_barrier_post(unsigned* bar, volatile LAS unsigned* st) {
    XcdBarrier b; b.bar = bar; b.x = (unsigned)__builtin_amdgcn_readfirstlane((int)xb_xcc_id()); b.st = st;
    if (threadIdx.x == 0) (void)xb_add(&bar[XB_XCNT(b.x)], 1u);
    return b;
}
__device__ __forceinline__ void xcd_barrier_complete(unsigned* bar, unsigned x, unsigned& nloc, unsigned& nx) {
    const unsigned G = gridDim.x * gridDim.y * gridDim.z;
    unsigned sum, cnt, mine, sp = 0u;
    for (;;) {
        sum = 0u; cnt = 0u; mine = 0u;
#pragma unroll
        for (unsigned j = 0; j < 16; ++j) { const unsigned c = xb_ld(&bar[XB_XCNT(j)]); sum += c; cnt += (c > 0u) ? 1u : 0u; mine = (j == x) ? c : mine; }
        if (sum == G) break;
        __builtin_amdgcn_s_sleep(1);
        if ((++sp & 255u) == 0u) { if (xb_ld(&bar[XB_TMO])) break; if (sp > XB_SPIN_CAP) { atomicAdd(&bar[XB_TMO], 1u); break; } }
    }
    nloc = mine > 0u ? mine : 1u; nx = cnt > 0u ? cnt : 1u;
}

__device__ __forceinline__ void xcd_barrier(const XcdBarrier& b) {
    asm volatile("s_waitcnt vmcnt(0)" ::: "memory");
    __syncthreads();
    if (threadIdx.x == 0) {
        unsigned* bar = b.bar; unsigned bx_ = b.x; asm volatile("" : "+s"(bx_));
        __builtin_amdgcn_s_waitcnt(0);
        unsigned nloc = b.st[0], nx = b.st[1];
        if (nloc == 0u) { xcd_barrier_complete(bar, bx_, nloc, nx); b.st[0] = nloc; b.st[1] = nx; }
        const unsigned old = xb_add(&bar[XB_XSUB(bx_)], 1u);
        const unsigned gen = old / nloc;
        if (old + 1u == (gen + 1u) * nloc) {
            __builtin_amdgcn_fence(__ATOMIC_RELEASE, "agent");
            asm volatile("s_waitcnt vmcnt(0)" ::: "memory");
            const unsigned og = xb_add(&bar[XB_TOP], 1u);
            const unsigned tg = og / nx;
            if (og + 1u == (tg + 1u) * nx) xb_add(&bar[XB_TOPGEN], 1u);
            else XB_SPIN(xb_ld(&bar[XB_TOPGEN]) == tg, bar);
            __builtin_amdgcn_fence(__ATOMIC_ACQUIRE, "agent");
            xb_add(&bar[XB_XGEN(bx_)], 1u);
            asm volatile("s_waitcnt vmcnt(0)" ::: "memory");
        } else {
            XB_SPIN(xb_ld(&bar[XB_XGEN(bx_)]) == gen, bar);
            __builtin_amdgcn_fence(__ATOMIC_ACQUIRE, "agent");
            asm volatile("s_waitcnt vmcnt(0)" ::: "memory");
        }
    }
    __syncthreads();
}

__global__ void __launch_bounds__(NTHR, 2) mk_fwd(P p) {
    extern __shared__ __attribute__((aligned(16))) unsigned char lds_raw[];
    LAS unsigned char* lds = (LAS unsigned char*)lds_raw;
    cg::grid_group grid = cg::this_grid();
    if (p.ws == nullptr) grid.sync();
    volatile LAS unsigned* bst = (volatile LAS unsigned*)(lds + 138240);
    if (threadIdx.x < 2) bst[threadIdx.x] = 0u;
    __syncthreads();
    const XcdBarrier xbar = xcd_barrier_post((unsigned*)(p.ws + WS_CTL), bst);
#define GRID_SYNC() xcd_barrier(xbar)
#define FRESH_IDS() int tid = threadIdx.x; asm volatile("" : "+v"(tid)); const int lane = tid & 63, wave = __builtin_amdgcn_readfirstlane(tid >> 6); int bx = blockIdx.x; asm volatile("" : "+s"(bx)); \
    const int vcu = (G % 8 == 0) ? (bx % 8) * (G / 8) + bx / 8 : bx; (void)lane; (void)wave; (void)vcu
    const int G = gridDim.x;
    unsigned char* ws = p.ws;
    float* MOD = (float*)(ws + WS_MOD);
    bf16* HX = (bf16*)(ws + WS_HX); bf16* Zb = (bf16*)(ws + WS_Z); bf16* MXb = (bf16*)(ws + WS_MX); bf16* Hb = (bf16*)(ws + WS_H);
    bf16* PQT = (bf16*)(ws + WS_PQT); bf16* PQTC = (bf16*)(ws + WS_PQTC); bf16* XS = (bf16*)(ws + WS_XS);
    const attn_body::bf16* QPb = (const attn_body::bf16*)(ws + WS_QP); const attn_body::bf16* KPb = (const attn_body::bf16*)(ws + WS_KP); const attn_body::bf16* VPb = (const attn_body::bf16*)(ws + WS_VP);

    LAS float* ropeT = (LAS float*)(lds + 139264);
    for (int i = threadIdx.x; i < 1024; i += NTHR) { const int pos = i >> 4, f = i & 15; const float fr = expf(-(float)f * (1.0f / 16.0f) * 9.210340371976184f); const float a = (float)pos * fr; float rev = a * 0.15915494309189535f; rev -= floorf(rev);
        ropeT[i] = __builtin_amdgcn_cosf(rev); ropeT[1024 + i] = __builtin_amdgcn_sinf(rev); }
    __syncthreads();
    { FRESH_IDS();
    p0_mod(p, lds, tid, wave, lane);
    __syncthreads();
    p0_comp(p, lds, tid);
    __syncthreads();
    p0_transposes(p, lds, wave, lane);
    p0_trig(p, tid); }
    GRID_SYNC();

    for (int layer = 0; layer < 2; ++layer) {
        const bool upd = layer == 0;
        const float* modl = MOD + (size_t)layer * 17 * MODW_;
        const bf16* WIN = (const bf16*)(ws + WS_WIN) + (size_t)layer * NIN * 1024;
        const bf16* WOUT = (const bf16*)(ws + WS_WOUT) + (size_t)layer * 1024 * 1024;
        const bf16* WGU = (const bf16*)(ws + WS_WGU) + (size_t)layer * NGU * 1024;
        const bf16* WDN = (const bf16*)(ws + WS_WDN) + (size_t)layer * 1024 * DFF;
        { FRESH_IDS(); if (layer == 0) norm_phase(p.x, p.ctx, MTR, p.g_mix, modl, 0, 1, HX, wave, lane); else norm_phase_bf16(XS, MTR, p.g_mix + 1024, modl, 0, 1, HX, wave, lane); }
        GRID_SYNC();
        { FRESH_IDS();
            pg8::EpiIn E{Zb, PQT, PQTC, 0, 0, (bf16*)(ws + WS_QP), (bf16*)(ws + WS_KP), (bf16*)(ws + WS_VP), p.q_gain + layer * 64, p.k_gain + layer * 64, ropeT, QSCALE};
            if (upd) { pg8::Gemm g{HX, WIN, MTR, NIN, 1024}; pg8::StaticOrder S; S.init(MTR, NIN, G, bx); pg8::gemm_phase<pg8::EpiIn, pg8::StaticOrder, true, true>(lds, g, S, E); }
            else {
                { pg8::Gemm g{HX, WIN, MXR, NIN, 1024}; pg8::StaticOrder S; S.init(MXR, NIN, G, bx); pg8::gemm_phase<pg8::EpiIn, pg8::StaticOrder, true, true>(lds, g, S, E); }
            }
        }
        GRID_SYNC();
        { FRESH_IDS();
          const int ngemm = upd ? 0 : 16;
          if (bx >= G - ngemm) { pg8::EpiIn E2{Zb, PQT, PQTC, MXR, 512, (bf16*)(ws + WS_QP), (bf16*)(ws + WS_KP), (bf16*)(ws + WS_VP), p.q_gain + layer * 64, p.k_gain + layer * 64, ropeT, QSCALE};
              pg8::Gemm g{HX + (size_t)MXR * 1024, WIN + (size_t)512 * 1024, MCR, 256, 1024}; pg8::StaticOrder S; S.init(MCR, 256, G, G - 1 - bx);
              pg8::gemm_phase<pg8::EpiIn, pg8::StaticOrder, true, true>(lds, g, S, E2); }
          else prep_phase(p, layer, lds, tid, wave, lane, bx, G - ngemm); }
        GRID_SYNC();
        { FRESH_IDS();
            for (int i = 0; i < (2048 + G - 1) / G; ++i) { const int pu = i * G + vcu; if (pu >= 2048) break;
                const int bg = pu >> 6, u = pu & 63, b = bg >> 1, gk = bg & 1, h = gk * 4 + (u >> 4), qb = u & 15;
                const size_t qrow = (size_t)b * SEQ + qb * 256;
                attn_body::attn_unit<8>(QPb + qrow * 512 + h * 64, KPb + (size_t)b * KVL * 128 + gk * 64, VPb + (size_t)b * KVL * 128 + gk * 64,
                                        (attn_body::bf16*)MXb + qrow * 1024 + h * 64, KVL / 64, (char*)lds_raw); }
            if (upd) for (int cu = vcu; cu < 128; cu += G) { const int b = cu >> 3, h = cu & 7, gk = h >> 2; const size_t qrow = (size_t)MXR + b * CTX;
                attn_body::attn_unit<8>(QPb + qrow * 512 + h * 64, KPb + (size_t)b * KVL * 128 + gk * 64, VPb + (size_t)b * KVL * 128 + gk * 64,
                                        (attn_body::bf16*)MXb + qrow * 1024 + h * 64, CTX / 64, (char*)lds_raw); }
            fft_phase(p, lds, tid, wave, lane, bx, G);
            if (upd) { pg8::Gemm g{(const bf16*)(ws + WS_TRIGC), (const bf16*)(ws + WS_PQFC), CTX, 4096, CTX}; pg8::StaticOrder S; S.init(CTX, 4096, G, G - 1 - bx); pg8::EpiFour E{MXb, MXR, CTX, 1.0f / 128.0f};
              pg8::gemm_phase<pg8::EpiFour, pg8::StaticOrder, true, true>(lds, g, S, E); }
        }
        GRID_SYNC();
        { FRESH_IDS(); const int M = upd ? MTR : MXR; pg8::Gemm g{MXb, WOUT, M, 1024, 1024}; pg8::StaticOrder S; S.init(M, 1024, G, bx); pg8::EpiRes E{layer == 0 ? p.x : (const float*)nullptr, p.ctx, XS, XS, (float*)nullptr, modl + 2 * 1024};
          pg8::gemm_phase<pg8::EpiRes, pg8::StaticOrder, true, true>(lds, g, S, E); }
        GRID_SYNC();
        { FRESH_IDS(); norm_phase_bf16(XS, upd ? MTR : MXR, p.g_ffn + layer * 1024, modl, 3, 4, HX, wave, lane); }
        GRID_SYNC();
        { FRESH_IDS(); const int M = upd ? MTR : MXR; pg8::Gemm g{HX, WGU, M, NGU, 1024}; pg8::StaticOrder S; S.init(M, NGU, G, bx); pg8::EpiSwiglu E{Hb};
          pg8::gemm_phase<pg8::EpiSwiglu, pg8::StaticOrder, true, true>(lds, g, S, E); }
        GRID_SYNC();
        { FRESH_IDS(); const int M = upd ? MTR : MXR; pg8::Gemm g{Hb, WDN, M, 1024, DFF}; pg8::StaticOrder S; S.init(M, 1024, G, bx); pg8::EpiRes E{(const float*)nullptr, (const float*)nullptr, XS, upd ? XS : (bf16*)nullptr, p.out, modl + 5 * 1024};
          pg8::gemm_phase<pg8::EpiRes, pg8::StaticOrder, true, true>(lds, g, S, E); }
        if (layer == 0) GRID_SYNC();
    }
}

extern "C" void kernel_launch(void* const* d_in, const int* in_sizes, int n_in, void* d_out, int out_size, void* d_ws, size_t ws_size, hipStream_t stream) {
    static int grid = 0;
    if (grid == 0) {
        if (n_in != 17 || ws_size < WS_END) { fprintf(stderr, "kernel_launch: unexpected n_in %d / ws %zu\n", n_in, ws_size); grid = -1; return; }
        int dev = 0, cus = 0, per_cu = 0;
        hipGetDevice(&dev); hipDeviceGetAttribute(&cus, hipDeviceAttributeMultiprocessorCount, dev);
        hipFuncSetAttribute((const void*)mk_fwd, hipFuncAttributeMaxDynamicSharedMemorySize, LDS_BYTES);
        hipOccupancyMaxActiveBlocksPerMultiprocessor(&per_cu, (const void*)mk_fwd, NTHR, LDS_BYTES);
        (void)hipGetLastError();
        if (per_cu < 1) per_cu = 1;
        grid = cus * per_cu;
    }
    if (grid < 0) return;
    if (hipMemsetAsync((char*)d_ws + WS_CTL, 0, CTL_BYTES, stream) != hipSuccess) { fprintf(stderr, "memset failed\n"); return; }
    P p{};
    const float** pp = (const float**)&p;
    for (int i = 0; i < 17; ++i) pp[i] = (const float*)d_in[i];
    p.out = (float*)d_out; p.ws = (unsigned char*)d_ws;
    void* args[] = {&p};
    hipError_t e = hipLaunchCooperativeKernel((const void*)mk_fwd, dim3(grid), dim3(NTHR), args, LDS_BYTES, stream);
    if (e != hipSuccess) fprintf(stderr, "cooperative launch failed: %s (grid %d)\n", hipGetErrorString(e), grid);
}
```
